# Optimizing an MI355X kernel written in HIP

```python
import math
import jax, jax.numpy as jnp
from jax import lax
import numpy as np

D_MODEL = 1024
BATCH = 8
SEQ = 4096
DEPTH = 4

PLE_DIM = 256
HEAD_DIM = 64
LRU_WIDTH = D_MODEL // 2
LRU_BLOCKS = 8
LRU_BLOCK = LRU_WIDTH // LRU_BLOCKS
CONV_WIDTH = 4
LRU_C = 8.0
SB_HEADS = 8
SB_WIDTH = SB_HEADS * HEAD_DIM
DIFF_HEADS = 8
DIFF_QK = DIFF_HEADS * 2 * HEAD_DIM
DIFF_V = DIFF_HEADS * 2 * HEAD_DIM
EVEN_IN = 2 * LRU_WIDTH + 4 * SB_WIDTH
EVEN_MIX = LRU_WIDTH + SB_WIDTH
ODD_IN = 2 * DIFF_QK + 2 * DIFF_V
ODD_MIX = DIFF_V
Q_BLOCK = 128
ROPE_THETA = 10000.0
EPS = 1e-6

kernel_name = 'hybrid_rglru_stickbreak_diffattn_trunk'


def rmsnorm(x, g):
    xf = x.astype(jnp.float32)
    ms = jnp.mean(xf * xf, axis=-1, keepdims=True)
    return (xf * lax.rsqrt(ms + EPS) * g.astype(jnp.float32)).astype(x.dtype)


def rope(x, positions):
    dh = x.shape[-1]
    inv_freq = ROPE_THETA ** (-jnp.arange(0, dh, 2, dtype=jnp.float32) / dh)
    ang = positions.astype(jnp.float32)[..., None] * inv_freq
    cos = jnp.cos(ang)[:, :, None, :]
    sin = jnp.sin(ang)[:, :, None, :]
    xf = x.astype(jnp.float32)
    x1, x2 = xf[..., : dh // 2], xf[..., dh // 2:]
    out = jnp.concatenate([x1 * cos - x2 * sin, x2 * cos + x1 * sin], axis=-1)
    return out.astype(x.dtype)


def causal_depthwise_conv(x, w, b):
    S = x.shape[1]
    xp = jnp.pad(x, ((0, 0), (CONV_WIDTH - 1, 0), (0, 0)))
    out = b
    for k in range(CONV_WIDTH):
        out = out + w[k] * xp[:, k:k + S]
    return out


def block_diag_linear(x, w, b):
    B, S, C = x.shape
    xb = x.reshape(B, S, LRU_BLOCKS, LRU_BLOCK)
    return jnp.einsum('bsnc,ncd->bsnd', xb, w).reshape(B, S, C) + b


def rg_lru(x, w_a, b_a, w_x, b_x, lam):
    r = jax.nn.sigmoid(block_diag_linear(x, w_a, b_a).astype(jnp.float32))
    i = jax.nn.sigmoid(block_diag_linear(x, w_x, b_x).astype(jnp.float32))
    log_a = LRU_C * r * jax.nn.log_sigmoid(lam.astype(jnp.float32))
    a = jnp.exp(log_a)
    u = jnp.sqrt(-jnp.expm1(2.0 * log_a)) * (i * x.astype(jnp.float32))

    def combine(left, right):
        a_l, b_l = left
        a_r, b_r = right
        return a_l * a_r, a_r * b_l + b_r

    _, h = lax.associative_scan(combine, (a, u), axis=1)
    return h.astype(x.dtype)


def stick_breaking_attention(q, k, v):
    B, S, H, Dh = q.shape
    scale = Dh ** -0.5
    outs = []
    for start in range(0, S, Q_BLOCK):
        end = start + Q_BLOCK
        z = jnp.einsum('bqhd,bkhd->bhqk', q[:, start:end].astype(jnp.float32),
                       k[:, :end].astype(jnp.float32)) * scale
        mask = jnp.arange(end)[None, :] < (start + jnp.arange(Q_BLOCK))[:, None]
        log_1m = jnp.where(mask, jax.nn.log_sigmoid(-z), 0.0)
        cs = jnp.cumsum(log_1m, axis=-1)
        log_w = jax.nn.log_sigmoid(z) + (cs[..., -1:] - cs)
        w = jnp.where(mask, jnp.exp(log_w), 0.0)
        outs.append(jnp.einsum('bhqk,bkhd->bqhd', w.astype(v.dtype), v[:, :end]))
    return jnp.concatenate(outs, axis=1)


def _causal_softmax_block(q_blk, k_pre, mask, scale):
    s = jnp.einsum('bqhd,bkhd->bhqk', q_blk.astype(jnp.float32), k_pre.astype(jnp.float32)) * scale
    s = jnp.where(mask, s, -jnp.inf)
    return jax.nn.softmax(s, axis=-1)


def differential_attention(q1, q2, k1, k2, v, lam):
    B, S, H, Dh = q1.shape
    scale = Dh ** -0.5
    outs = []
    for start in range(0, S, Q_BLOCK):
        end = start + Q_BLOCK
        mask = jnp.arange(end)[None, :] <= (start + jnp.arange(Q_BLOCK))[:, None]
        p1 = _causal_softmax_block(q1[:, start:end], k1[:, :end], mask, scale)
        p2 = _causal_softmax_block(q2[:, start:end], k2[:, :end], mask, scale)
        w = p1 - lam.astype(jnp.float32) * p2
        outs.append(jnp.einsum('bhqk,bkhd->bqhd', w.astype(v.dtype), v[:, :end]))
    return jnp.concatenate(outs, axis=1)


def even_mixer(h, w_in, conv_w, conv_b, w_a, b_a, w_x, b_x, lam, w_out):
    B, S, _ = h.shape
    y = h @ w_in
    xa, ga, q, k, v, gb = jnp.split(
        y, [LRU_WIDTH, 2 * LRU_WIDTH, 2 * LRU_WIDTH + SB_WIDTH,
            2 * LRU_WIDTH + 2 * SB_WIDTH, 2 * LRU_WIDTH + 3 * SB_WIDTH], axis=-1)
    xa = causal_depthwise_conv(xa, conv_w, conv_b)
    oa = rg_lru(xa, w_a, b_a, w_x, b_x, lam) * jax.nn.silu(ga)
    q = q.reshape(B, S, SB_HEADS, HEAD_DIM)
    k = k.reshape(B, S, SB_HEADS, HEAD_DIM)
    v = v.reshape(B, S, SB_HEADS, HEAD_DIM)
    ob = stick_breaking_attention(q, k, v).reshape(B, S, SB_WIDTH) * jax.nn.silu(gb)
    return jnp.concatenate([oa, ob], axis=-1) @ w_out


def odd_mixer(h, positions, w_in, lq1, lk1, lq2, lk2, subln_g, w_out, lambda_init):
    B, S, _ = h.shape
    y = h @ w_in
    q, k, v, g = jnp.split(y, [DIFF_QK, 2 * DIFF_QK, 2 * DIFF_QK + DIFF_V], axis=-1)
    q = rope(q.reshape(B, S, 2 * DIFF_HEADS, HEAD_DIM), positions).reshape(B, S, DIFF_HEADS, 2, HEAD_DIM)
    k = rope(k.reshape(B, S, 2 * DIFF_HEADS, HEAD_DIM), positions).reshape(B, S, DIFF_HEADS, 2, HEAD_DIM)
    v = v.reshape(B, S, DIFF_HEADS, 2 * HEAD_DIM)
    lam = (jnp.exp(jnp.sum(lq1.astype(jnp.float32) * lk1.astype(jnp.float32)))
           - jnp.exp(jnp.sum(lq2.astype(jnp.float32) * lk2.astype(jnp.float32))) + lambda_init)
    o = differential_attention(q[:, :, :, 0], q[:, :, :, 1], k[:, :, :, 0], k[:, :, :, 1], v, lam)
    o = rmsnorm(o, subln_g) * (1.0 - lambda_init)
    o = o.reshape(B, S, ODD_MIX) * jax.nn.silu(g)
    return o @ w_out


def setup_inputs(seed: int = 0) -> dict:
    key = jax.random.key(seed)
    n_even = (DEPTH + 1) // 2
    n_odd = DEPTH // 2
    ks = jax.random.split(key, 24)

    def nrm(k, shape, scale):
        return scale * jax.random.normal(k, shape, jnp.float32)

    x = nrm(ks[0], (BATCH, SEQ, D_MODEL), 1.0)
    p = nrm(ks[1], (DEPTH, BATCH, SEQ, PLE_DIM), 1.0)
    positions = jnp.broadcast_to(jnp.arange(SEQ, dtype=jnp.int32), (BATCH, SEQ))
    norm_mix = 1.0 + nrm(ks[2], (DEPTH, D_MODEL), 0.02)
    norm_ple = 1.0 + nrm(ks[3], (DEPTH, D_MODEL), 0.02)
    w_ple_gate = nrm(ks[4], (DEPTH, D_MODEL, D_MODEL), D_MODEL ** -0.5)
    w_ple_proj = nrm(ks[5], (DEPTH, PLE_DIM, D_MODEL), 0.5 * PLE_DIM ** -0.5)
    w_in_e = nrm(ks[6], (n_even, D_MODEL, EVEN_IN), D_MODEL ** -0.5)
    conv_w = nrm(ks[7], (n_even, CONV_WIDTH, LRU_WIDTH), CONV_WIDTH ** -0.5)
    conv_b = nrm(ks[8], (n_even, LRU_WIDTH), 0.02)
    lru_wa = nrm(ks[9], (n_even, LRU_BLOCKS, LRU_BLOCK, LRU_BLOCK), LRU_BLOCK ** -0.5)
    lru_ba = nrm(ks[10], (n_even, LRU_WIDTH), 0.1)
    lru_wx = nrm(ks[11], (n_even, LRU_BLOCKS, LRU_BLOCK, LRU_BLOCK), LRU_BLOCK ** -0.5)
    lru_bx = nrm(ks[12], (n_even, LRU_WIDTH), 0.1)
    u = jax.random.uniform(ks[13], (n_even, LRU_WIDTH), jnp.float32, minval=0.9, maxval=0.999)
    a0 = u ** (1.0 / LRU_C)
    lru_lambda = jnp.log(a0) - jnp.log1p(-a0)
    w_out_e = nrm(ks[14], (n_even, EVEN_MIX, D_MODEL), EVEN_MIX ** -0.5)
    w_in_o = nrm(ks[15], (n_odd, D_MODEL, ODD_IN), D_MODEL ** -0.5)
    lam_q1 = nrm(ks[16], (n_odd, HEAD_DIM), 0.1)
    lam_k1 = nrm(ks[17], (n_odd, HEAD_DIM), 0.1)
    lam_q2 = nrm(ks[18], (n_odd, HEAD_DIM), 0.1)
    lam_k2 = nrm(ks[19], (n_odd, HEAD_DIM), 0.1)
    subln_g = 1.0 + nrm(ks[20], (n_odd, 2 * HEAD_DIM), 0.02)
    w_out_o = nrm(ks[21], (n_odd, ODD_MIX, D_MODEL), ODD_MIX ** -0.5)
    final_norm = 1.0 + nrm(ks[22], (D_MODEL,), 0.02)
    return {'x': x, 'p': p, 'positions': positions, 'norm_mix': norm_mix, 'norm_ple': norm_ple,
            'w_ple_gate': w_ple_gate, 'w_ple_proj': w_ple_proj, 'w_in_e': w_in_e,
            'conv_w': conv_w, 'conv_b': conv_b, 'lru_wa': lru_wa, 'lru_ba': lru_ba,
            'lru_wx': lru_wx, 'lru_bx': lru_bx, 'lru_lambda': lru_lambda, 'w_out_e': w_out_e,
            'w_in_o': w_in_o, 'lam_q1': lam_q1, 'lam_k1': lam_k1, 'lam_q2': lam_q2,
            'lam_k2': lam_k2, 'subln_g': subln_g, 'w_out_o': w_out_o, 'final_norm': final_norm}


def reference(x, p, positions, norm_mix, norm_ple, w_ple_gate, w_ple_proj, w_in_e,
              conv_w, conv_b, lru_wa, lru_ba, lru_wx, lru_bx, lru_lambda, w_out_e,
              w_in_o, lam_q1, lam_k1, lam_q2, lam_k2, subln_g, w_out_o, final_norm):
    h = x
    for i in range(DEPTH):
        j = i // 2
        hn = rmsnorm(h, norm_mix[i])
        if i % 2 == 0:
            mix = even_mixer(hn, w_in_e[j], conv_w[j], conv_b[j], lru_wa[j], lru_ba[j],
                             lru_wx[j], lru_bx[j], lru_lambda[j], w_out_e[j])
        else:
            lambda_init = 0.8 - 0.6 * math.exp(-0.3 * i)
            mix = odd_mixer(hn, positions, w_in_o[j], lam_q1[j], lam_k1[j], lam_q2[j],
                            lam_k2[j], subln_g[j], w_out_o[j], lambda_init)
        h = h + mix
        gate = jax.nn.sigmoid(rmsnorm(h, norm_ple[i]) @ w_ple_gate[i])
        h = h + gate * (p[i] @ w_ple_proj[i])
    return rmsnorm(h, final_norm)
```

```cpp
#include <hip/hip_runtime.h>
#include <hip/hip_cooperative_groups.h>
#include <cstdio>
#include <cstdint>
#include <cmath>
namespace pg8 {
#define PG8_LAS __attribute__((address_space(3)))
typedef unsigned short bf16_t;
typedef short bf16x8 __attribute__((ext_vector_type(8)));
typedef float f32x4 __attribute__((ext_vector_type(4)));
typedef unsigned u32x4 __attribute__((ext_vector_type(4)));
constexpr int BM = 256, BK = 64, HALF = 128, HTB = HALF * BK * 2  , STAGE_BYTES = 8 * HTB, NXCD = 8, WGM = 8;

__host__ __device__ __forceinline__ int lds_byte(int r, int c) { const int st = (r >> 4) * 2 + (c >> 5), rr = r & 15, cc = c & 31, ob = rr * 64 + cc * 2; return st * 1024 + (ob ^ (((ob >> 9) & 1) << 5)); }
__host__ __device__ __forceinline__ void stage_rc(int b, int& R, int& C) { const int st = b / 1024, sb = b % 1024, swz = sb ^ (((sb >> 9) & 1) << 5); R = (st >> 1) * 16 + swz / 64; C = (st & 1) * 32 + (swz % 64) / 2; }
__host__ __device__ __forceinline__ int perm32(int rho) { const int n = rho >> 4, i = rho & 15; return 8 * (i >> 2) + 4 * n + (i & 3); }

struct Unit { int pm, pn; };
struct Gemm { const bf16_t* A; const bf16_t* Bt; int M, N, K; };

struct StaticOrder {
    int nM, nN, nwg, G, c;
    __host__ __device__ void init(int M, int N, int G_, int c_) { nM = M / BM; nN = N / BM; nwg = nM * nN; G = G_; c = c_; }
    __host__ __device__ bool next(int i, Unit& u) const {
        const long L = (long)i * G + c; if (L >= nwg) return false;
        int wgid = (int)L; { const int q = nwg / NXCD, r = nwg % NXCD, xcd = wgid % NXCD, off = wgid / NXCD; wgid = (xcd < r ? xcd * (q + 1) : r * (q + 1) + (xcd - r) * q) + off; }
        const int nig = WGM * nN, gid = wgid / nig, fm = gid * WGM, gsz = (nM - fm) < WGM ? (nM - fm) : WGM;
        u.pm = fm + ((wgid % nig) % gsz); u.pn = (wgid % nig) / gsz; return true;
    }
    __device__ __forceinline__ void a_ready(const Unit&) const {}
    __device__ __forceinline__ void done(const Unit&) const {}
};

__device__ __forceinline__ unsigned cvt_pk_bf16(float lo, float hi) { unsigned r; asm volatile("v_cvt_pk_bf16_f32 %0, %1, %2" : "=v"(r) : "v"(lo), "v"(hi)); return r; }
__device__ __forceinline__ float bf2f(unsigned short u) { return __uint_as_float((unsigned)u << 16); }
__device__ __forceinline__ u32x4 pack8(const f32x4& v0, const f32x4& v1) { u32x4 w; w.x = cvt_pk_bf16(v0[0], v0[1]); w.y = cvt_pk_bf16(v0[2], v0[3]); w.z = cvt_pk_bf16(v1[0], v1[1]); w.w = cvt_pk_bf16(v1[2], v1[3]); return w; }
constexpr float RMS_EPS = 1e-6f;
typedef unsigned long long ss_t;
__device__ __forceinline__ float ss_rstd(ss_t v) { return __builtin_amdgcn_rsqf((float)v * (2.3283064365386963e-10f / 1024.0f) + RMS_EPS); }
__device__ __forceinline__ void ss_add(ss_t* p, float sq) { atomicAdd(p, (ss_t)(sq * 4294967296.0f)); }

struct EpiY {
    static constexpr bool PERM = true, AFTER_DRAIN = false;
    bf16_t* O; int ldc; const ss_t* ss; const float* rope; int rope_pn;
    __device__ __forceinline__ void operator()(const f32x4 (&acc)[2][2][4][2], const Unit& u, int wr, int wc, int fr, int fq) const {
        asm volatile("" : "+v"(fr), "+v"(fq));
        const int row0 = u.pm * BM + wr * 64 + fr, col0 = u.pn * BM + wc * 32 + 8 * fq;
        const bool do_rope = u.pn < rope_pn;
#pragma unroll
        for (int ai = 0; ai < 2; ++ai)
#pragma unroll
            for (int m = 0; m < 4; ++m) {
                const int row = row0 + ai * HALF + m * 16;
                const float rstd = ss_rstd(ss[row]);
                f32x4 cs0 = {1.f, 0.f, 1.f, 0.f}, cs1 = {1.f, 0.f, 1.f, 0.f};
                if (do_rope) { const float* rp = rope + (size_t)row * 64 + ((wc & 1) * 16 + 4 * fq) * 2; cs0 = *(const f32x4*)rp; cs1 = *(const f32x4*)(rp + 4); }
                bf16_t* rowp = O + (size_t)row * ldc + col0;
#pragma unroll
                for (int bj = 0; bj < 2; ++bj) {
                    f32x4 v0 = acc[ai][bj][m][0] * rstd, v1 = acc[ai][bj][m][1] * rstd;
                    if (do_rope) {
                        const f32x4 c = {cs0[0], cs0[2], cs1[0], cs1[2]}, s = {cs0[1], cs0[3], cs1[1], cs1[3]};
                        const f32x4 o0 = v0 * c - v1 * s, o1 = v1 * c + v0 * s; v0 = o0; v1 = o1;
                    }
                    *(u32x4*)(rowp + bj * HALF) = pack8(v0, v1);
                }
                if (do_rope && (m & 1)) asm volatile("" ::: "memory");
            }
    }
};
struct EpiVt {
    static constexpr bool PERM = true, AFTER_DRAIN = false;
    bf16_t* O; int dvs; const ss_t* ss;
    __device__ __forceinline__ void operator()(const f32x4 (&acc)[2][2][4][2], const Unit& u, int wr, int wc, int fr, int fq) const {
        asm volatile("" : "+v"(fr), "+v"(fq));
        const int row0 = u.pm * BM + wr * 64 + fr, col0 = u.pn * BM + wc * 32 + 8 * fq;
        f32x4 r0[2], r1[2];
#pragma unroll
        for (int bj = 0; bj < 2; ++bj) {
#pragma unroll
            for (int i = 0; i < 4; ++i) { r0[bj][i] = ss_rstd(ss[col0 + bj * HALF + i]); r1[bj][i] = ss_rstd(ss[col0 + bj * HALF + 4 + i]); }
        }
#pragma unroll
        for (int ai = 0; ai < 2; ++ai)
#pragma unroll
            for (int m = 0; m < 4; ++m) {
                const int c = row0 + ai * HALF + m * 16, hh = c >> dvs, d = c & ((1 << dvs) - 1);
#pragma unroll
                for (int bj = 0; bj < 2; ++bj) { const int tok = col0 + bj * HALF, b = tok >> 12, s = tok & 4095;
                    *(u32x4*)(O + ((((size_t)(b * 8 + hh) * 64 + (s >> 6)) << dvs) + d) * 64 + (s & 63)) = pack8(acc[ai][bj][m][0] * r0[bj], acc[ai][bj][m][1] * r1[bj]); }
            }
    }
};
struct EpiPlain {
    static constexpr bool PERM = true, AFTER_DRAIN = false;
    bf16_t* O; int ldc;
    __device__ __forceinline__ void operator()(const f32x4 (&acc)[2][2][4][2], const Unit& u, int wr, int wc, int fr, int fq) const {
        asm volatile("" : "+v"(fr), "+v"(fq));
        const int row0 = u.pm * BM + wr * 64 + fr, col0 = u.pn * BM + wc * 32 + 8 * fq;
#pragma unroll
        for (int ai = 0; ai < 2; ++ai)
#pragma unroll
            for (int m = 0; m < 4; ++m) {
                bf16_t* rowp = O + (size_t)(row0 + ai * HALF + m * 16) * ldc + col0;
#pragma unroll
                for (int bj = 0; bj < 2; ++bj) *(u32x4*)(rowp + bj * HALF) = pack8(acc[ai][bj][m][0], acc[ai][bj][m][1]);
            }
    }
};
struct EpiRes {
    static constexpr bool PERM = true, AFTER_DRAIN = false;
    const float* base; float* out; bf16_t* hb; ss_t* ssacc;
    __device__ __forceinline__ void operator()(const f32x4 (&acc)[2][2][4][2], const Unit& u, int wr, int wc, int fr, int fq) const {
        asm volatile("" : "+v"(fr), "+v"(fq));
        const int row0 = u.pm * BM + wr * 64 + fr, col0 = u.pn * BM + wc * 32 + 8 * fq;
#pragma unroll
        for (int ai = 0; ai < 2; ++ai)
#pragma unroll
            for (int m = 0; m < 4; ++m) {
                const int row = row0 + ai * HALF + m * 16; float sq = 0.f;
#pragma unroll
                for (int bj = 0; bj < 2; ++bj) {
                    const size_t off = (size_t)row * 1024 + col0 + bj * HALF;
                    const f32x4 v0 = *(const f32x4*)(base + off) + acc[ai][bj][m][0], v1 = *(const f32x4*)(base + off + 4) + acc[ai][bj][m][1];
                    *(u32x4*)(hb + off) = pack8(v0, v1);
                    sq += (v0[0] * v0[0] + v0[1] * v0[1]) + (v0[2] * v0[2] + v0[3] * v0[3]) + (v1[0] * v1[0] + v1[1] * v1[1]) + (v1[2] * v1[2] + v1[3] * v1[3]);
                }
                sq += __shfl_xor(sq, 16); sq += __shfl_xor(sq, 32);
                if (fq == 0) ss_add(ssacc + row, sq);
                if (m & 1) asm volatile("" ::: "memory");
            }
    }
};
struct EpiGate {
    static constexpr bool PERM = true, AFTER_DRAIN = false;
    const ss_t* ss; const bf16_t* h1b; float* h; const bf16_t* pp; bf16_t* hb; ss_t* ssacc;
    __device__ __forceinline__ void operator()(const f32x4 (&acc)[2][2][4][2], const Unit& u, int wr, int wc, int fr, int fq) const {
        asm volatile("" : "+v"(fr), "+v"(fq));
        const int row0 = u.pm * BM + wr * 64 + fr, col0 = u.pn * BM + wc * 32 + 8 * fq;
#pragma unroll
        for (int ai = 0; ai < 2; ++ai)
#pragma unroll
            for (int m = 0; m < 4; ++m) {
                const int row = row0 + ai * HALF + m * 16; float sq = 0.f;
                const float rstd = ss_rstd(ss[row]) * -1.4426950408889634f;
#pragma unroll
                for (int bj = 0; bj < 2; ++bj) {
                    const size_t off = (size_t)row * 1024 + col0 + bj * HALF;
                    const u32x4 pw = *(const u32x4*)(pp + off);
                    const f32x4 p0 = {__uint_as_float(pw.x << 16), __uint_as_float(pw.x & 0xffff0000u), __uint_as_float(pw.y << 16), __uint_as_float(pw.y & 0xffff0000u)};
                    const f32x4 p1 = {__uint_as_float(pw.z << 16), __uint_as_float(pw.z & 0xffff0000u), __uint_as_float(pw.w << 16), __uint_as_float(pw.w & 0xffff0000u)};
                    f32x4 g0, g1;
#pragma unroll
                    for (int i = 0; i < 4; ++i) { g0[i] = __builtin_amdgcn_rcpf(1.0f + __builtin_amdgcn_exp2f(acc[ai][bj][m][0][i] * rstd)); g1[i] = __builtin_amdgcn_rcpf(1.0f + __builtin_amdgcn_exp2f(acc[ai][bj][m][1][i] * rstd)); }
                    const u32x4 hw = *(const u32x4*)(h1b + off);
                    const f32x4 h0 = {__uint_as_float(hw.x << 16), __uint_as_float(hw.x & 0xffff0000u), __uint_as_float(hw.y << 16), __uint_as_float(hw.y & 0xffff0000u)};
                    const f32x4 h1 = {__uint_as_float(hw.z << 16), __uint_as_float(hw.z & 0xffff0000u), __uint_as_float(hw.w << 16), __uint_as_float(hw.w & 0xffff0000u)};
                    const f32x4 v0 = h0 + g0 * p0, v1 = h1 + g1 * p1;
                    *(f32x4*)(h + off) = v0; *(f32x4*)(h + off + 4) = v1; *(u32x4*)(hb + off) = pack8(v0, v1);
                    sq += (v0[0] * v0[0] + v0[1] * v0[1]) + (v0[2] * v0[2] + v0[3] * v0[3]) + (v1[0] * v1[0] + v1[1] * v1[1]) + (v1[2] * v1[2] + v1[3] * v1[3]);
                }
                sq += __shfl_xor(sq, 16); sq += __shfl_xor(sq, 32);
                if (fq == 0) ss_add(ssacc + row, sq);
                if (m & 1) asm volatile("" ::: "memory");
            }
    }
};
template <class Epi, class Sched, bool ALIGN_EPI = false, bool SP2 = false>
__device__ __forceinline__ void gemm_phase(PG8_LAS unsigned char* lds, const Gemm g, const Sched& S, const Epi& E) {
    int tid_ = threadIdx.x; asm volatile("" : "+v"(tid_));
    const int tid = tid_, wid = __builtin_amdgcn_readfirstlane(tid >> 6), lane = tid & 63, wr = wid >> 2, wc = wid & 3, fr = lane & 15, fq = lane >> 4;
    const int K = g.K, nt = K / BK;
    unsigned voffA[2], voffB[2];
#pragma unroll
    for (int i = 0; i < 2; ++i) { int R, C; stage_rc(tid * 16 + i * 8192, R, C); const int Rb = Epi::PERM ? ((R & ~31) + perm32(R & 31)) : R;
        voffA[i] = (unsigned)(R * K + C) * 2u; voffB[i] = (unsigned)(Rb * K + C) * 2u; }
    const size_t kstep = (size_t)(BK * 2);
    const size_t hstep = (size_t)HALF * K * 2;
    const size_t tstep = 2 * hstep;
    const unsigned ldsw = (unsigned)wid * 1024u;
    const int aoff = lds_byte(wr * 64 + fr, fq * 8), boff = lds_byte(wc * 32 + fr, fq * 8);
#define PG8_SA(b, h) (((b) * 2 + (h)) * HTB)
#define PG8_SB(b, h) ((4 + (b) * 2 + (h)) * HTB)
#define PG8_STAGE(bufoff, gbase, voff) do { _Pragma("unroll") for (int _i = 0; _i < 2; ++_i) \
        __builtin_amdgcn_global_load_lds((const unsigned*)((const char*)(gbase) + (voff)[_i]), (PG8_LAS unsigned*)(lds + (bufoff) + ldsw + _i * 8192), 16, 0, 0); } while (0)
#define PG8_LDA(dst, b, h) do { _Pragma("unroll") for (int m = 0; m < 4; ++m) _Pragma("unroll") for (int k = 0; k < 2; ++k) dst[m][k] = *(const PG8_LAS bf16x8*)(lds + PG8_SA(b, h) + aoff + m * 2048 + k * 1024); } while (0)
#define PG8_LDB(dst, b, h) do { _Pragma("unroll") for (int n = 0; n < 2; ++n) _Pragma("unroll") for (int k = 0; k < 2; ++k) dst[n][k] = *(const PG8_LAS bf16x8*)(lds + PG8_SB(b, h) + boff + n * 2048 + k * 1024); } while (0)
#define PG8_MMA(ai, bj, At, Bt) do { __builtin_amdgcn_s_setprio(1); _Pragma("unroll") for (int m = 0; m < 4; ++m) _Pragma("unroll") for (int n = 0; n < 2; ++n) _Pragma("unroll") for (int k = 0; k < 2; ++k) \
        acc[ai][bj][m][n] = __builtin_amdgcn_mfma_f32_16x16x32_bf16(Bt[n][k], At[m][k], acc[ai][bj][m][n], 0, 0, 0); __builtin_amdgcn_s_setprio(0); } while (0)
#define PG8_WAIT_V(n) asm volatile("s_waitcnt vmcnt(" #n ")" ::: "memory")
#define PG8_WAIT_L(n) asm volatile("s_waitcnt lgkmcnt(" #n ")" ::: "memory")
#define PG8_BAR __builtin_amdgcn_s_barrier()
#define PG8_SCHED __builtin_amdgcn_sched_barrier(0)
    Unit cur, nxt; int ui = 0;
    if (!S.next(0, cur)) return;
    f32x4 acc[2][2][4][2];
#pragma unroll
    for (int a = 0; a < 2; ++a)
#pragma unroll
        for (int b = 0; b < 2; ++b)
#pragma unroll
            for (int m = 0; m < 4; ++m)
#pragma unroll
                for (int n = 0; n < 2; ++n) acc[a][b][m][n] = (f32x4){0.f, 0.f, 0.f, 0.f};
    bf16x8 At[4][2], B0[2][2], B1[2][2];
    const char* cA = (const char*)g.A + (size_t)cur.pm * tstep; const char* cB = (const char*)g.Bt + (size_t)cur.pn * tstep;
    S.a_ready(cur);
    if constexpr (SP2) {
        PG8_STAGE(PG8_SB(0, 0), cB, voffB); PG8_STAGE(PG8_SB(0, 1), cB + hstep, voffB); PG8_STAGE(PG8_SA(0, 0), cA, voffA); PG8_STAGE(PG8_SA(0, 1), cA + hstep, voffA);
        if (wr == 1) PG8_BAR;
        PG8_WAIT_V(2); PG8_BAR;
        PG8_STAGE(PG8_SB(1, 0), cB + kstep, voffB); PG8_STAGE(PG8_SA(1, 0), cA + kstep, voffA); PG8_STAGE(PG8_SB(1, 1), cB + hstep + kstep, voffB);
        PG8_WAIT_V(6); PG8_BAR;
    } else {
        PG8_STAGE(PG8_SB(0, 0), cB, voffB); PG8_STAGE(PG8_SA(0, 0), cA, voffA); PG8_STAGE(PG8_SB(0, 1), cB + hstep, voffB); PG8_STAGE(PG8_SA(0, 1), cA + hstep, voffA);
        if (wr == 1) PG8_BAR;
        PG8_WAIT_V(4); PG8_BAR;
        PG8_STAGE(PG8_SB(1, 0), cB + kstep, voffB); PG8_STAGE(PG8_SA(1, 0), cA + kstep, voffA); PG8_STAGE(PG8_SB(1, 1), cB + hstep + kstep, voffB);
        PG8_WAIT_V(6); PG8_BAR;
    }
    for (;;) {
        const bool has_next = S.next(ui + 1, nxt);
        const char* nA = has_next ? (const char*)g.A + (size_t)nxt.pm * tstep : cA; const char* nB = has_next ? (const char*)g.Bt + (size_t)nxt.pn * tstep : cB;
        for (int t = 0; t < nt; t += 2) {
            const bool last = (t == nt - 2);
            const char* a1 = cA + (size_t)(t + 1) * kstep;
            const char* a2 = last ? nA : cA + (size_t)(t + 2) * kstep; const char* b2 = last ? nB : cB + (size_t)(t + 2) * kstep;
            const char* a3 = a2 + kstep; const char* b3 = b2 + kstep;
            if (last && has_next) S.a_ready(nxt);
            if constexpr (SP2) {
            PG8_LDB(B0, 0, 0); PG8_LDB(B1, 0, 1); PG8_SCHED; PG8_LDA(At, 0, 0); PG8_STAGE(PG8_SA(1, 1), a1 + hstep, voffA);
            PG8_WAIT_V(8); PG8_WAIT_L(0); PG8_BAR; PG8_MMA(0, 0, At, B0); PG8_MMA(0, 1, At, B1); PG8_BAR; PG8_SCHED;
            PG8_LDA(At, 0, 1); PG8_STAGE(PG8_SB(0, 0), b2, voffB); PG8_STAGE(PG8_SB(0, 1), b2 + hstep, voffB); PG8_STAGE(PG8_SA(0, 0), a2, voffA);
            PG8_WAIT_V(8); PG8_WAIT_L(0); PG8_BAR; PG8_MMA(1, 0, At, B0); PG8_MMA(1, 1, At, B1); PG8_BAR; PG8_SCHED;
            PG8_LDB(B0, 1, 0); PG8_LDB(B1, 1, 1); PG8_SCHED; PG8_LDA(At, 1, 0); PG8_STAGE(PG8_SA(0, 1), a2 + hstep, voffA);
            PG8_WAIT_V(8); PG8_WAIT_L(0); PG8_BAR; PG8_MMA(0, 0, At, B0); PG8_MMA(0, 1, At, B1); PG8_BAR; PG8_SCHED;
            PG8_LDA(At, 1, 1); PG8_STAGE(PG8_SB(1, 0), b3, voffB); PG8_STAGE(PG8_SB(1, 1), b3 + hstep, voffB); PG8_STAGE(PG8_SA(1, 0), a3, voffA);
            PG8_WAIT_V(8); PG8_WAIT_L(0); PG8_BAR; PG8_MMA(1, 0, At, B0); PG8_MMA(1, 1, At, B1); PG8_BAR; PG8_SCHED;
            } else {
            PG8_LDB(B0, 0, 0); PG8_SCHED; PG8_LDA(At, 0, 0); PG8_STAGE(PG8_SA(1, 1), a1 + hstep, voffA);
            PG8_WAIT_L(8); PG8_BAR; PG8_WAIT_L(0); PG8_MMA(0, 0, At, B0); PG8_BAR; PG8_SCHED;
            PG8_LDB(B1, 0, 1); PG8_STAGE(PG8_SB(0, 0), b2, voffB);
            PG8_BAR; PG8_WAIT_L(0); PG8_MMA(0, 1, At, B1); PG8_BAR;
            PG8_LDA(At, 0, 1); PG8_STAGE(PG8_SA(0, 0), a2, voffA);
            PG8_BAR; PG8_WAIT_L(0); PG8_MMA(1, 0, At, B0); PG8_BAR; PG8_SCHED;
            PG8_STAGE(PG8_SB(0, 1), b2 + hstep, voffB);
            PG8_WAIT_V(6); PG8_BAR; PG8_MMA(1, 1, At, B1); PG8_BAR;
            PG8_LDB(B0, 1, 0); PG8_SCHED; PG8_LDA(At, 1, 0); PG8_STAGE(PG8_SA(0, 1), a2 + hstep, voffA);
            PG8_WAIT_L(8); PG8_BAR; PG8_WAIT_L(0); PG8_MMA(0, 0, At, B0); PG8_BAR; PG8_SCHED;
            PG8_LDB(B1, 1, 1); PG8_STAGE(PG8_SB(1, 0), b3, voffB);
            PG8_BAR; PG8_WAIT_L(0); PG8_MMA(0, 1, At, B1); PG8_BAR;
            PG8_LDA(At, 1, 1); PG8_STAGE(PG8_SA(1, 0), a3, voffA);
            PG8_BAR; PG8_WAIT_L(0); PG8_MMA(1, 0, At, B0); PG8_BAR; PG8_SCHED;
            PG8_STAGE(PG8_SB(1, 1), b3 + hstep, voffB);
            PG8_WAIT_V(6); PG8_BAR; PG8_MMA(1, 1, At, B1); PG8_BAR;
            }
        }
        if constexpr (ALIGN_EPI) { if (wr == 0) PG8_BAR; }
        if constexpr (!Epi::AFTER_DRAIN) { E(acc, cur, wr, wc, fr, fq); S.done(cur); }
        if (!has_next) break;
#pragma unroll
        for (int a = 0; a < 2; ++a)
#pragma unroll
            for (int b = 0; b < 2; ++b)
#pragma unroll
                for (int m = 0; m < 4; ++m)
#pragma unroll
                    for (int n = 0; n < 2; ++n) acc[a][b][m][n] = (f32x4){0.f, 0.f, 0.f, 0.f};
        cur = nxt; cA = nA; cB = nB; ++ui;
        if constexpr (ALIGN_EPI) { if (wr == 1) PG8_BAR; }
    }
    PG8_WAIT_V(0);
    if constexpr (!ALIGN_EPI) { if (wr == 0) PG8_BAR; }
    PG8_BAR;
    if constexpr (Epi::AFTER_DRAIN) { E.fused(acc, cur, wr, wc, fr, fq, lds, wid, lane); S.done(cur); }
#undef PG8_SA
#undef PG8_SB
#undef PG8_STAGE
#undef PG8_LDA
#undef PG8_LDB
#undef PG8_MMA
#undef PG8_WAIT_V
#undef PG8_WAIT_L
#undef PG8_BAR
#undef PG8_SCHED
}
}

namespace cg = cooperative_groups;
#define LAS __attribute__((address_space(3)))
typedef unsigned short bf16;
typedef short bf16x8 __attribute__((ext_vector_type(8)));
typedef float f32x4 __attribute__((ext_vector_type(4)));
typedef float f32x16 __attribute__((ext_vector_type(16)));
typedef unsigned u32x4 __attribute__((ext_vector_type(4)));

constexpr int NB = 8, SEQ = 4096, DM = 1024, MT = NB * SEQ;
constexpr int LDY_E = 2560, LDY_O = 3072;
constexpr float QSCALE = 0.125f * 1.4426950408889634f;
constexpr size_t MiB = 1u << 20;
constexpr size_t WS_SS = 5 * MiB + 512 * 1024;
constexpr size_t WS_SUM = 3 * MiB;
constexpr size_t WS_LRUW = 5 * MiB;
constexpr size_t WS_ROPE = 8 * MiB;
constexpr size_t WS_WINE = 16 * MiB;
constexpr size_t WS_WINO = 28 * MiB;
constexpr size_t WS_WOUT = 44 * MiB;
constexpr size_t WS_WG = 52 * MiB;
constexpr size_t WS_WP = 60 * MiB;
constexpr size_t WS_PB = 64 * MiB;
constexpr size_t WS_HB0 = 80 * MiB;
constexpr size_t WS_OMIX = 144 * MiB;
constexpr size_t WS_Y = 208 * MiB;
constexpr size_t WS_PP = WS_Y, WS_HB1 = WS_Y + 64 * MiB;
constexpr size_t WS_VT = 400 * MiB;
constexpr size_t WS_END = 464 * MiB;
constexpr int LDS_BYTES = 147456;
constexpr int NTHREADS = 512;

struct Params {
    const float* x; const float* p; const int* pos; const float* norm_mix; const float* norm_ple; const float* w_ple_gate; const float* w_ple_proj;
    const float* w_in_e; const float* conv_w; const float* conv_b; const float* lru_wa; const float* lru_ba; const float* lru_wx; const float* lru_bx; const float* lru_lambda; const float* w_out_e;
    const float* w_in_o; const float* lq1; const float* lk1; const float* lq2; const float* lk2; const float* subln_g; const float* w_out_o; const float* final_norm;
    float* out; unsigned char* ws;
    float lam_init[2]; float pad[2];
};

typedef const __attribute__((address_space(4))) Params* KPtr;
#define KP_GET() ({ KPtr kp_ = (KPtr)__builtin_amdgcn_kernarg_segment_ptr(); asm volatile("" : "+s"(kp_)); kp_; })
__device__ const float INV_FREQ[32] = {1.000000000e+00f, 7.498942018e-01f, 5.623413324e-01f, 4.216965139e-01f, 3.162277639e-01f, 2.371373773e-01f, 1.778279394e-01f, 1.333521456e-01f, 1.000000015e-01f, 7.498942316e-02f, 5.623413250e-02f, 4.216964915e-02f, 3.162277490e-02f, 2.371373773e-02f, 1.778279431e-02f, 1.333521400e-02f, 9.999999776e-03f, 7.498942316e-03f, 5.623413250e-03f, 4.216964822e-03f, 3.162277630e-03f, 2.371373819e-03f, 1.778279431e-03f, 1.333521446e-03f, 1.000000047e-03f, 7.498941850e-04f, 5.623413017e-04f, 4.216965172e-04f, 3.162277571e-04f, 2.371373703e-04f, 1.778279402e-04f, 1.333521504e-04f};
__device__ __forceinline__ float bf2f(bf16 u) { return __uint_as_float((unsigned)u << 16); }
typedef float f32x2_t __attribute__((ext_vector_type(2))); typedef __bf16 bf16x2_t __attribute__((ext_vector_type(2)));
__device__ __forceinline__ unsigned cvtpk(float lo, float hi) { f32x2_t v = {lo, hi}; bf16x2_t b = __builtin_convertvector(v, bf16x2_t); return __builtin_bit_cast(unsigned, b); }
__device__ __forceinline__ bf16 f2bf(float f) { return (bf16)(cvtpk(f, 0.f) & 0xffffu); }
__device__ __forceinline__ float wave_sum(float v) {
#pragma unroll
    for (int o = 1; o < 64; o <<= 1) v += __shfl_xor(v, o);
    return v;
}
__device__ __forceinline__ int crow(int r, int hi) { return (r & 3) + 8 * (r >> 2) + 4 * hi; }
#define GLDS16(gptr, ldsptr) __builtin_amdgcn_global_load_lds((const unsigned*)(gptr), (LAS unsigned*)(ldsptr), 16, 0, 0)
#define MFMA32(a, b, c) __builtin_amdgcn_mfma_f32_32x32x16_bf16((a), (b), (c), 0, 0, 0)

__device__ __forceinline__ void colmap(int kind, int np, int& src, float& sc) {
    src = np; sc = 1.f;
    if (kind == 2) {
        if (np >= 1024 && np < 1536) sc = QSCALE;
        else if (np >= 2048 && np < 2560) src = np + 512;
        else if (np >= 2560) src = np - 512;
    } else if (kind == 3) {
        if (np < 2048) { const int head = np >> 6, s = np & 63, w = s >> 5, fq = (s >> 3) & 3, n = (s >> 2) & 1, i = s & 3; src = head * 64 + 16 * w + 4 * fq + i + 32 * n; if (np < 1024) sc = QSCALE; }
        else if (np < 3072) src = np + 1024;
        else src = np - 1024;
    }
}
__device__ __forceinline__ void wt_item(const float* W, int K, int N, bf16* WT, int nrows, int kind, const float* gk, LAS float* scr, int item, int lane) {
    const int nblk = nrows / 32, kb = item / nblk, nb = item % nblk, k0 = 64 * kb, n0 = 32 * nb;
    int src; float sc; colmap(kind, n0 + (lane & 31), src, sc);
#pragma unroll 8
    for (int i = 0; i < 32; ++i) { const int kk = 2 * i + (lane >> 5); const float g = gk ? gk[k0 + kk] : 1.f; scr[kk * 33 + (lane & 31)] = W[(size_t)(k0 + kk) * N + src] * (g * sc); }
    const int c = lane & 7;
#pragma unroll
    for (int j = 0; j < 4; ++j) { const int n = (lane >> 3) + 8 * j; const LAS float* s = scr + (8 * c) * 33 + n;
        u32x4 o; o.x = cvtpk(s[0 * 33], s[1 * 33]); o.y = cvtpk(s[2 * 33], s[3 * 33]); o.z = cvtpk(s[4 * 33], s[5 * 33]); o.w = cvtpk(s[6 * 33], s[7 * 33]);
        *(u32x4*)(WT + (size_t)(n0 + n) * K + k0 + 8 * c) = o; }
}
__device__ __forceinline__ void sincos_acc(float af, float& s, float& c) {
    const double a = (double)af; const double q = rint(a * 0.63661977236758134308); const double r = fma(-q, 1.57079632679489661923, a) - q * 6.123233995736766e-17;
    const double r2 = r * r;
    const double sp = r * (1.0 + r2 * (-1.0 / 6 + r2 * (1.0 / 120 + r2 * (-1.0 / 5040 + r2 * (1.0 / 362880 + r2 * (-1.0 / 39916800 + r2 * (1.0 / 6227020800.0)))))));
    const double cp = 1.0 + r2 * (-0.5 + r2 * (1.0 / 24 + r2 * (-1.0 / 720 + r2 * (1.0 / 40320 + r2 * (-1.0 / 3628800 + r2 * (1.0 / 479001600.0 + r2 * (-1.0 / 87178291200.0)))))));
    const int qi = ((int)q) & 3;
    const double ss = (qi == 0) ? sp : (qi == 1) ? cp : (qi == 2) ? -sp : -cp;
    const double cc = (qi == 0) ? cp : (qi == 1) ? -sp : (qi == 2) ? -cp : sp;
    s = (float)ss; c = (float)cc;
}

__device__ __forceinline__ void prologue(KPtr P, LAS unsigned char* lds, int vcu, int G, int wave, int lane) {
    unsigned char* ws = P->ws;
    LAS float* scr = (LAS float*)(lds + wave * 16384);
    const int gw = vcu * 8 + wave, NGW = G * 8;
    constexpr int I_E = 16 * 96, I_O = 16 * 128, I_S = 16 * 32, I_P = 4 * 32;
    constexpr int I_L = 2 * 16 * 2;
    constexpr int NITEMS = 2 * I_E + 2 * I_O + 4 * I_S + 4 * I_S + 4 * I_P + I_L;
    for (int it = gw; it < NITEMS; it += NGW) {
        int r = it;
        if (r < 2 * I_E) { const int j = r / I_E; wt_item(P->w_in_e + (size_t)j * 1024 * 3072, 1024, 3072, (bf16*)(ws + WS_WINE) + (size_t)j * 3072 * 1024, 3072, 2, P->norm_mix + (2 * j) * 1024, scr, r % I_E, lane); continue; } r -= 2 * I_E;
        if (r < 2 * I_O) { const int j = r / I_O; wt_item(P->w_in_o + (size_t)j * 1024 * 4096, 1024, 4096, (bf16*)(ws + WS_WINO) + (size_t)j * 4096 * 1024, 4096, 3, P->norm_mix + (2 * j + 1) * 1024, scr, r % I_O, lane); continue; } r -= 2 * I_O;
        if (r < 4 * I_S) { const int i = r / I_S; const float* src = (i & 1) ? P->w_out_o + (size_t)(i >> 1) * 1024 * 1024 : P->w_out_e + (size_t)(i >> 1) * 1024 * 1024;
            wt_item(src, 1024, 1024, (bf16*)(ws + WS_WOUT) + (size_t)i * 1024 * 1024, 1024, 0, nullptr, scr, r % I_S, lane); continue; } r -= 4 * I_S;
        if (r < 4 * I_S) { const int i = r / I_S; wt_item(P->w_ple_gate + (size_t)i * 1024 * 1024, 1024, 1024, (bf16*)(ws + WS_WG) + (size_t)i * 1024 * 1024, 1024, 1, P->norm_ple + i * 1024, scr, r % I_S, lane); continue; } r -= 4 * I_S;
        if (r < 4 * I_P) { const int i = r / I_P; wt_item(P->w_ple_proj + (size_t)i * 256 * 1024, 256, 1024, (bf16*)(ws + WS_WP) + (size_t)i * 1024 * 256, 1024, 0, nullptr, scr, r % I_P, lane); continue; } r -= 4 * I_P;
        { const int gate = r >> 5, blk = (r >> 1) & 15; wt_item((gate ? P->lru_wx : P->lru_wa) + (size_t)blk * 4096, 64, 64, (bf16*)(ws + WS_LRUW) + (size_t)(gate * 16 + blk) * 4096, 64, 0, nullptr, scr, r & 1, lane); }
    }
    pg8::ss_t* SS = (pg8::ss_t*)(ws + WS_SS);
    for (int m0 = 4 * gw; m0 < MT; m0 += 4 * NGW) {
        f32x4 v[4][4];
#pragma unroll
        for (int q = 0; q < 4; ++q) { const f32x4* xr = (const f32x4*)(P->x + (size_t)(m0 + q) * DM) + lane;
#pragma unroll
            for (int j = 0; j < 4; ++j) v[q][j] = xr[64 * j]; }
#pragma unroll
        for (int q = 0; q < 4; ++q) { float s = 0.f; unsigned long long* o8 = (unsigned long long*)((bf16*)(ws + WS_HB0) + (size_t)(m0 + q) * DM) + lane;
#pragma unroll
            for (int j = 0; j < 4; ++j) { const f32x4 w = v[q][j]; s += (w.x * w.x + w.y * w.y) + (w.z * w.z + w.w * w.w);
                o8[64 * j] = (unsigned long long)cvtpk(w.x, w.y) | ((unsigned long long)cvtpk(w.z, w.w) << 32); }
            s = wave_sum(s); if (lane == 0) SS[m0 + q] = (pg8::ss_t)(s * 4294967296.0f); }
    }
    { const int gt = gw * 64 + lane, NT = NGW * 64; for (int i = gt; i < 8 * MT; i += NT) SS[MT + i] = 0ull; }
    { const int gt = gw * 64 + lane, NT = NGW * 64; float* R = (float*)(ws + WS_ROPE);
      for (int i = gt; i < MT * 32; i += NT) { const int m = i >> 5, f = i & 31; const float ang = (float)P->pos[m] * INV_FREQ[f]; float s, c; sincos_acc(ang, s, c); R[2 * i] = c; R[2 * i + 1] = s; } }
}
__device__ __forceinline__ void convert_p(KPtr P, unsigned char* wsb, int layer, int vcu, int G, int tid) {
    const f32x4* src = (const f32x4*)(P->p + (size_t)layer * MT * 256); u32x4* dst = (u32x4*)(wsb + WS_PB);
    const int gt = vcu * NTHREADS + tid, NT = G * NTHREADS;
    for (int i = gt; i < MT * 256 / 8; i += NT) { const f32x4 a = src[2 * i], b = src[2 * i + 1]; u32x4 o; o.x = cvtpk(a.x, a.y); o.y = cvtpk(a.z, a.w); o.z = cvtpk(b.x, b.y); o.w = cvtpk(b.z, b.w); dst[i] = o; }
}
__device__ __forceinline__ void final_norm(KPtr P, int vcu, int G, int wave, int lane) {
    const pg8::ss_t* SS = (const pg8::ss_t*)(P->ws + WS_SS) + 8 * (size_t)MT;
    const int gw = vcu * 8 + wave, NGW = G * 8;
    f32x4 g[4];
#pragma unroll
    for (int j = 0; j < 4; ++j) g[j] = ((const f32x4*)P->final_norm)[lane + 64 * j];
    for (int m0 = 4 * gw; m0 < MT; m0 += 4 * NGW) {
        f32x4 v[4][4]; float rs[4];
#pragma unroll
        for (int q = 0; q < 4; ++q) { const f32x4* xr = (const f32x4*)(P->out + (size_t)(m0 + q) * DM) + lane; rs[q] = pg8::ss_rstd(SS[m0 + q]);
#pragma unroll
            for (int j = 0; j < 4; ++j) v[q][j] = xr[64 * j]; }
#pragma unroll
        for (int q = 0; q < 4; ++q) { f32x4* xr = (f32x4*)(P->out + (size_t)(m0 + q) * DM) + lane;
#pragma unroll
            for (int j = 0; j < 4; ++j) xr[64 * j] = v[q][j] * rs[q] * g[j]; }
    }
}

__device__ __forceinline__ int tperm(int i) { return ((i & 4) << 2) | ((i & 16) >> 1) | ((i & 8) >> 1) | (i & 3); }
__device__ __forceinline__ void lru_unit(KPtr P, unsigned char* wsb, int j, int u, int pass, LAS unsigned char* xct, int lane) {
    asm volatile("" : "+v"(lane));
    const int ch = u & 63, n = (u >> 6) & 7, b = u >> 9, c32 = lane & 31, hi = lane >> 5, cg0 = 64 * n + c32;
    const bf16* Y = (const bf16*)(wsb + WS_Y); bf16* OM = (bf16*)(wsb + WS_OMIX);
    float* SA = (float*)(wsb + WS_SUM); float* SH = SA + 8 * 64 * 512;
    const float* cw = P->conv_w + j * 4 * 512;
    float w0[2], w1[2], w2[2], w3[2], cbi[2], ba[2], bx[2], c8[2];
    bf16x8 Ba[2][4], Bx[2][4];
#pragma unroll
    for (int cb = 0; cb < 2; ++cb) {
        const int cgi = cg0 + 32 * cb;
        w0[cb] = cw[cgi]; w1[cb] = cw[512 + cgi]; w2[cb] = cw[1024 + cgi]; w3[cb] = cw[1536 + cgi]; cbi[cb] = P->conv_b[j * 512 + cgi];
        ba[cb] = P->lru_ba[j * 512 + cgi]; bx[cb] = P->lru_bx[j * 512 + cgi];
        const float lam = P->lru_lambda[j * 512 + cgi];
        c8[cb] = 8.0f * (fminf(lam, 0.f) - log1pf(__expf(-fabsf(lam))));
        const bf16* wa = (const bf16*)(wsb + WS_LRUW) + ((size_t)((j * 8 + n) * 64 + c32 + 32 * cb)) * 64 + 8 * hi; const bf16* wx = wa + 16 * 4096;
#pragma unroll
        for (int kk = 0; kk < 4; ++kk) { Ba[cb][kk] = *(const bf16x8*)(wa + 16 * kk); Bx[cb][kk] = *(const bf16x8*)(wx + 16 * kk); }
    }
    const size_t tok0 = (size_t)b * SEQ + ch * 64;
    float hc[2] = {0.f, 0.f}; float Ap[2] = {1.f, 1.f};
    if (pass == 1) {
#pragma unroll
        for (int cb = 0; cb < 2; ++cb) { const float* sa = SA + (size_t)b * 64 * 512 + cg0 + 32 * cb; const float* sh = SH + (size_t)b * 64 * 512 + cg0 + 32 * cb; float h = 0.f;
#pragma unroll 16
            for (int c = 0; c < ch; ++c) h = sa[c * 512] * h + sh[c * 512];
            hc[cb] = h; }
    }
    const int arow = tperm(c32), aswz = (arow >> 1) & 7;
    for (int sub = 0; sub < 2; ++sub) {
        const size_t t0 = tok0 + sub * 32 + 16 * hi;
        const bool first = (ch == 0) && (sub == 0) && (hi == 0);
        f32x16 xc[2];
#pragma unroll
        for (int cb = 0; cb < 2; ++cb) {
            const bf16* yp = Y + t0 * LDY_E + cg0 + 32 * cb;
            float x0 = 0.f, x1 = 0.f, x2 = 0.f;
            if (!first) { x0 = bf2f(*(yp - 3 * (ptrdiff_t)LDY_E)); x1 = bf2f(*(yp - 2 * (ptrdiff_t)LDY_E)); x2 = bf2f(*(yp - (ptrdiff_t)LDY_E)); }
#pragma unroll
            for (int r = 0; r < 16; ++r) { const float xv = bf2f(yp[(size_t)r * LDY_E]); xc[cb][r] = cbi[cb] + w0[cb] * x0 + w1[cb] * x1 + w2[cb] * x2 + w3[cb] * xv; x0 = x1; x1 = x2; x2 = xv; }
#pragma unroll
            for (int r = 0; r < 16; ++r) { const int tt = 16 * hi + r, col = c32 + 32 * cb;
                *(LAS bf16*)(xct + tt * 128 + ((((col >> 3) ^ ((tt >> 1) & 7))) << 4) + (col & 7) * 2) = f2bf(xc[cb][r]); }
        }
        f32x16 pa[2], px[2];
        pa[0] = (f32x16){}; pa[1] = (f32x16){}; px[0] = (f32x16){}; px[1] = (f32x16){};
#pragma unroll
        for (int kk = 0; kk < 4; ++kk) {
            const bf16x8 af = *(const LAS bf16x8*)(xct + arow * 128 + (((2 * kk + hi) ^ aswz) << 4));
            pa[0] = MFMA32(af, Ba[0][kk], pa[0]); pa[1] = MFMA32(af, Ba[1][kk], pa[1]); px[0] = MFMA32(af, Bx[0][kk], px[0]); px[1] = MFMA32(af, Bx[1][kk], px[1]);
        }
        float Al[2], Hl[2];
#pragma unroll
        for (int cb = 0; cb < 2; ++cb) {
            float al = 1.f, hl = 0.f;
#pragma unroll
            for (int r = 0; r < 16; ++r) {
                const float rg = __builtin_amdgcn_rcpf(1.0f + __expf(-(pa[cb][r] + ba[cb]))), ig = __builtin_amdgcn_rcpf(1.0f + __expf(-(px[cb][r] + bx[cb])));
                const float la = c8[cb] * rg, a = __expf(la), x2 = 2.0f * la;
                const float ems = -x2 * (1.0f + x2 * (0.5f + x2 * ((1.0f / 6) + x2 * ((1.0f / 24) + x2 * ((1.0f / 120) + x2 * (1.0f / 720))))));
                const float em = (x2 > -0.5f) ? ems : 1.0f - a * a;
                const float uu = sqrtf(em) * (ig * xc[cb][r]);
                pa[cb][r] = a; px[cb][r] = uu; hl = a * hl + uu; al *= a;
            }
            Al[cb] = al; Hl[cb] = hl;
        }
#pragma unroll
        for (int cb = 0; cb < 2; ++cb) {
            const float oA = __shfl_xor(Al[cb], 32), oH = __shfl_xor(Hl[cb], 32);
            const float hmid = hi ? (oA * hc[cb] + oH) : (Al[cb] * hc[cb] + Hl[cb]);
            const float hin = hi ? hmid : hc[cb];
            const float hend = hi ? (Al[cb] * hmid + Hl[cb]) : (oA * hmid + oH);
            Ap[cb] *= Al[cb] * oA;
            if (pass == 1) {
                const bf16* gp = Y + t0 * LDY_E + 512 + cg0 + 32 * cb; bf16* op = OM + t0 * 1024 + cg0 + 32 * cb;
                float h = hin;
#pragma unroll
                for (int r = 0; r < 16; ++r) { h = pa[cb][r] * h + px[cb][r]; const float g = bf2f(gp[(size_t)r * LDY_E]); op[(size_t)r * 1024] = f2bf(h * g * __builtin_amdgcn_rcpf(1.0f + __expf(-g))); }
            }
            hc[cb] = hend;
        }
    }
    if (pass == 0 && hi == 0) {
#pragma unroll
        for (int cb = 0; cb < 2; ++cb) { SA[((size_t)b * 64 + ch) * 512 + cg0 + 32 * cb] = Ap[cb]; SH[((size_t)b * 64 + ch) * 512 + cg0 + 32 * cb] = hc[cb]; }
    }
}

__device__ __forceinline__ int tile_off(int row, int chunk) { return row * 128 + ((chunk ^ ((row >> 1) & 7)) << 4); }
__device__ __forceinline__ int kperm(int i) { return (i & 0x13) | ((i & 4) << 1) | ((i & 8) >> 1); }

__device__ __forceinline__ void sb_unit(KPtr P, unsigned char* wsb, int b, int h, int qb, LAS unsigned char* lds, int tid, int wave, int lane) {
    const bf16* Y = (const bf16*)(wsb + WS_Y); const bf16* VT = (const bf16*)(wsb + WS_VT); bf16* OM = (bf16*)(wsb + WS_OMIX);
    asm volatile("" : "+v"(lane));
    const int r32 = lane & 31, hi = lane >> 5;
    const size_t rowbase = (size_t)b * SEQ; const int q0 = qb * 256, qw0 = q0 + wave * 32;
    const int srow = wave * 8 + (lane >> 3), sch = (lane & 7) ^ ((srow >> 1) & 7);
    const bf16* kg = Y + (rowbase + srow) * LDY_E + 1536 + h * 64 + sch * 8;
    const bf16* vg = VT + ((size_t)(b * 8 + h) * 64) * 4096 + srow * 64 + sch * 8;
    bf16x8 qr[4];
#pragma unroll
    for (int d0 = 0; d0 < 4; ++d0) qr[d0] = *(const bf16x8*)(Y + (rowbase + qw0 + r32) * LDY_E + 1024 + h * 64 + d0 * 16 + hi * 8);
    const int krow = kperm(r32), kswz = (krow >> 1) & 7, vswz = (r32 >> 1) & 7;
    f32x16 o0 = {}, o1 = {};
    float R = 1.0f;
    const int jmax = (q0 + 255) >> 6;
    GLDS16(kg + (size_t)(jmax * 64) * LDY_E, lds + wave * 1024); GLDS16(vg + (size_t)jmax * 4096, lds + 8192 + wave * 1024);
    LAS unsigned* alive = (LAS unsigned*)(lds + 32768);
    if (tid < 3) alive[tid] = 0u;
    __syncthreads();
    int it = 0, aw = 0; bool walive = true;
    for (int j = jmax; j >= 0; --j, ++it) {
        LAS unsigned char* Kb = lds + (it & 1) * 16384; LAS unsigned char* Vb = Kb + 8192;
        if (j > 0) { LAS unsigned char* Kn = lds + ((it + 1) & 1) * 16384 + wave * 1024; GLDS16(kg + (size_t)((j - 1) * 64) * LDY_E, Kn); GLDS16(vg + (size_t)(j - 1) * 4096, Kn + 8192); }
        const int k0 = j * 64;
        if (k0 < qw0 + 31 && walive) {
            f32x16 p0 = {}, p1 = {};
#pragma unroll
            for (int d0 = 0; d0 < 4; ++d0) {
                const int co = ((2 * d0 + hi) ^ kswz) << 4;
                const bf16x8 a0 = *(const LAS bf16x8*)(Kb + krow * 128 + co), a1 = *(const LAS bf16x8*)(Kb + (krow + 32) * 128 + co);
                p0 = MFMA32(a0, qr[d0], p0); p1 = MFMA32(a1, qr[d0], p1);
            }
            const int tq = qw0 + r32; const bool need_mask = (k0 + 63 >= qw0);
            if (need_mask) {
                asm volatile("" ::: );
#pragma unroll
                for (int r = 0; r < 16; ++r) { const int s = k0 + 16 * (r >> 3) + 8 * hi + (r & 7); if (s >= tq) p0[r] = -INFINITY; if (s + 32 >= tq) p1[r] = -INFINITY; }
            }
            f32x16 b0, b1;
#pragma unroll
            for (int r = 0; r < 16; ++r) {
                { const float om = __builtin_amdgcn_rcpf(1.0f + __builtin_amdgcn_exp2f(p0[r])); p0[r] = om; b0[r] = 1.0f - om; }
                { const float om = __builtin_amdgcn_rcpf(1.0f + __builtin_amdgcn_exp2f(p1[r])); p1[r] = om; b1[r] = 1.0f - om; }
            }
            f32x4 own;
            own[0] = ((p0[0] * p0[1]) * (p0[2] * p0[3])) * ((p0[4] * p0[5]) * (p0[6] * p0[7]));
            own[1] = ((p0[8] * p0[9]) * (p0[10] * p0[11])) * ((p0[12] * p0[13]) * (p0[14] * p0[15]));
            own[2] = ((p1[0] * p1[1]) * (p1[2] * p1[3])) * ((p1[4] * p1[5]) * (p1[6] * p1[7]));
            own[3] = ((p1[8] * p1[9]) * (p1[10] * p1[11])) * ((p1[12] * p1[13]) * (p1[14] * p1[15]));
            const float t0 = __shfl_xor(own[0], 32), t1 = __shfl_xor(own[1], 32), t2 = __shfl_xor(own[2], 32), t3 = __shfl_xor(own[3], 32);
            const float a0 = hi ? t0 : own[0], a1 = hi ? own[0] : t0, a2 = hi ? t1 : own[1], a3 = hi ? own[1] : t1, a4 = hi ? t2 : own[2], a5 = hi ? own[2] : t2, a6 = hi ? t3 : own[3], a7 = hi ? own[3] : t3;
            const float s7 = 1.0f, s6 = a7, s5 = s6 * a6, s4 = s5 * a5, s3 = s4 * a4, s2 = s3 * a3, s1 = s2 * a2, s0 = s1 * a1;
            const float total = s0 * a0;
            { float run = (hi ? s1 : s0) * R;
#pragma unroll
              for (int jj = 7; jj >= 0; --jj) { const float w = b0[jj] * run; run *= p0[jj]; b0[jj] = w; } }
            { float run = (hi ? s3 : s2) * R;
#pragma unroll
              for (int jj = 7; jj >= 0; --jj) { const float w = b0[8 + jj] * run; run *= p0[8 + jj]; b0[8 + jj] = w; } }
            { float run = (hi ? s5 : s4) * R;
#pragma unroll
              for (int jj = 7; jj >= 0; --jj) { const float w = b1[jj] * run; run *= p1[jj]; b1[jj] = w; } }
            { float run = (hi ? s7 : s6) * R;
#pragma unroll
              for (int jj = 7; jj >= 0; --jj) { const float w = b1[8 + jj] * run; run *= p1[8 + jj]; b1[8 + jj] = w; } }
            R *= total;
            const u32x4 pw0 = {cvtpk(b0[0], b0[1]), cvtpk(b0[2], b0[3]), cvtpk(b0[4], b0[5]), cvtpk(b0[6], b0[7])}, pw1 = {cvtpk(b0[8], b0[9]), cvtpk(b0[10], b0[11]), cvtpk(b0[12], b0[13]), cvtpk(b0[14], b0[15])};
            const u32x4 pw2 = {cvtpk(b1[0], b1[1]), cvtpk(b1[2], b1[3]), cvtpk(b1[4], b1[5]), cvtpk(b1[6], b1[7])}, pw3 = {cvtpk(b1[8], b1[9]), cvtpk(b1[10], b1[11]), cvtpk(b1[12], b1[13]), cvtpk(b1[14], b1[15])};
#define SB_PV(kk, pw) { const int co = ((2 * (kk) + hi) ^ vswz) << 4; const bf16x8 v0 = *(const LAS bf16x8*)(Vb + r32 * 128 + co), v1 = *(const LAS bf16x8*)(Vb + (r32 + 32) * 128 + co); \
                o0 = MFMA32(__builtin_bit_cast(bf16x8, pw), v0, o0); o1 = MFMA32(__builtin_bit_cast(bf16x8, pw), v1, o1); }
            SB_PV(0, pw0) SB_PV(1, pw1) SB_PV(2, pw2) SB_PV(3, pw3)
#undef SB_PV
        }
        const int an = (aw == 2) ? 0 : aw + 1;
        walive = __any(R != 0.0f);
        if (walive && lane == 0) alive[aw] = 1u;
        if (tid == 0) alive[an] = 0u;
        __syncthreads();
        if (alive[aw] == 0u) break;
        aw = an;
    }
    int r32e = r32; asm volatile("" : "+v"(r32e));
#pragma unroll
    for (int r = 0; r < 16; ++r) {
        const size_t tok = rowbase + qw0 + crow(r, hi);
        const float g0 = bf2f(Y[tok * LDY_E + 2048 + h * 64 + r32e]), g1 = bf2f(Y[tok * LDY_E + 2048 + h * 64 + 32 + r32e]);
        OM[tok * 1024 + 512 + h * 64 + r32e] = f2bf(o0[r] * g0 * __builtin_amdgcn_rcpf(1.0f + __expf(-g0)));
        OM[tok * 1024 + 512 + h * 64 + 32 + r32e] = f2bf(o1[r] * g1 * __builtin_amdgcn_rcpf(1.0f + __expf(-g1)));
    }
    __syncthreads();
}

__device__ __forceinline__ void diff_map_half(LAS unsigned char* Qb  , LAS unsigned char* Kb, LAS unsigned char* Vb, LAS float* wsf, f32x16 (&O)[4], float& mrow, float& lrow,
                                              int kbase  , int p, int tq, bool need_mask, int krow, int kswz, int vswz, int r32, int hi) {
    f32x16 s = {};
#pragma unroll
    for (int d0 = 0; d0 < 4; ++d0) {
        const int co = ((2 * d0 + hi) ^ kswz) << 4;
        const bf16x8 a0 = *(const LAS bf16x8*)(Kb + (krow + 32 * p) * 128 + co);
        const bf16x8 qf = *(const LAS bf16x8*)(Qb + r32 * 128 + (((2 * d0 + hi) ^ vswz) << 4));
        s = MFMA32(a0, qf, s);
    }
    if (need_mask) {
        asm volatile("" ::: );
#pragma unroll
        for (int r = 0; r < 16; ++r) { const int key = kbase + 16 * (r >> 3) + 8 * hi + (r & 7); if (key > tq) s[r] = -INFINITY; }
    }
    float mx = fmaxf(s[0], s[1]);
#pragma unroll
    for (int r = 2; r < 16; ++r) mx = fmaxf(mx, s[r]);
    { const auto rr = __builtin_amdgcn_permlane32_swap(__float_as_uint(mx), __float_as_uint(mx), false, false); mx = fmaxf(__uint_as_float(rr[0]), __uint_as_float(rr[1])); }
    constexpr float DIFF_THR = 8.0f;
    float mnew = mrow;
    if (__any(mx > mrow + DIFF_THR)) {
        mnew = fmaxf(mrow, mx);
        const float alpha = __builtin_amdgcn_exp2f(mrow - mnew);
        lrow *= alpha;
        if (hi == 0) wsf[r32] = alpha;
#pragma unroll
        for (int r = 0; r < 16; ++r) { const float al = wsf[crow(r, hi)];
#pragma unroll
            for (int dd = 0; dd < 4; ++dd) O[dd][r] *= al; }
    }
    mrow = mnew;
    float sum = 0.f;
#pragma unroll
    for (int r = 0; r < 16; ++r) { s[r] = __builtin_amdgcn_exp2f(s[r] - mnew); sum += s[r]; }
    lrow += sum;
    const u32x4 pw0 = {cvtpk(s[0], s[1]), cvtpk(s[2], s[3]), cvtpk(s[4], s[5]), cvtpk(s[6], s[7])}, pw1 = {cvtpk(s[8], s[9]), cvtpk(s[10], s[11]), cvtpk(s[12], s[13]), cvtpk(s[14], s[15])};
#pragma unroll
    for (int dd = 0; dd < 4; ++dd) {
        const bf16x8 v0 = *(const LAS bf16x8*)(Vb + (r32 + 32 * dd) * 128 + (((4 * p + hi) ^ vswz) << 4)), v1 = *(const LAS bf16x8*)(Vb + (r32 + 32 * dd) * 128 + (((4 * p + 2 + hi) ^ vswz) << 4));
        O[dd] = MFMA32(__builtin_bit_cast(bf16x8, pw0), v0, O[dd]); O[dd] = MFMA32(__builtin_bit_cast(bf16x8, pw1), v1, O[dd]);
    }
}

__device__ __forceinline__ void diff_unit(KPtr P, unsigned char* wsb, int jl, float lam, int b, int h, int qb, LAS unsigned char* lds, int tid, int wave, int lane) {
    const bf16* Y = (const bf16*)(wsb + WS_Y); const bf16* VT = (const bf16*)(wsb + WS_VT); bf16* OM = (bf16*)(wsb + WS_OMIX);
    asm volatile("" : "+v"(lane));
    const int r32 = lane & 31, hi = lane >> 5;
    const size_t rowbase = (size_t)b * SEQ; const int q0 = qb * 256, qw0 = q0 + wave * 32;
    const int srow = wave * 8 + (lane >> 3), sch = (lane & 7) ^ ((srow >> 1) & 7);
    const bf16* k1g = Y + (rowbase + srow) * LDY_O + 1024 + (2 * h) * 64 + sch * 8;
    const bf16* k2g = k1g + 64;
    const bf16* vg = VT + ((size_t)(b * 8 + h) * 64) * 8192 + srow * 64 + sch * 8;
    constexpr int BUF = 32768;
    LAS float* wsf = (LAS float*)(lds + 2 * BUF) + wave * 64;
    LAS unsigned char* Q1b = lds + 2 * BUF + 2048 + wave * 8192; LAS unsigned char* Q2b = Q1b + 4096;
#pragma unroll
    for (int i = 0; i < 4; ++i) { const int qrow = 8 * i + (lane >> 3), qch = (lane & 7) ^ ((qrow >> 1) & 7); const bf16* qp = Y + (rowbase + qw0 + qrow) * LDY_O + (2 * h) * 64 + qch * 8;
        GLDS16(qp, Q1b + i * 1024); GLDS16(qp + 64, Q2b + i * 1024); }
    const int krow = kperm(r32), kswz = (krow >> 1) & 7, vswz = (r32 >> 1) & 7;
    f32x16 O1[4], O2[4];
#pragma unroll
    for (int dd = 0; dd < 4; ++dd) { O1[dd] = (f32x16){}; O2[dd] = (f32x16){}; }
    float m1 = -INFINITY, m2 = -INFINITY, l1 = 0.f, l2 = 0.f;
    const int jmax = (q0 + 255) >> 6;
    { LAS unsigned char* Bn = lds + wave * 1024; GLDS16(k1g, Bn); GLDS16(k2g, Bn + 8192); GLDS16(vg, Bn + 16384); GLDS16(vg + 4096, Bn + 24576); }
    __syncthreads();
    const int tq = qw0 + r32;
    for (int j = 0; j <= jmax; ++j) {
        LAS unsigned char* B0 = lds + (j & 1) * BUF;
        if (j < jmax) { const size_t ko = (size_t)(j + 1) * 64; LAS unsigned char* Bn = lds + ((j + 1) & 1) * BUF + wave * 1024; GLDS16(k1g + ko * LDY_O, Bn); GLDS16(k2g + ko * LDY_O, Bn + 8192); GLDS16(vg + (size_t)(j + 1) * 8192, Bn + 16384); GLDS16(vg + (size_t)(j + 1) * 8192 + 4096, Bn + 24576); }
        const int k0 = j * 64;
        if (k0 <= qw0 + 31) {
            const bool need_mask = (k0 + 63 > qw0);
            diff_map_half(Q1b, B0, B0 + 16384, wsf, O1, m1, l1, k0, 0, tq, need_mask, krow, kswz, vswz, r32, hi);
            diff_map_half(Q2b, B0 + 8192, B0 + 16384, wsf + 32, O2, m2, l2, k0, 0, tq, need_mask, krow, kswz, vswz, r32, hi);
            if (k0 + 32 <= qw0 + 31) {
                diff_map_half(Q1b, B0, B0 + 16384, wsf, O1, m1, l1, k0 + 32, 1, tq, need_mask, krow, kswz, vswz, r32, hi);
                diff_map_half(Q2b, B0 + 8192, B0 + 16384, wsf + 32, O2, m2, l2, k0 + 32, 1, tq, need_mask, krow, kswz, vswz, r32, hi);
            }
        }
        __syncthreads();
    }
    l1 += __shfl_xor(l1, 32); l2 += __shfl_xor(l2, 32);
    int r32e = r32; asm volatile("" : "+v"(r32e));
    if (hi == 0) { wsf[r32] = __builtin_amdgcn_rcpf(l1); wsf[32 + r32] = lam * __builtin_amdgcn_rcpf(l2); }
    const float* sg = P->subln_g + jl * 128; const float post = 1.0f - P->lam_init[jl];
    f32x4 gsc;
#pragma unroll
    for (int dd = 0; dd < 4; ++dd) gsc[dd] = sg[32 * dd + r32e] * post;
#pragma unroll
    for (int r = 0; r < 16; ++r) {
        const int qr_ = crow(r, hi); const float i1 = wsf[qr_], i2 = wsf[32 + qr_];
        f32x4 v; float sq = 0.f;
#pragma unroll
        for (int dd = 0; dd < 4; ++dd) { v[dd] = O1[dd][r] * i1 - O2[dd][r] * i2; sq += v[dd] * v[dd]; }
        sq += __shfl_xor(sq, 1); sq += __shfl_xor(sq, 2); sq += __shfl_xor(sq, 4); sq += __shfl_xor(sq, 8); sq += __shfl_xor(sq, 16);
        const float rn = __builtin_amdgcn_rsqf(sq * (1.0f / 128.0f) + 1e-6f);
        const size_t tok = rowbase + qw0 + qr_;
#pragma unroll
        for (int dd = 0; dd < 4; ++dd) { const float g = bf2f(Y[tok * LDY_O + 2048 + h * 128 + 32 * dd + r32e]);
            OM[tok * 1024 + h * 128 + 32 * dd + r32e] = f2bf(v[dd] * rn * gsc[dd] * g * __builtin_amdgcn_rcpf(1.0f + __expf(-g))); }
    }
    __syncthreads();
}

#define XB_TMO      128
#define XB_XCNT(j)  (256  + 64 * (j))
#define XB_XSUB(j)  (1280 + 64 * (j))
#define XB_XGEN(j)  (2304 + 64 * (j))
#define XB_TOP      3328
#define XB_TOPGEN   3392
#define XCD_BAR_WORDS 3456
#define XB_SPIN_CAP (1u << 18)

__device__ __forceinline__ unsigned xb_ld(unsigned* p)              { return __hip_atomic_load(p, __ATOMIC_RELAXED, __HIP_MEMORY_SCOPE_AGENT); }
__device__ __forceinline__ unsigned xb_add(unsigned* p, unsigned v) { return __hip_atomic_fetch_add(p, v, __ATOMIC_RELAXED, __HIP_MEMORY_SCOPE_AGENT); }
__device__ __forceinline__ unsigned xb_xcc_id() { return (unsigned)__builtin_amdgcn_s_getreg((3 << 11) | 20) & 0xFu; }
#define XB_SPIN(cond, bar) do { unsigned _sp = 0; while (cond) { __builtin_amdgcn_s_sleep(1); \
    if ((++_sp & 255u) == 0u) { if (xb_ld(&(bar)[XB_TMO])) break; if (_sp > XB_SPIN_CAP) { atomicAdd(&(bar)[XB_TMO], 1u); break; } } } } while (0)

struct XcdBarrier {
    unsigned* bar; unsigned x;
    volatile LAS unsigned* st;
};

__device__ __forceinline__ XcdBarrier xcd_barrier_post(unsigned* bar, volatile LAS unsigned* st) {
    XcdBarrier b; b.bar = bar; b.x = xb_xcc_id(); b.st = st;
    if (threadIdx.x == 0) (void)xb_add(&bar[XB_XCNT(b.x)], 1u);
    return b;
}
__device__ __forceinline__ void xcd_barrier_complete(unsigned* bar, unsigned x, unsigned& nloc, unsigned& nx) {
    const unsigned G = gridDim.x * gridDim.y * gridDim.z;
    unsigned sum, cnt, mine, sp = 0u;
    for (;;) {
        sum = 0u; cnt = 0u; mine = 0u;
#pragma unroll
        for (unsigned j = 0; j < 16; ++j) { const unsigned c = xb_ld(&bar[XB_XCNT(j)]); sum += c; cnt += (c > 0u) ? 1u : 0u; mine = (j == x) ? c : mine; }
        if (sum == G) break;
        __builtin_amdgcn_s_sleep(1);
        if ((++sp & 255u) == 0u) { if (xb_ld(&bar[XB_TMO])) break; if (sp > XB_SPIN_CAP) { atomicAdd(&bar[XB_TMO], 1u); break; } }
    }
    nloc = mine > 0u ? mine : 1u; nx = cnt > 0u ? cnt : 1u;
}

__device__ __forceinline__ void xcd_barrier(const XcdBarrier& b) {
    asm volatile("s_waitcnt vmcnt(0)" ::: "memory");
    __syncthreads();
    if (threadIdx.x == 0) {
        unsigned* bar = b.bar;
        __builtin_amdgcn_s_waitcnt(0);
        unsigned nloc = b.st[0], nx = b.st[1];
        if (nloc == 0u) { xcd_barrier_complete(bar, b.x, nloc, nx); b.st[0] = nloc; b.st[1] = nx; }
        const unsigned old = xb_add(&bar[XB_XSUB(b.x)], 1u);
        const unsigned gen = old / nloc;
        if (old + 1u == (gen + 1u) * nloc) {
            __builtin_amdgcn_fence(__ATOMIC_RELEASE, "agent");
            asm volatile("s_waitcnt vmcnt(0)" ::: "memory");
            const unsigned og = xb_add(&bar[XB_TOP], 1u);
            const unsigned tg = og / nx;
            if (og + 1u == (tg + 1u) * nx) xb_add(&bar[XB_TOPGEN], 1u);
            else XB_SPIN(xb_ld(&bar[XB_TOPGEN]) == tg, bar);
            __builtin_amdgcn_fence(__ATOMIC_ACQUIRE, "agent");
            xb_add(&bar[XB_XGEN(b.x)], 1u);
            asm volatile("s_waitcnt vmcnt(0)" ::: "memory");
        } else {
            XB_SPIN(xb_ld(&bar[XB_XGEN(b.x)]) == gen, bar);
            __builtin_amdgcn_fence(__ATOMIC_ACQUIRE, "agent");
            asm volatile("s_waitcnt vmcnt(0)" ::: "memory");
        }
    }
    __syncthreads();
}

#ifndef DUP_MASK
#define DUP_MASK 0
#endif
#define GSYNC() do { xcd_barrier(xbar); if (DUP_MASK & 128) xcd_barrier(xbar); } while (0)
__global__ void __launch_bounds__(NTHREADS, 2) trunk_fwd(Params Pv) {
    extern __shared__ __attribute__((aligned(16))) unsigned char lds_raw[];
    LAS unsigned char* lds = (LAS unsigned char*)lds_raw;
    cg::grid_group grid = cg::this_grid();
    const int tid0 = threadIdx.x, lane0 = tid0 & 63, wave0 = __builtin_amdgcn_readfirstlane(tid0 >> 6);
    const int G = gridDim.x, bx = blockIdx.x, vcu = (G % 8 == 0) ? (bx % 8) * (G / 8) + bx / 8 : bx;

    volatile LAS unsigned* bst = (volatile LAS unsigned*)(lds + LDS_BYTES - 64);
    if (tid0 < 2) bst[tid0] = 0u;
    __syncthreads();
    XcdBarrier xbar;
    { KPtr P = KP_GET();
      if (bx == 0) for (int i = tid0; i < XCD_BAR_WORDS; i += NTHREADS) ((unsigned*)P->ws)[i] = 0u;
      prologue(P, lds, vcu, G, wave0, lane0);
      convert_p(P, P->ws, 0, vcu, G, tid0); }
    grid.sync();
    { KPtr P = KP_GET(); xbar = xcd_barrier_post((unsigned*)P->ws, bst); }

    for (int layer = 0; layer < 4; ++layer) {
        const int jl = layer >> 1; const bool odd = layer & 1;
        int tid = threadIdx.x; asm volatile("" : "+v"(tid));
        KPtr P = KP_GET();
        unsigned char* ws = P->ws; asm volatile("" : "+s"(ws));
        pg8::ss_t* SS = (pg8::ss_t*)(ws + WS_SS);
        bf16* HB0 = (bf16*)(ws + WS_HB0); bf16* HB1 = (bf16*)(ws + WS_HB1); bf16* OMIX = (bf16*)(ws + WS_OMIX); bf16* Yb = (bf16*)(ws + WS_Y); bf16* VTb = (bf16*)(ws + WS_VT); bf16* PPb = (bf16*)(ws + WS_PP); bf16* PBb = (bf16*)(ws + WS_PB);
        const int lane = tid & 63, wave = __builtin_amdgcn_readfirstlane(tid >> 6);
        const pg8::ss_t* ss_mix = SS + (size_t)layer * MT; pg8::ss_t* ss_ple = SS + (size_t)(4 + layer) * MT; pg8::ss_t* ss_next = SS + (size_t)(layer < 3 ? layer + 1 : 8) * MT;
        {
            const bf16* Wt = odd ? (const bf16*)(ws + WS_WINO) + (size_t)jl * 4096 * 1024 : (const bf16*)(ws + WS_WINE) + (size_t)jl * 3072 * 1024;
            const int nmain = odd ? 3072 : 2560, nv = odd ? 1024 : 512;
            for (int rep = 0; rep < ((DUP_MASK & 1) ? 2 : 1); ++rep) {
            { pg8::Gemm g{HB0, Wt, MT, nmain, 1024}; pg8::StaticOrder S; S.init(MT, nmain, G, bx);
              pg8::EpiY E{Yb, nmain, ss_mix, (const float*)(ws + WS_ROPE), odd ? 8 : 0};
              pg8::gemm_phase<pg8::EpiY, pg8::StaticOrder, true, true>(lds, g, S, E); }
            { pg8::Gemm g{Wt + (size_t)nmain * 1024, HB0, nv, MT, 1024}; pg8::StaticOrder S; S.init(nv, MT, G, bx);
              pg8::EpiVt E{VTb, odd ? 7 : 6, ss_mix};
              pg8::gemm_phase<pg8::EpiVt, pg8::StaticOrder, true, true>(lds, g, S, E); }
            }
        }
        GSYNC();
        if (!odd) {
            LAS unsigned char* xct = lds + wave * 4096;
            for (int rep = 0; rep < ((DUP_MASK & 2) ? 2 : 1); ++rep)
            for (int u = vcu * 8 + wave; u < 4096; u += G * 8) lru_unit(P, ws, jl, u, 0, xct, lane);
            if (layer > 0) convert_p(P, ws, layer, vcu, G, tid);
            GSYNC();
            for (int rep = 0; rep < ((DUP_MASK & 2) ? 2 : 1); ++rep)
            for (int u = vcu * 8 + wave; u < 4096; u += G * 8) lru_unit(P, ws, jl, u, 1, xct, lane);
            __syncthreads();
            for (int rep = 0; rep < ((DUP_MASK & 8) ? 2 : 1); ++rep)
            for (int vv = vcu; vv < 256; vv += G)
                for (int i = 0; i < 4; ++i) { const int li = vv & 31, bh = 8 * (vv >> 5) + 2 * i + (li >> 4), qb = (i & 1) ? 15 - (li & 15) : (li & 15); sb_unit(P, ws, bh >> 3, bh & 7, qb, lds, tid, wave, lane); }
        } else {
            float lam;
            { const float a = wave_sum(lane < 64 ? P->lq1[jl * 64 + lane] * P->lk1[jl * 64 + lane] : 0.f), c = wave_sum(P->lq2[jl * 64 + lane] * P->lk2[jl * 64 + lane]); lam = __expf(a) - __expf(c) + P->lam_init[jl]; }
            convert_p(P, ws, layer, vcu, G, tid);
            for (int rep = 0; rep < ((DUP_MASK & 16) ? 2 : 1); ++rep)
            for (int vv = vcu; vv < 256; vv += G)
                for (int i = 0; i < 4; ++i) { const int li = vv & 31, bh = 8 * (vv >> 5) + 2 * i + (li >> 4), qb = (i & 1) ? 15 - (li & 15) : (li & 15); diff_unit(P, ws, jl, lam, bh >> 3, bh & 7, qb, lds, tid, wave, lane); }
        }
        GSYNC();
        {
            { pg8::Gemm g{OMIX, (const bf16*)(ws + WS_WOUT) + (size_t)layer * 1024 * 1024, MT, 1024, 1024}; pg8::StaticOrder S; S.init(MT, 1024, G, bx);
              pg8::EpiRes E{layer == 0 ? P->x : P->out, P->out, HB1, ss_ple};
              pg8::gemm_phase<pg8::EpiRes, pg8::StaticOrder, true, true>(lds, g, S, E); }
            { pg8::Gemm g{PBb, (const bf16*)(ws + WS_WP) + (size_t)layer * 1024 * 256, MT, 1024, 256}; pg8::StaticOrder S; S.init(MT, 1024, G, bx);
              pg8::EpiPlain E{PPb, 1024};
              pg8::gemm_phase<pg8::EpiPlain, pg8::StaticOrder, false, true>(lds, g, S, E); }
        }
        GSYNC();
        {
            pg8::Gemm g{HB1, (const bf16*)(ws + WS_WG) + (size_t)layer * 1024 * 1024, MT, 1024, 1024}; pg8::StaticOrder S; S.init(MT, 1024, G, bx);
            pg8::EpiGate E{ss_ple, HB1, P->out, PPb, HB0, ss_next};
            pg8::gemm_phase<pg8::EpiGate, pg8::StaticOrder, true, true>(lds, g, S, E);
        }
        GSYNC();
    }
    { KPtr P = KP_GET(); final_norm(P, vcu, G, wave0, lane0); }
}

extern "C" void kernel_launch(void* const* d_in, const int* in_sizes, int n_in, void* d_out, int out_size, void* d_ws, size_t ws_size, hipStream_t stream) {
    static int grid = 0;
    if (grid == 0) {
        if (n_in != 24 || out_size != MT * DM || ws_size < WS_END) { fprintf(stderr, "kernel_launch: unexpected problem (n_in %d out %d ws %zu)\n", n_in, out_size, ws_size); grid = -1; return; }
        int dev = 0, cus = 0, per_cu = 0;
        hipGetDevice(&dev); hipDeviceGetAttribute(&cus, hipDeviceAttributeMultiprocessorCount, dev);
        hipFuncSetAttribute((const void*)trunk_fwd, hipFuncAttributeMaxDynamicSharedMemorySize, LDS_BYTES);
        hipOccupancyMaxActiveBlocksPerMultiprocessor(&per_cu, (const void*)trunk_fwd, NTHREADS, LDS_BYTES);
        (void)hipGetLastError();
        if (per_cu < 1) per_cu = 1;
        grid = cus;
        if (grid > 256) grid = 256;
        grid &= ~7;
    }
    if (grid <= 0) return;
    Params P{};
    P.x = (const float*)d_in[0]; P.p = (const float*)d_in[1]; P.pos = (const int*)d_in[2]; P.norm_mix = (const float*)d_in[3]; P.norm_ple = (const float*)d_in[4];
    P.w_ple_gate = (const float*)d_in[5]; P.w_ple_proj = (const float*)d_in[6]; P.w_in_e = (const float*)d_in[7]; P.conv_w = (const float*)d_in[8]; P.conv_b = (const float*)d_in[9];
    P.lru_wa = (const float*)d_in[10]; P.lru_ba = (const float*)d_in[11]; P.lru_wx = (const float*)d_in[12]; P.lru_bx = (const float*)d_in[13]; P.lru_lambda = (const float*)d_in[14];
    P.w_out_e = (const float*)d_in[15]; P.w_in_o = (const float*)d_in[16]; P.lq1 = (const float*)d_in[17]; P.lk1 = (const float*)d_in[18]; P.lq2 = (const float*)d_in[19]; P.lk2 = (const float*)d_in[20];
    P.subln_g = (const float*)d_in[21]; P.w_out_o = (const float*)d_in[22]; P.final_norm = (const float*)d_in[23];
    P.out = (float*)d_out; P.ws = (unsigned char*)d_ws;
    P.lam_init[0] = (float)(0.8 - 0.6 * exp(-0.3 * 1.0)); P.lam_init[1] = (float)(0.8 - 0.6 * exp(-0.3 * 3.0));
    void* args[] = {&P};
    hipError_t e = hipLaunchCooperativeKernel((const void*)trunk_fwd, dim3(grid), dim3(NTHREADS), args, LDS_BYTES, stream);
    if (e != hipSuccess) fprintf(stderr, "cooperative launch failed: %s (grid %d)\n", hipGetErrorString(e), grid);
}
```

```cpp
#include <hip/hip_runtime.h>
#include <hip/hip_cooperative_groups.h>
#include <cstdio>
#include <cstdint>
#include <cmath>
namespace pg8 {
#define PG8_LAS __attribute__((address_space(3)))
typedef unsigned short bf16_t;
typedef short bf16x8 __attribute__((ext_vector_type(8)));
typedef float f32x4 __attribute__((ext_vector_type(4)));
typedef unsigned u32x4 __attribute__((ext_vector_type(4)));
constexpr int BM = 256, BK = 64, HALF = 128, HTB = HALF * BK * 2  , STAGE_BYTES = 8 * HTB, NXCD = 8, WGM = 8;

__host__ __device__ __forceinline__ int lds_byte(int r, int c) { const int st = (r >> 4) * 2 + (c >> 5), rr = r & 15, cc = c & 31, ob = rr * 64 + cc * 2; return st * 1024 + (ob ^ (((ob >> 9) & 1) << 5)); }
__host__ __device__ __forceinline__ void stage_rc(int b, int& R, int& C) { const int st = b / 1024, sb = b % 1024, swz = sb ^ (((sb >> 9) & 1) << 5); R = (st >> 1) * 16 + swz / 64; C = (st & 1) * 32 + (swz % 64) / 2; }
__host__ __device__ __forceinline__ int perm32(int rho) { const int n = rho >> 4, i = rho & 15; return 8 * (i >> 2) + 4 * n + (i & 3); }

struct Unit { int pm, pn; };
struct Gemm { const bf16_t* A; const bf16_t* Bt; int M, N, K; };

struct StaticOrder {
    int nM, nN, nwg, G, c;
    __host__ __device__ void init(int M, int N, int G_, int c_) { nM = M / BM; nN = N / BM; nwg = nM * nN; G = G_; c = c_; }
    __host__ __device__ bool next(int i, Unit& u) const {
        const long L = (long)i * G + c; if (L >= nwg) return false;
        int wgid = (int)L; { const int q = nwg / NXCD, r = nwg % NXCD, xcd = wgid % NXCD, off = wgid / NXCD; wgid = (xcd < r ? xcd * (q + 1) : r * (q + 1) + (xcd - r) * q) + off; }
        const int nig = WGM * nN, gid = wgid / nig, fm = gid * WGM, gsz = (nM - fm) < WGM ? (nM - fm) : WGM;
        u.pm = fm + ((wgid % nig) % gsz); u.pn = (wgid % nig) / gsz; return true;
    }
    __device__ __forceinline__ void a_ready(const Unit&) const {}
    __device__ __forceinline__ void done(const Unit&) const {}
};

__device__ __forceinline__ unsigned cvt_pk_bf16(float lo, float hi) { unsigned r; asm volatile("v_cvt_pk_bf16_f32 %0, %1, %2" : "=v"(r) : "v"(lo), "v"(hi)); return r; }
__device__ __forceinline__ float bf2f(unsigned short u) { return __uint_as_float((unsigned)u << 16); }
__device__ __forceinline__ u32x4 pack8(const f32x4& v0, const f32x4& v1) { u32x4 w; w.x = cvt_pk_bf16(v0[0], v0[1]); w.y = cvt_pk_bf16(v0[2], v0[3]); w.z = cvt_pk_bf16(v1[0], v1[1]); w.w = cvt_pk_bf16(v1[2], v1[3]); return w; }
constexpr float RMS_EPS = 1e-6f;
typedef unsigned long long ss_t;
__device__ __forceinline__ float ss_rstd(ss_t v) { return __builtin_amdgcn_rsqf((float)v * (2.3283064365386963e-10f / 1024.0f) + RMS_EPS); }
__device__ __forceinline__ void ss_add(ss_t* p, float sq) { atomicAdd(p, (ss_t)(sq * 4294967296.0f)); }

struct EpiY {
    static constexpr bool PERM = true, AFTER_DRAIN = false;
    bf16_t* O; int ldc; const ss_t* ss; const float* rope; int rope_pn;
    __device__ __forceinline__ void operator()(const f32x4 (&acc)[2][2][4][2], const Unit& u, int wr, int wc, int fr, int fq) const {
        asm volatile("" : "+v"(fr), "+v"(fq));
        const int row0 = u.pm * BM + wr * 64 + fr, col0 = u.pn * BM + wc * 32 + 8 * fq;
        const bool do_rope = u.pn < rope_pn;
#pragma unroll
        for (int ai = 0; ai < 2; ++ai)
#pragma unroll
            for (int m = 0; m < 4; ++m) {
                const int row = row0 + ai * HALF + m * 16;
                const float rstd = ss_rstd(ss[row]);
                f32x4 cs0 = {1.f, 0.f, 1.f, 0.f}, cs1 = {1.f, 0.f, 1.f, 0.f};
                if (do_rope) { const float* rp = rope + (size_t)row * 64 + ((wc & 1) * 16 + 4 * fq) * 2; cs0 = *(const f32x4*)rp; cs1 = *(const f32x4*)(rp + 4); }
                bf16_t* rowp = O + (size_t)row * ldc + col0;
#pragma unroll
                for (int bj = 0; bj < 2; ++bj) {
                    f32x4 v0 = acc[ai][bj][m][0] * rstd, v1 = acc[ai][bj][m][1] * rstd;
                    if (do_rope) {
                        const f32x4 c = {cs0[0], cs0[2], cs1[0], cs1[2]}, s = {cs0[1], cs0[3], cs1[1], cs1[3]};
                        const f32x4 o0 = v0 * c - v1 * s, o1 = v1 * c + v0 * s; v0 = o0; v1 = o1;
                    }
                    *(u32x4*)(rowp + bj * HALF) = pack8(v0, v1);
                }
                if (do_rope && (m & 1)) asm volatile("" ::: "memory");
            }
    }
};
struct EpiVt {
    static constexpr bool PERM = true, AFTER_DRAIN = false;
    bf16_t* O; int dvs; const ss_t* ss;
    __device__ __forceinline__ void operator()(const f32x4 (&acc)[2][2][4][2], const Unit& u, int wr, int wc, int fr, int fq) const {
        asm volatile("" : "+v"(fr), "+v"(fq));
        const int row0 = u.pm * BM + wr * 64 + fr, col0 = u.pn * BM + wc * 32 + 8 * fq;
        f32x4 r0[2], r1[2];
#pragma unroll
        for (int bj = 0; bj < 2; ++bj) {
#pragma unroll
            for (int i = 0; i < 4; ++i) { r0[bj][i] = ss_rstd(ss[col0 + bj * HALF + i]); r1[bj][i] = ss_rstd(ss[col0 + bj * HALF + 4 + i]); }
        }
#pragma unroll
        for (int ai = 0; ai < 2; ++ai)
#pragma unroll
            for (int m = 0; m < 4; ++m) {
                const int c = row0 + ai * HALF + m * 16, hh = c >> dvs, d = c & ((1 << dvs) - 1);
#pragma unroll
                for (int bj = 0; bj < 2; ++bj) { const int tok = col0 + bj * HALF, b = tok >> 12, s = tok & 4095;
                    *(u32x4*)(O + ((((size_t)(b * 8 + hh) * 64 + (s >> 6)) << dvs) + d) * 64 + (s & 63)) = pack8(acc[ai][bj][m][0] * r0[bj], acc[ai][bj][m][1] * r1[bj]); }
            }
    }
};
struct EpiPlain {
    static constexpr bool PERM = true, AFTER_DRAIN = false;
    bf16_t* O; int ldc;
    __device__ __forceinline__ void operator()(const f32x4 (&acc)[2][2][4][2], const Unit& u, int wr, int wc, int fr, int fq) const {
        asm volatile("" : "+v"(fr), "+v"(fq));
        const int row0 = u.pm * BM + wr * 64 + fr, col0 = u.pn * BM + wc * 32 + 8 * fq;
#pragma unroll
        for (int ai = 0; ai < 2; ++ai)
#pragma unroll
            for (int m = 0; m < 4; ++m) {
                bf16_t* rowp = O + (size_t)(row0 + ai * HALF + m * 16) * ldc + col0;
#pragma unroll
                for (int bj = 0; bj < 2; ++bj) *(u32x4*)(rowp + bj * HALF) = pack8(acc[ai][bj][m][0], acc[ai][bj][m][1]);
            }
    }
};
struct EpiRes {
    static constexpr bool PERM = true, AFTER_DRAIN = false;
    const float* base; float* out; bf16_t* hb; ss_t* ssacc;
    __device__ __forceinline__ void operator()(const f32x4 (&acc)[2][2][4][2], const Unit& u, int wr, int wc, int fr, int fq) const {
        asm volatile("" : "+v"(fr), "+v"(fq));
        const int row0 = u.pm * BM + wr * 64 + fr, col0 = u.pn * BM + wc * 32 + 8 * fq;
#pragma unroll
        for (int ai = 0; ai < 2; ++ai)
#pragma unroll
            for (int m = 0; m < 4; ++m) {
                const int row = row0 + ai * HALF + m * 16; float sq = 0.f;
#pragma unroll
                for (int bj = 0; bj < 2; ++bj) {
                    const size_t off = (size_t)row * 1024 + col0 + bj * HALF;
                    const f32x4 v0 = *(const f32x4*)(base + off) + acc[ai][bj][m][0], v1 = *(const f32x4*)(base + off + 4) + acc[ai][bj][m][1];
                    *(u32x4*)(hb + off) = pack8(v0, v1);
                    sq += (v0[0] * v0[0] + v0[1] * v0[1]) + (v0[2] * v0[2] + v0[3] * v0[3]) + (v1[0] * v1[0] + v1[1] * v1[1]) + (v1[2] * v1[2] + v1[3] * v1[3]);
                }
                sq += __shfl_xor(sq, 16); sq += __shfl_xor(sq, 32);
                if (fq == 0) ss_add(ssacc + row, sq);
                if (m & 1) asm volatile("" ::: "memory");
            }
    }
};
struct EpiGate {
    static constexpr bool PERM = true, AFTER_DRAIN = false;
    const ss_t* ss; const bf16_t* h1b; float* h; const bf16_t* pp; bf16_t* hb; ss_t* ssacc;
    __device__ __forceinline__ void operator()(const f32x4 (&acc)[2][2][4][2], const Unit& u, int wr, int wc, int fr, int fq) const {
        asm volatile("" : "+v"(fr), "+v"(fq));
        const int row0 = u.pm * BM + wr * 64 + fr, col0 = u.pn * BM + wc * 32 + 8 * fq;
#pragma unroll
        for (int ai = 0; ai < 2; ++ai)
#pragma unroll
            for (int m = 0; m < 4; ++m) {
                const int row = row0 + ai * HALF + m * 16; float sq = 0.f;
                const float rstd = ss_rstd(ss[row]) * -1.4426950408889634f;
#pragma unroll
                for (int bj = 0; bj < 2; ++bj) {
                    const size_t off = (size_t)row * 1024 + col0 + bj * HALF;
                    const u32x4 pw = *(const u32x4*)(pp + off);
                    const f32x4 p0 = {__uint_as_float(pw.x << 16), __uint_as_float(pw.x & 0xffff0000u), __uint_as_float(pw.y << 16), __uint_as_float(pw.y & 0xffff0000u)};
                    const f32x4 p1 = {__uint_as_float(pw.z << 16), __uint_as_float(pw.z & 0xffff0000u), __uint_as_float(pw.w << 16), __uint_as_float(pw.w & 0xffff0000u)};
                    f32x4 g0, g1;
#pragma unroll
                    for (int i = 0; i < 4; ++i) { g0[i] = __builtin_amdgcn_rcpf(1.0f + __builtin_amdgcn_exp2f(acc[ai][bj][m][0][i] * rstd)); g1[i] = __builtin_amdgcn_rcpf(1.0f + __builtin_amdgcn_exp2f(acc[ai][bj][m][1][i] * rstd)); }
                    const u32x4 hw = *(const u32x4*)(h1b + off);
                    const f32x4 h0 = {__uint_as_float(hw.x << 16), __uint_as_float(hw.x & 0xffff0000u), __uint_as_float(hw.y << 16), __uint_as_float(hw.y & 0xffff0000u)};
                    const f32x4 h1 = {__uint_as_float(hw.z << 16), __uint_as_float(hw.z & 0xffff0000u), __uint_as_float(hw.w << 16), __uint_as_float(hw.w & 0xffff0000u)};
                    const f32x4 v0 = h0 + g0 * p0, v1 = h1 + g1 * p1;
                    *(f32x4*)(h + off) = v0; *(f32x4*)(h + off + 4) = v1; *(u32x4*)(hb + off) = pack8(v0, v1);
                    sq += (v0[0] * v0[0] + v0[1] * v0[1]) + (v0[2] * v0[2] + v0[3] * v0[3]) + (v1[0] * v1[0] + v1[1] * v1[1]) + (v1[2] * v1[2] + v1[3] * v1[3]);
                }
                sq += __shfl_xor(sq, 16); sq += __shfl_xor(sq, 32);
                if (fq == 0) ss_add(ssacc + row, sq);
                if (m & 1) asm volatile("" ::: "memory");
            }
    }
};
template <class Epi, class Sched, bool ALIGN_EPI = false, bool SP2 = false>
__device__ __forceinline__ void gemm_phase(PG8_LAS unsigned char* lds, const Gemm g, const Sched& S, const Epi& E) {
    int tid_ = threadIdx.x; asm volatile("" : "+v"(tid_));
    const int tid = tid_, wid = __builtin_amdgcn_readfirstlane(tid >> 6), lane = tid & 63, wr = wid >> 2, wc = wid & 3, fr = lane & 15, fq = lane >> 4;
    const int K = g.K, nt = K / BK;
    unsigned voffA[2], voffB[2];
#pragma unroll
    for (int i = 0; i < 2; ++i) { int R, C; stage_rc(tid * 16 + i * 8192, R, C); const int Rb = Epi::PERM ? ((R & ~31) + perm32(R & 31)) : R;
        voffA[i] = (unsigned)(R * K + C) * 2u; voffB[i] = (unsigned)(Rb * K + C) * 2u; }
    const size_t kstep = (size_t)(BK * 2);
    const size_t hstep = (size_t)HALF * K * 2;
    const size_t tstep = 2 * hstep;
    const unsigned ldsw = (unsigned)wid * 1024u;
    const int aoff = lds_byte(wr * 64 + fr, fq * 8), boff = lds_byte(wc * 32 + fr, fq * 8);
#define PG8_SA(b, h) (((b) * 2 + (h)) * HTB)
#define PG8_SB(b, h) ((4 + (b) * 2 + (h)) * HTB)
#define PG8_STAGE(bufoff, gbase, voff) do { _Pragma("unroll") for (int _i = 0; _i < 2; ++_i) \
        __builtin_amdgcn_global_load_lds((const unsigned*)((const char*)(gbase) + (voff)[_i]), (PG8_LAS unsigned*)(lds + (bufoff) + ldsw + _i * 8192), 16, 0, 0); } while (0)
#define PG8_LDA(dst, b, h) do { _Pragma("unroll") for (int m = 0; m < 4; ++m) _Pragma("unroll") for (int k = 0; k < 2; ++k) dst[m][k] = *(const PG8_LAS bf16x8*)(lds + PG8_SA(b, h) + aoff + m * 2048 + k * 1024); } while (0)
#define PG8_LDB(dst, b, h) do { _Pragma("unroll") for (int n = 0; n < 2; ++n) _Pragma("unroll") for (int k = 0; k < 2; ++k) dst[n][k] = *(const PG8_LAS bf16x8*)(lds + PG8_SB(b, h) + boff + n * 2048 + k * 1024); } while (0)
#define PG8_MMA(ai, bj, At, Bt) do { __builtin_amdgcn_s_setprio(1); _Pragma("unroll") for (int m = 0; m < 4; ++m) _Pragma("unroll") for (int n = 0; n < 2; ++n) _Pragma("unroll") for (int k = 0; k < 2; ++k) \
        acc[ai][bj][m][n] = __builtin_amdgcn_mfma_f32_16x16x32_bf16(Bt[n][k], At[m][k], acc[ai][bj][m][n], 0, 0, 0); __builtin_amdgcn_s_setprio(0); } while (0)
#define PG8_WAIT_V(n) asm volatile("s_waitcnt vmcnt(" #n ")" ::: "memory")
#define PG8_WAIT_L(n) asm volatile("s_waitcnt lgkmcnt(" #n ")" ::: "memory")
#define PG8_BAR __builtin_amdgcn_s_barrier()
#define PG8_SCHED __builtin_amdgcn_sched_barrier(0)
    Unit cur, nxt; int ui = 0;
    if (!S.next(0, cur)) return;
    f32x4 acc[2][2][4][2];
#pragma unroll
    for (int a = 0; a < 2; ++a)
#pragma unroll
        for (int b = 0; b < 2; ++b)
#pragma unroll
            for (int m = 0; m < 4; ++m)
#pragma unroll
                for (int n = 0; n < 2; ++n) acc[a][b][m][n] = (f32x4){0.f, 0.f, 0.f, 0.f};
    bf16x8 At[4][2], B0[2][2], B1[2][2];
    const char* cA = (const char*)g.A + (size_t)cur.pm * tstep; const char* cB = (const char*)g.Bt + (size_t)cur.pn * tstep;
    S.a_ready(cur);
    if constexpr (SP2) {
        PG8_STAGE(PG8_SB(0, 0), cB, voffB); PG8_STAGE(PG8_SB(0, 1), cB + hstep, voffB); PG8_STAGE(PG8_SA(0, 0), cA, voffA); PG8_STAGE(PG8_SA(0, 1), cA + hstep, voffA);
        if (wr == 1) PG8_BAR;
        PG8_WAIT_V(2); PG8_BAR;
        PG8_STAGE(PG8_SB(1, 0), cB + kstep, voffB); PG8_STAGE(PG8_SA(1, 0), cA + kstep, voffA); PG8_STAGE(PG8_SB(1, 1), cB + hstep + kstep, voffB);
        PG8_WAIT_V(6); PG8_BAR;
    } else {
        PG8_STAGE(PG8_SB(0, 0), cB, voffB); PG8_STAGE(PG8_SA(0, 0), cA, voffA); PG8_STAGE(PG8_SB(0, 1), cB + hstep, voffB); PG8_STAGE(PG8_SA(0, 1), cA + hstep, voffA);
        if (wr == 1) PG8_BAR;
        PG8_WAIT_V(4); PG8_BAR;
        PG8_STAGE(PG8_SB(1, 0), cB + kstep, voffB); PG8_STAGE(PG8_SA(1, 0), cA + kstep, voffA); PG8_STAGE(PG8_SB(1, 1), cB + hstep + kstep, voffB);
        PG8_WAIT_V(6); PG8_BAR;
    }
    for (;;) {
        const bool has_next = S.next(ui + 1, nxt);
        const char* nA = has_next ? (const char*)g.A + (size_t)nxt.pm * tstep : cA; const char* nB = has_next ? (const char*)g.Bt + (size_t)nxt.pn * tstep : cB;
        for (int t = 0; t < nt; t += 2) {
            const bool last = (t == nt - 2);
            const char* a1 = cA + (size_t)(t + 1) * kstep;
            const char* a2 = last ? nA : cA + (size_t)(t + 2) * kstep; const char* b2 = last ? nB : cB + (size_t)(t + 2) * kstep;
            const char* a3 = a2 + kstep; const char* b3 = b2 + kstep;
            if (last && has_next) S.a_ready(nxt);
            if constexpr (SP2) {
            PG8_LDB(B0, 0, 0); PG8_LDB(B1, 0, 1); PG8_SCHED; PG8_LDA(At, 0, 0); PG8_STAGE(PG8_SA(1, 1), a1 + hstep, voffA);
            PG8_WAIT_V(8); PG8_WAIT_L(0); PG8_BAR; PG8_MMA(0, 0, At, B0); PG8_MMA(0, 1, At, B1); PG8_BAR; PG8_SCHED;
            PG8_LDA(At, 0, 1); PG8_STAGE(PG8_SB(0, 0), b2, voffB); PG8_STAGE(PG8_SB(0, 1), b2 + hstep, voffB); PG8_STAGE(PG8_SA(0, 0), a2, voffA);
            PG8_WAIT_V(8); PG8_WAIT_L(0); PG8_BAR; PG8_MMA(1, 0, At, B0); PG8_MMA(1, 1, At, B1); PG8_BAR; PG8_SCHED;
            PG8_LDB(B0, 1, 0); PG8_LDB(B1, 1, 1); PG8_SCHED; PG8_LDA(At, 1, 0); PG8_STAGE(PG8_SA(0, 1), a2 + hstep, voffA);
            PG8_WAIT_V(8); PG8_WAIT_L(0); PG8_BAR; PG8_MMA(0, 0, At, B0); PG8_MMA(0, 1, At, B1); PG8_BAR; PG8_SCHED;
            PG8_LDA(At, 1, 1); PG8_STAGE(PG8_SB(1, 0), b3, voffB); PG8_STAGE(PG8_SB(1, 1), b3 + hstep, voffB); PG8_STAGE(PG8_SA(1, 0), a3, voffA);
            PG8_WAIT_V(8); PG8_WAIT_L(0); PG8_BAR; PG8_MMA(1, 0, At, B0); PG8_MMA(1, 1, At, B1); PG8_BAR; PG8_SCHED;
            } else {
            PG8_LDB(B0, 0, 0); PG8_SCHED; PG8_LDA(At, 0, 0); PG8_STAGE(PG8_SA(1, 1), a1 + hstep, voffA);
            PG8_WAIT_L(8); PG8_BAR; PG8_WAIT_L(0); PG8_MMA(0, 0, At, B0); PG8_BAR; PG8_SCHED;
            PG8_LDB(B1, 0, 1); PG8_STAGE(PG8_SB(0, 0), b2, voffB);
            PG8_BAR; PG8_WAIT_L(0); PG8_MMA(0, 1, At, B1); PG8_BAR;
            PG8_LDA(At, 0, 1); PG8_STAGE(PG8_SA(0, 0), a2, voffA);
            PG8_BAR; PG8_WAIT_L(0); PG8_MMA(1, 0, At, B0); PG8_BAR; PG8_SCHED;
            PG8_STAGE(PG8_SB(0, 1), b2 + hstep, voffB);
            PG8_WAIT_V(6); PG8_BAR; PG8_MMA(1, 1, At, B1); PG8_BAR;
            PG8_LDB(B0, 1, 0); PG8_SCHED; PG8_LDA(At, 1, 0); PG8_STAGE(PG8_SA(0, 1), a2 + hstep, voffA);
            PG8_WAIT_L(8); PG8_BAR; PG8_WAIT_L(0); PG8_MMA(0, 0, At, B0); PG8_BAR; PG8_SCHED;
            PG8_LDB(B1, 1, 1); PG8_STAGE(PG8_SB(1, 0), b3, voffB);
            PG8_BAR; PG8_WAIT_L(0); PG8_MMA(0, 1, At, B1); PG8_BAR;
            PG8_LDA(At, 1, 1); PG8_STAGE(PG8_SA(1, 0), a3, voffA);
            PG8_BAR; PG8_WAIT_L(0); PG8_MMA(1, 0, At, B0); PG8_BAR; PG8_SCHED;
            PG8_STAGE(PG8_SB(1, 1), b3 + hstep, voffB);
            PG8_WAIT_V(6); PG8_BAR; PG8_MMA(1, 1, At, B1); PG8_BAR;
            }
        }
        if constexpr (ALIGN_EPI) { if (wr == 0) PG8_BAR; }
        if constexpr (!Epi::AFTER_DRAIN) { E(acc, cur, wr, wc, fr, fq); S.done(cur); }
        if (!has_next) break;
#pragma unroll
        for (int a = 0; a < 2; ++a)
#pragma unroll
            for (int b = 0; b < 2; ++b)
#pragma unroll
                for (int m = 0; m < 4; ++m)
#pragma unroll
                    for (int n = 0; n < 2; ++n) acc[a][b][m][n] = (f32x4){0.f, 0.f, 0.f, 0.f};
        cur = nxt; cA = nA; cB = nB; ++ui;
        if constexpr (ALIGN_EPI) { if (wr == 1) PG8_BAR; }
    }
    PG8_WAIT_V(0);
    if constexpr (!ALIGN_EPI) { if (wr == 0) PG8_BAR; }
    PG8_BAR;
    if constexpr (Epi::AFTER_DRAIN) { E.fused(acc, cur, wr, wc, fr, fq, lds, wid, lane); S.done(cur); }
#undef PG8_SA
#undef PG8_SB
#undef PG8_STAGE
#undef PG8_LDA
#undef PG8_LDB
#undef PG8_MMA
#undef PG8_WAIT_V
#undef PG8_WAIT_L
#undef PG8_BAR
#undef PG8_SCHED
}
}

namespace cg = cooperative_groups;
#define LAS __attribute__((address_space(3)))
typedef unsigned short bf16;
typedef short bf16x8 __attribute__((ext_vector_type(8)));
typedef float f32x4 __attribute__((ext_vector_type(4)));
typedef float f32x16 __attribute__((ext_vector_type(16)));
typedef unsigned u32x4 __attribute__((ext_vector_type(4)));

constexpr int NB = 8, SEQ = 4096, DM = 1024, MT = NB * SEQ;
constexpr int LDY_E = 2560, LDY_O = 3072;
constexpr float QSCALE = 0.125f * 1.4426950408889634f;
constexpr size_t MiB = 1u << 20;
constexpr size_t WS_SS = 5 * MiB + 512 * 1024;
constexpr size_t WS_SUM = 3 * MiB;
constexpr size_t WS_LRUW = 5 * MiB;
constexpr size_t WS_ROPE = 8 * MiB;
constexpr size_t WS_WINE = 16 * MiB;
constexpr size_t WS_WINO = 28 * MiB;
constexpr size_t WS_WOUT = 44 * MiB;
constexpr size_t WS_WG = 52 * MiB;
constexpr size_t WS_WP = 60 * MiB;
constexpr size_t WS_PB = 64 * MiB;
constexpr size_t WS_HB0 = 80 * MiB;
constexpr size_t WS_OMIX = 144 * MiB;
constexpr size_t WS_Y = 208 * MiB;
constexpr size_t WS_PP = WS_Y, WS_HB1 = WS_Y + 64 * MiB;
constexpr size_t WS_VT = 400 * MiB;
constexpr size_t WS_END = 464 * MiB;
constexpr int LDS_BYTES = 147456;
constexpr int NTHREADS = 512;

struct Params {
    const float* x; const float* p; const int* pos; const float* norm_mix; const float* norm_ple; const float* w_ple_gate; const float* w_ple_proj;
    const float* w_in_e; const float* conv_w; const float* conv_b; const float* lru_wa; const float* lru_ba; const float* lru_wx; const float* lru_bx; const float* lru_lambda; const float* w_out_e;
    const float* w_in_o; const float* lq1; const float* lk1; const float* lq2; const float* lk2; const float* subln_g; const float* w_out_o; const float* final_norm;
    float* out; unsigned char* ws;
    float lam_init[2]; float pad[2];
};

typedef const __attribute__((address_space(4))) Params* KPtr;
#define KP_GET() ({ KPtr kp_ = (KPtr)__builtin_amdgcn_kernarg_segment_ptr(); asm volatile("" : "+s"(kp_)); kp_; })
template <class T> __device__ __forceinline__ T* G_(T* p) { __attribute__((address_space(1))) T* g = (__attribute__((address_space(1))) T*)p; asm("" : "+s"(g)); return (T*)g; }
__device__ const float INV_FREQ[32] = {1.000000000e+00f, 7.498942018e-01f, 5.623413324e-01f, 4.216965139e-01f, 3.162277639e-01f, 2.371373773e-01f, 1.778279394e-01f, 1.333521456e-01f, 1.000000015e-01f, 7.498942316e-02f, 5.623413250e-02f, 4.216964915e-02f, 3.162277490e-02f, 2.371373773e-02f, 1.778279431e-02f, 1.333521400e-02f, 9.999999776e-03f, 7.498942316e-03f, 5.623413250e-03f, 4.216964822e-03f, 3.162277630e-03f, 2.371373819e-03f, 1.778279431e-03f, 1.333521446e-03f, 1.000000047e-03f, 7.498941850e-04f, 5.623413017e-04f, 4.216965172e-04f, 3.162277571e-04f, 2.371373703e-04f, 1.778279402e-04f, 1.333521504e-04f};
__device__ __forceinline__ float bf2f(bf16 u) { return __uint_as_float((unsigned)u << 16); }
typedef float f32x2_t __attribute__((ext_vector_type(2))); typedef __bf16 bf16x2_t __attribute__((ext_vector_type(2)));
__device__ __forceinline__ unsigned cvtpk(float lo, float hi) { f32x2_t v = {lo, hi}; bf16x2_t b = __builtin_convertvector(v, bf16x2_t); return __builtin_bit_cast(unsigned, b); }
__device__ __forceinline__ bf16 f2bf(float f) { return (bf16)(cvtpk(f, 0.f) & 0xffffu); }
__device__ __forceinline__ float wave_sum(float v) {
#pragma unroll
    for (int o = 1; o < 64; o <<= 1) v += __shfl_xor(v, o);
    return v;
}
__device__ __forceinline__ int crow(int r, int hi) { return (r & 3) + 8 * (r >> 2) + 4 * hi; }
#define GLDS16(gptr, ldsptr) __builtin_amdgcn_global_load_lds((const unsigned*)(gptr), (LAS unsigned*)(ldsptr), 16, 0, 0)
#define MFMA32(a, b, c) __builtin_amdgcn_mfma_f32_32x32x16_bf16((a), (b), (c), 0, 0, 0)

__device__ __forceinline__ void colmap(int kind, int np, int& src, float& sc) {
    src = np; sc = 1.f;
    if (kind == 2) {
        if (np >= 1024 && np < 1536) sc = QSCALE;
        else if (np >= 2048 && np < 2560) src = np + 512;
        else if (np >= 2560) src = np - 512;
    } else if (kind == 3) {
        if (np < 2048) { const int head = np >> 6, s = np & 63, w = s >> 5, fq = (s >> 3) & 3, n = (s >> 2) & 1, i = s & 3; src = head * 64 + 16 * w + 4 * fq + i + 32 * n; if (np < 1024) sc = QSCALE; }
        else if (np < 3072) src = np + 1024;
        else src = np - 1024;
    }
}
__device__ __forceinline__ void wt_item(const float* W, int K, int N, bf16* WT, int nrows, int kind, const float* gk, LAS float* scr, int item, int lane) {
    const int nblk = nrows / 32, kb = item / nblk, nb = item % nblk, k0 = 64 * kb, n0 = 32 * nb;
    int src; float sc; colmap(kind, n0 + (lane & 31), src, sc);
#pragma unroll 8
    for (int i = 0; i < 32; ++i) { const int kk = 2 * i + (lane >> 5); const float g = gk ? gk[k0 + kk] : 1.f; scr[kk * 33 + (lane & 31)] = W[(size_t)(k0 + kk) * N + src] * (g * sc); }
    const int c = lane & 7;
#pragma unroll
    for (int j = 0; j < 4; ++j) { const int n = (lane >> 3) + 8 * j; const LAS float* s = scr + (8 * c) * 33 + n;
        u32x4 o; o.x = cvtpk(s[0 * 33], s[1 * 33]); o.y = cvtpk(s[2 * 33], s[3 * 33]); o.z = cvtpk(s[4 * 33], s[5 * 33]); o.w = cvtpk(s[6 * 33], s[7 * 33]);
        *(u32x4*)(WT + (size_t)(n0 + n) * K + k0 + 8 * c) = o; }
}
__device__ __forceinline__ void sincos_acc(float af, float& s, float& c) {
    const double a = (double)af; const double q = rint(a * 0.63661977236758134308); const double r = fma(-q, 1.57079632679489661923, a) - q * 6.123233995736766e-17;
    const double r2 = r * r;
    const double sp = r * (1.0 + r2 * (-1.0 / 6 + r2 * (1.0 / 120 + r2 * (-1.0 / 5040 + r2 * (1.0 / 362880 + r2 * (-1.0 / 39916800 + r2 * (1.0 / 6227020800.0)))))));
    const double cp = 1.0 + r2 * (-0.5 + r2 * (1.0 / 24 + r2 * (-1.0 / 720 + r2 * (1.0 / 40320 + r2 * (-1.0 / 3628800 + r2 * (1.0 / 479001600.0 + r2 * (-1.0 / 87178291200.0)))))));
    const int qi = ((int)q) & 3;
    const double ss = (qi == 0) ? sp : (qi == 1) ? cp : (qi == 2) ? -sp : -cp;
    const double cc = (qi == 0) ? cp : (qi == 1) ? -sp : (qi == 2) ? -cp : sp;
    s = (float)ss; c = (float)cc;
}

__device__ __forceinline__ void prologue(KPtr P, LAS unsigned char* lds, int vcu, int G, int wave, int lane) {
    unsigned char* ws = G_(P->ws);
    LAS float* scr = (LAS float*)(lds + wave * 16384);
    const int gw = vcu * 8 + wave, NGW = G * 8;
    constexpr int I_E = 16 * 96, I_O = 16 * 128, I_S = 16 * 32, I_P = 4 * 32;
    constexpr int I_L = 2 * 16 * 2;
    constexpr int NITEMS = 2 * I_E + 2 * I_O + 4 * I_S + 4 * I_S + 4 * I_P + I_L;
    for (int it = gw; it < NITEMS; it += NGW) {
        int r = it;
        if (r < 2 * I_E) { const int j = r / I_E; wt_item(G_(P->w_in_e) + (size_t)j * 1024 * 3072, 1024, 3072, (bf16*)(ws + WS_WINE) + (size_t)j * 3072 * 1024, 3072, 2, G_(P->norm_mix) + (2 * j) * 1024, scr, r % I_E, lane); continue; } r -= 2 * I_E;
        if (r < 2 * I_O) { const int j = r / I_O; wt_item(G_(P->w_in_o) + (size_t)j * 1024 * 4096, 1024, 4096, (bf16*)(ws + WS_WINO) + (size_t)j * 4096 * 1024, 4096, 3, G_(P->norm_mix) + (2 * j + 1) * 1024, scr, r % I_O, lane); continue; } r -= 2 * I_O;
        if (r < 4 * I_S) { const int i = r / I_S; const float* src = (i & 1) ? G_(P->w_out_o) + (size_t)(i >> 1) * 1024 * 1024 : G_(P->w_out_e) + (size_t)(i >> 1) * 1024 * 1024;
            wt_item(src, 1024, 1024, (bf16*)(ws + WS_WOUT) + (size_t)i * 1024 * 1024, 1024, 0, nullptr, scr, r % I_S, lane); continue; } r -= 4 * I_S;
        if (r < 4 * I_S) { const int i = r / I_S; wt_item(G_(P->w_ple_gate) + (size_t)i * 1024 * 1024, 1024, 1024, (bf16*)(ws + WS_WG) + (size_t)i * 1024 * 1024, 1024, 1, G_(P->norm_ple) + i * 1024, scr, r % I_S, lane); continue; } r -= 4 * I_S;
        if (r < 4 * I_P) { const int i = r / I_P; wt_item(G_(P->w_ple_proj) + (size_t)i * 256 * 1024, 256, 1024, (bf16*)(ws + WS_WP) + (size_t)i * 1024 * 256, 1024, 0, nullptr, scr, r % I_P, lane); continue; } r -= 4 * I_P;
        { const int gate = r >> 5, blk = (r >> 1) & 15; wt_item((gate ? G_(P->lru_wx) : G_(P->lru_wa)) + (size_t)blk * 4096, 64, 64, (bf16*)(ws + WS_LRUW) + (size_t)(gate * 16 + blk) * 4096, 64, 0, nullptr, scr, r & 1, lane); }
    }
    pg8::ss_t* SS = (pg8::ss_t*)(ws + WS_SS);
    for (int m0 = 4 * gw; m0 < MT; m0 += 4 * NGW) {
        f32x4 v[4][4];
#pragma unroll
        for (int q = 0; q < 4; ++q) { const f32x4* xr = (const f32x4*)(G_(P->x) + (size_t)(m0 + q) * DM) + lane;
#pragma unroll
            for (int j = 0; j < 4; ++j) v[q][j] = xr[64 * j]; }
#pragma unroll
        for (int q = 0; q < 4; ++q) { float s = 0.f; unsigned long long* o8 = (unsigned long long*)((bf16*)(ws + WS_HB0) + (size_t)(m0 + q) * DM) + lane;
#pragma unroll
            for (int j = 0; j < 4; ++j) { const f32x4 w = v[q][j]; s += (w.x * w.x + w.y * w.y) + (w.z * w.z + w.w * w.w);
                o8[64 * j] = (unsigned long long)cvtpk(w.x, w.y) | ((unsigned long long)cvtpk(w.z, w.w) << 32); }
            s = wave_sum(s); if (lane == 0) SS[m0 + q] = (pg8::ss_t)(s * 4294967296.0f); }
    }
    { const int gt = gw * 64 + lane, NT = NGW * 64; for (int i = gt; i < 8 * MT; i += NT) SS[MT + i] = 0ull; }
    { const int gt = gw * 64 + lane, NT = NGW * 64; float* R = (float*)(ws + WS_ROPE);
      for (int i = gt; i < MT * 32; i += NT) { const int m = i >> 5, f = i & 31; const float ang = (float)G_(P->pos)[m] * INV_FREQ[f]; float s, c; sincos_acc(ang, s, c); R[2 * i] = c; R[2 * i + 1] = s; } }
}
__device__ __forceinline__ void convert_p(KPtr P, unsigned char* wsb, int layer, int vcu, int G, int tid) {
    const f32x4* src = (const f32x4*)(G_(P->p) + (size_t)layer * MT * 256); u32x4* dst = (u32x4*)(wsb + WS_PB);
    const int gt = vcu * NTHREADS + tid, NT = G * NTHREADS;
    for (int i = gt; i < MT * 256 / 8; i += NT) { const f32x4 a = src[2 * i], b = src[2 * i + 1]; u32x4 o; o.x = cvtpk(a.x, a.y); o.y = cvtpk(a.z, a.w); o.z = cvtpk(b.x, b.y); o.w = cvtpk(b.z, b.w); dst[i] = o; }
}
__device__ __forceinline__ void final_norm(KPtr P, int vcu, int G, int wave, int lane) {
    const pg8::ss_t* SS = (const pg8::ss_t*)(G_(P->ws) + WS_SS) + 8 * (size_t)MT;
    const int gw = vcu * 8 + wave, NGW = G * 8;
    f32x4 g[4];
#pragma unroll
    for (int j = 0; j < 4; ++j) g[j] = ((const f32x4*)G_(P->final_norm))[lane + 64 * j];
    for (int m0 = 4 * gw; m0 < MT; m0 += 4 * NGW) {
        f32x4 v[4][4]; float rs[4];
#pragma unroll
        for (int q = 0; q < 4; ++q) { const f32x4* xr = (const f32x4*)(G_(P->out) + (size_t)(m0 + q) * DM) + lane; rs[q] = pg8::ss_rstd(SS[m0 + q]);
#pragma unroll
            for (int j = 0; j < 4; ++j) v[q][j] = xr[64 * j]; }
#pragma unroll
        for (int q = 0; q < 4; ++q) { f32x4* xr = (f32x4*)(G_(P->out) + (size_t)(m0 + q) * DM) + lane;
#pragma unroll
            for (int j = 0; j < 4; ++j) xr[64 * j] = v[q][j] * rs[q] * g[j]; }
    }
}

__device__ __forceinline__ int tperm(int i) { return ((i & 4) << 2) | ((i & 16) >> 1) | ((i & 8) >> 1) | (i & 3); }
__device__ __forceinline__ void lru_unit(KPtr P, unsigned char* wsb, int j, int u, int pass, LAS unsigned char* xct, int lane) {
    asm volatile("" : "+v"(lane));
    const int ch = u & 63, n = (u >> 6) & 7, b = u >> 9, c32 = lane & 31, hi = lane >> 5, cg0 = 64 * n + c32;
    const bf16* Y = (const bf16*)(wsb + WS_Y); bf16* OM = (bf16*)(wsb + WS_OMIX);
    float* SA = (float*)(wsb + WS_SUM); float* SH = SA + 8 * 64 * 512;
    const float* cw = G_(P->conv_w) + j * 4 * 512;
    float w0[2], w1[2], w2[2], w3[2], cbi[2], ba[2], bx[2], c8[2];
    bf16x8 Ba[2][4], Bx[2][4];
#pragma unroll
    for (int cb = 0; cb < 2; ++cb) {
        const int cgi = cg0 + 32 * cb;
        w0[cb] = cw[cgi]; w1[cb] = cw[512 + cgi]; w2[cb] = cw[1024 + cgi]; w3[cb] = cw[1536 + cgi]; cbi[cb] = G_(P->conv_b)[j * 512 + cgi];
        ba[cb] = G_(P->lru_ba)[j * 512 + cgi]; bx[cb] = G_(P->lru_bx)[j * 512 + cgi];
        const float lam = G_(P->lru_lambda)[j * 512 + cgi];
        c8[cb] = 8.0f * (fminf(lam, 0.f) - log1pf(__expf(-fabsf(lam))));
        const bf16* wa = (const bf16*)(wsb + WS_LRUW) + ((size_t)((j * 8 + n) * 64 + c32 + 32 * cb)) * 64 + 8 * hi; const bf16* wx = wa + 16 * 4096;
#pragma unroll
        for (int kk = 0; kk < 4; ++kk) { Ba[cb][kk] = *(const bf16x8*)(wa + 16 * kk); Bx[cb][kk] = *(const bf16x8*)(wx + 16 * kk); }
    }
    const size_t tok0 = (size_t)b * SEQ + ch * 64;
    float hc[2] = {0.f, 0.f}; float Ap[2] = {1.f, 1.f};
    if (pass == 1) {
#pragma unroll
        for (int cb = 0; cb < 2; ++cb) { const float* sa = SA + (size_t)b * 64 * 512 + cg0 + 32 * cb; const float* sh = SH + (size_t)b * 64 * 512 + cg0 + 32 * cb; float h = 0.f;
#pragma unroll 16
            for (int c = 0; c < ch; ++c) h = sa[c * 512] * h + sh[c * 512];
            hc[cb] = h; }
    }
    const int arow = tperm(c32), aswz = (arow >> 1) & 7;
    for (int sub = 0; sub < 2; ++sub) {
        const size_t t0 = tok0 + sub * 32 + 16 * hi;
        const bool first = (ch == 0) && (sub == 0) && (hi == 0);
        f32x16 xc[2];
#pragma unroll
        for (int cb = 0; cb < 2; ++cb) {
            const bf16* yp = Y + t0 * LDY_E + cg0 + 32 * cb;
            float x0 = 0.f, x1 = 0.f, x2 = 0.f;
            if (!first) { x0 = bf2f(*(yp - 3 * (ptrdiff_t)LDY_E)); x1 = bf2f(*(yp - 2 * (ptrdiff_t)LDY_E)); x2 = bf2f(*(yp - (ptrdiff_t)LDY_E)); }
#pragma unroll
            for (int r = 0; r < 16; ++r) { const float xv = bf2f(yp[(size_t)r * LDY_E]); xc[cb][r] = cbi[cb] + w0[cb] * x0 + w1[cb] * x1 + w2[cb] * x2 + w3[cb] * xv; x0 = x1; x1 = x2; x2 = xv; }
#pragma unroll
            for (int r = 0; r < 16; ++r) { const int tt = 16 * hi + r, col = c32 + 32 * cb;
                *(LAS bf16*)(xct + tt * 128 + ((((col >> 3) ^ ((tt >> 1) & 7))) << 4) + (col & 7) * 2) = f2bf(xc[cb][r]); }
        }
        f32x16 pa[2], px[2];
        pa[0] = (f32x16){}; pa[1] = (f32x16){}; px[0] = (f32x16){}; px[1] = (f32x16){};
#pragma unroll
        for (int kk = 0; kk < 4; ++kk) {
            const bf16x8 af = *(const LAS bf16x8*)(xct + arow * 128 + (((2 * kk + hi) ^ aswz) << 4));
            pa[0] = MFMA32(af, Ba[0][kk], pa[0]); pa[1] = MFMA32(af, Ba[1][kk], pa[1]); px[0] = MFMA32(af, Bx[0][kk], px[0]); px[1] = MFMA32(af, Bx[1][kk], px[1]);
        }
        float Al[2], Hl[2];
#pragma unroll
        for (int cb = 0; cb < 2; ++cb) {
            float al = 1.f, hl = 0.f;
#pragma unroll
            for (int r = 0; r < 16; ++r) {
                const float rg = __builtin_amdgcn_rcpf(1.0f + __expf(-(pa[cb][r] + ba[cb]))), ig = __builtin_amdgcn_rcpf(1.0f + __expf(-(px[cb][r] + bx[cb])));
                const float la = c8[cb] * rg, a = __expf(la), x2 = 2.0f * la;
                const float ems = -x2 * (1.0f + x2 * (0.5f + x2 * ((1.0f / 6) + x2 * ((1.0f / 24) + x2 * ((1.0f / 120) + x2 * (1.0f / 720))))));
                const float em = (x2 > -0.5f) ? ems : 1.0f - a * a;
                const float uu = sqrtf(em) * (ig * xc[cb][r]);
                pa[cb][r] = a; px[cb][r] = uu; hl = a * hl + uu; al *= a;
            }
            Al[cb] = al; Hl[cb] = hl;
        }
#pragma unroll
        for (int cb = 0; cb < 2; ++cb) {
            const float oA = __shfl_xor(Al[cb], 32), oH = __shfl_xor(Hl[cb], 32);
            const float hmid = hi ? (oA * hc[cb] + oH) : (Al[cb] * hc[cb] + Hl[cb]);
            const float hin = hi ? hmid : hc[cb];
            const float hend = hi ? (Al[cb] * hmid + Hl[cb]) : (oA * hmid + oH);
            Ap[cb] *= Al[cb] * oA;
            if (pass == 1) {
                const bf16* gp = Y + t0 * LDY_E + 512 + cg0 + 32 * cb; bf16* op = OM + t0 * 1024 + cg0 + 32 * cb;
                float h = hin;
#pragma unroll
                for (int r = 0; r < 16; ++r) { h = pa[cb][r] * h + px[cb][r]; const float g = bf2f(gp[(size_t)r * LDY_E]); op[(size_t)r * 1024] = f2bf(h * g * __builtin_amdgcn_rcpf(1.0f + __expf(-g))); }
            }
            hc[cb] = hend;
        }
    }
    if (pass == 0 && hi == 0) {
#pragma unroll
        for (int cb = 0; cb < 2; ++cb) { SA[((size_t)b * 64 + ch) * 512 + cg0 + 32 * cb] = Ap[cb]; SH[((size_t)b * 64 + ch) * 512 + cg0 + 32 * cb] = hc[cb]; }
    }
}

__device__ __forceinline__ int tile_off(int row, int chunk) { return row * 128 + ((chunk ^ ((row >> 1) & 7)) << 4); }
__device__ __forceinline__ int kperm(int i) { return (i & 0x13) | ((i & 4) << 1) | ((i & 8) >> 1); }

__device__ __forceinline__ void sb_unit(KPtr P, unsigned char* wsb, int b, int h, int qb, LAS unsigned char* lds, int tid, int wave, int lane) {
    const bf16* Y = (const bf16*)(wsb + WS_Y); const bf16* VT = (const bf16*)(wsb + WS_VT); bf16* OM = (bf16*)(wsb + WS_OMIX);
    asm volatile("" : "+v"(lane));
    const int r32 = lane & 31, hi = lane >> 5;
    const size_t rowbase = (size_t)b * SEQ; const int q0 = qb * 256, qw0 = q0 + wave * 32;
    const int srow = wave * 8 + (lane >> 3), sch = (lane & 7) ^ ((srow >> 1) & 7);
    const bf16* kg = Y + (rowbase + srow) * LDY_E + 1536 + h * 64 + sch * 8;
    const bf16* vg = VT + ((size_t)(b * 8 + h) * 64) * 4096 + srow * 64 + sch * 8;
    bf16x8 qr[4];
#pragma unroll
    for (int d0 = 0; d0 < 4; ++d0) qr[d0] = *(const bf16x8*)(Y + (rowbase + qw0 + r32) * LDY_E + 1024 + h * 64 + d0 * 16 + hi * 8);
    const int krow = kperm(r32), kswz = (krow >> 1) & 7, vswz = (r32 >> 1) & 7;
    f32x16 o0 = {}, o1 = {};
    float R = 1.0f;
    const int jmax = (q0 + 255) >> 6;
    GLDS16(kg + (size_t)(jmax * 64) * LDY_E, lds + wave * 1024); GLDS16(vg + (size_t)jmax * 4096, lds + 8192 + wave * 1024);
    LAS unsigned* alive = (LAS unsigned*)(lds + 32768);
    if (tid < 3) alive[tid] = 0u;
    __syncthreads();
    int it = 0, aw = 0; bool walive = true;
    for (int j = jmax; j >= 0; --j, ++it) {
        LAS unsigned char* Kb = lds + (it & 1) * 16384; LAS unsigned char* Vb = Kb + 8192;
        if (j > 0) { LAS unsigned char* Kn = lds + ((it + 1) & 1) * 16384 + wave * 1024; GLDS16(kg + (size_t)((j - 1) * 64) * LDY_E, Kn); GLDS16(vg + (size_t)(j - 1) * 4096, Kn + 8192); }
        const int k0 = j * 64;
        if (k0 < qw0 + 31 && walive) {
            f32x16 p0 = {}, p1 = {};
#pragma unroll
            for (int d0 = 0; d0 < 4; ++d0) {
                const int co = ((2 * d0 + hi) ^ kswz) << 4;
                const bf16x8 a0 = *(const LAS bf16x8*)(Kb + krow * 128 + co), a1 = *(const LAS bf16x8*)(Kb + (krow + 32) * 128 + co);
                p0 = MFMA32(a0, qr[d0], p0); p1 = MFMA32(a1, qr[d0], p1);
            }
            const int tq = qw0 + r32; const bool need_mask = (k0 + 63 >= qw0);
            if (need_mask) {
                asm volatile("" ::: );
#pragma unroll
                for (int r = 0; r < 16; ++r) { const int s = k0 + 16 * (r >> 3) + 8 * hi + (r & 7); if (s >= tq) p0[r] = -INFINITY; if (s + 32 >= tq) p1[r] = -INFINITY; }
            }
            f32x16 b0, b1;
#pragma unroll
            for (int r = 0; r < 16; ++r) {
                { const float om = __builtin_amdgcn_rcpf(1.0f + __builtin_amdgcn_exp2f(p0[r])); p0[r] = om; b0[r] = 1.0f - om; }
                { const float om = __builtin_amdgcn_rcpf(1.0f + __builtin_amdgcn_exp2f(p1[r])); p1[r] = om; b1[r] = 1.0f - om; }
            }
            f32x4 own;
            own[0] = ((p0[0] * p0[1]) * (p0[2] * p0[3])) * ((p0[4] * p0[5]) * (p0[6] * p0[7]));
            own[1] = ((p0[8] * p0[9]) * (p0[10] * p0[11])) * ((p0[12] * p0[13]) * (p0[14] * p0[15]));
            own[2] = ((p1[0] * p1[1]) * (p1[2] * p1[3])) * ((p1[4] * p1[5]) * (p1[6] * p1[7]));
            own[3] = ((p1[8] * p1[9]) * (p1[10] * p1[11])) * ((p1[12] * p1[13]) * (p1[14] * p1[15]));
            const float t0 = __shfl_xor(own[0], 32), t1 = __shfl_xor(own[1], 32), t2 = __shfl_xor(own[2], 32), t3 = __shfl_xor(own[3], 32);
            const float a0 = hi ? t0 : own[0], a1 = hi ? own[0] : t0, a2 = hi ? t1 : own[1], a3 = hi ? own[1] : t1, a4 = hi ? t2 : own[2], a5 = hi ? own[2] : t2, a6 = hi ? t3 : own[3], a7 = hi ? own[3] : t3;
            const float s7 = 1.0f, s6 = a7, s5 = s6 * a6, s4 = s5 * a5, s3 = s4 * a4, s2 = s3 * a3, s1 = s2 * a2, s0 = s1 * a1;
            const float total = s0 * a0;
            { float run = (hi ? s1 : s0) * R;
#pragma unroll
              for (int jj = 7; jj >= 0; --jj) { const float w = b0[jj] * run; run *= p0[jj]; b0[jj] = w; } }
            { float run = (hi ? s3 : s2) * R;
#pragma unroll
              for (int jj = 7; jj >= 0; --jj) { const float w = b0[8 + jj] * run; run *= p0[8 + jj]; b0[8 + jj] = w; } }
            { float run = (hi ? s5 : s4) * R;
#pragma unroll
              for (int jj = 7; jj >= 0; --jj) { const float w = b1[jj] * run; run *= p1[jj]; b1[jj] = w; } }
            { float run = (hi ? s7 : s6) * R;
#pragma unroll
              for (int jj = 7; jj >= 0; --jj) { const float w = b1[8 + jj] * run; run *= p1[8 + jj]; b1[8 + jj] = w; } }
            R *= total;
            const u32x4 pw0 = {cvtpk(b0[0], b0[1]), cvtpk(b0[2], b0[3]), cvtpk(b0[4], b0[5]), cvtpk(b0[6], b0[7])}, pw1 = {cvtpk(b0[8], b0[9]), cvtpk(b0[10], b0[11]), cvtpk(b0[12], b0[13]), cvtpk(b0[14], b0[15])};
            const u32x4 pw2 = {cvtpk(b1[0], b1[1]), cvtpk(b1[2], b1[3]), cvtpk(b1[4], b1[5]), cvtpk(b1[6], b1[7])}, pw3 = {cvtpk(b1[8], b1[9]), cvtpk(b1[10], b1[11]), cvtpk(b1[12], b1[13]), cvtpk(b1[14], b1[15])};
#define SB_PV(kk, pw) { const int co = ((2 * (kk) + hi) ^ vswz) << 4; const bf16x8 v0 = *(const LAS bf16x8*)(Vb + r32 * 128 + co), v1 = *(const LAS bf16x8*)(Vb + (r32 + 32) * 128 + co); \
                o0 = MFMA32(__builtin_bit_cast(bf16x8, pw), v0, o0); o1 = MFMA32(__builtin_bit_cast(bf16x8, pw), v1, o1); }
            SB_PV(0, pw0) SB_PV(1, pw1) SB_PV(2, pw2) SB_PV(3, pw3)
#undef SB_PV
        }
        const int an = (aw == 2) ? 0 : aw + 1;
        walive = __any(R != 0.0f);
        if (walive && lane == 0) alive[aw] = 1u;
        if (tid == 0) alive[an] = 0u;
        __syncthreads();
        if (alive[aw] == 0u) break;
        aw = an;
    }
    int r32e = r32; asm volatile("" : "+v"(r32e));
#pragma unroll
    for (int r = 0; r < 16; ++r) {
        const size_t tok = rowbase + qw0 + crow(r, hi);
        const float g0 = bf2f(Y[tok * LDY_E + 2048 + h * 64 + r32e]), g1 = bf2f(Y[tok * LDY_E + 2048 + h * 64 + 32 + r32e]);
        OM[tok * 1024 + 512 + h * 64 + r32e] = f2bf(o0[r] * g0 * __builtin_amdgcn_rcpf(1.0f + __expf(-g0)));
        OM[tok * 1024 + 512 + h * 64 + 32 + r32e] = f2bf(o1[r] * g1 * __builtin_amdgcn_rcpf(1.0f + __expf(-g1)));
    }
    __syncthreads();
}

__device__ __forceinline__ void diff_map_half(LAS unsigned char* Qb  , LAS unsigned char* Kb, LAS unsigned char* Vb, LAS float* wsf, f32x16 (&O)[4], float& mrow, float& lrow,
                                              int kbase  , int p, int tq, bool need_mask, int krow, int kswz, int vswz, int r32, int hi) {
    f32x16 s = {};
#pragma unroll
    for (int d0 = 0; d0 < 4; ++d0) {
        const int co = ((2 * d0 + hi) ^ kswz) << 4;
        const bf16x8 a0 = *(const LAS bf16x8*)(Kb + (krow + 32 * p) * 128 + co);
        const bf16x8 qf = *(const LAS bf16x8*)(Qb + r32 * 128 + (((2 * d0 + hi) ^ vswz) << 4));
        s = MFMA32(a0, qf, s);
    }
    if (need_mask) {
        asm volatile("" ::: );
#pragma unroll
        for (int r = 0; r < 16; ++r) { const int key = kbase + 16 * (r >> 3) + 8 * hi + (r & 7); if (key > tq) s[r] = -INFINITY; }
    }
    float mx = fmaxf(s[0], s[1]);
#pragma unroll
    for (int r = 2; r < 16; ++r) mx = fmaxf(mx, s[r]);
    { const auto rr = __builtin_amdgcn_permlane32_swap(__float_as_uint(mx), __float_as_uint(mx), false, false); mx = fmaxf(__uint_as_float(rr[0]), __uint_as_float(rr[1])); }
    constexpr float DIFF_THR = 8.0f;
    float mnew = mrow;
    if (__any(mx > mrow + DIFF_THR)) {
        mnew = fmaxf(mrow, mx);
        const float alpha = __builtin_amdgcn_exp2f(mrow - mnew);
        lrow *= alpha;
        if (hi == 0) wsf[r32] = alpha;
#pragma unroll
        for (int r = 0; r < 16; ++r) { const float al = wsf[crow(r, hi)];
#pragma unroll
            for (int dd = 0; dd < 4; ++dd) O[dd][r] *= al; }
    }
    mrow = mnew;
    float sum = 0.f;
#pragma unroll
    for (int r = 0; r < 16; ++r) { s[r] = __builtin_amdgcn_exp2f(s[r] - mnew); sum += s[r]; }
    lrow += sum;
    const u32x4 pw0 = {cvtpk(s[0], s[1]), cvtpk(s[2], s[3]), cvtpk(s[4], s[5]), cvtpk(s[6], s[7])}, pw1 = {cvtpk(s[8], s[9]), cvtpk(s[10], s[11]), cvtpk(s[12], s[13]), cvtpk(s[14], s[15])};
#pragma unroll
    for (int dd = 0; dd < 4; ++dd) {
        const bf16x8 v0 = *(const LAS bf16x8*)(Vb + (r32 + 32 * dd) * 128 + (((4 * p + hi) ^ vswz) << 4)), v1 = *(const LAS bf16x8*)(Vb + (r32 + 32 * dd) * 128 + (((4 * p + 2 + hi) ^ vswz) << 4));
        O[dd] = MFMA32(__builtin_bit_cast(bf16x8, pw0), v0, O[dd]); O[dd] = MFMA32(__builtin_bit_cast(bf16x8, pw1), v1, O[dd]);
    }
}

__device__ __forceinline__ void diff_unit(KPtr P, unsigned char* wsb, int jl, float lam, int b, int h, int qb, LAS unsigned char* lds, int tid, int wave, int lane) {
    const bf16* Y = (const bf16*)(wsb + WS_Y); const bf16* VT = (const bf16*)(wsb + WS_VT); bf16* OM = (bf16*)(wsb + WS_OMIX);
    asm volatile("" : "+v"(lane));
    const int r32 = lane & 31, hi = lane >> 5;
    const size_t rowbase = (size_t)b * SEQ; const int q0 = qb * 256, qw0 = q0 + wave * 32;
    const int srow = wave * 8 + (lane >> 3), sch = (lane & 7) ^ ((srow >> 1) & 7);
    const bf16* k1g = Y + (rowbase + srow) * LDY_O + 1024 + (2 * h) * 64 + sch * 8;
    const bf16* k2g = k1g + 64;
    const bf16* vg = VT + ((size_t)(b * 8 + h) * 64) * 8192 + srow * 64 + sch * 8;
    constexpr int BUF = 32768;
    LAS float* wsf = (LAS float*)(lds + 2 * BUF) + wave * 64;
    LAS unsigned char* Q1b = lds + 2 * BUF + 2048 + wave * 8192; LAS unsigned char* Q2b = Q1b + 4096;
#pragma unroll
    for (int i = 0; i < 4; ++i) { const int qrow = 8 * i + (lane >> 3), qch = (lane & 7) ^ ((qrow >> 1) & 7); const bf16* qp = Y + (rowbase + qw0 + qrow) * LDY_O + (2 * h) * 64 + qch * 8;
        GLDS16(qp, Q1b + i * 1024); GLDS16(qp + 64, Q2b + i * 1024); }
    const int krow = kperm(r32), kswz = (krow >> 1) & 7, vswz = (r32 >> 1) & 7;
    f32x16 O1[4], O2[4];
#pragma unroll
    for (int dd = 0; dd < 4; ++dd) { O1[dd] = (f32x16){}; O2[dd] = (f32x16){}; }
    float m1 = -INFINITY, m2 = -INFINITY, l1 = 0.f, l2 = 0.f;
    const int jmax = (q0 + 255) >> 6;
    { LAS unsigned char* Bn = lds + wave * 1024; GLDS16(k1g, Bn); GLDS16(k2g, Bn + 8192); GLDS16(vg, Bn + 16384); GLDS16(vg + 4096, Bn + 24576); }
    __syncthreads();
    const int tq = qw0 + r32;
    for (int j = 0; j <= jmax; ++j) {
        LAS unsigned char* B0 = lds + (j & 1) * BUF;
        if (j < jmax) { const size_t ko = (size_t)(j + 1) * 64; LAS unsigned char* Bn = lds + ((j + 1) & 1) * BUF + wave * 1024; GLDS16(k1g + ko * LDY_O, Bn); GLDS16(k2g + ko * LDY_O, Bn + 8192); GLDS16(vg + (size_t)(j + 1) * 8192, Bn + 16384); GLDS16(vg + (size_t)(j + 1) * 8192 + 4096, Bn + 24576); }
        const int k0 = j * 64;
        if (k0 <= qw0 + 31) {
            const bool need_mask = (k0 + 63 > qw0);
            diff_map_half(Q1b, B0, B0 + 16384, wsf, O1, m1, l1, k0, 0, tq, need_mask, krow, kswz, vswz, r32, hi);
            diff_map_half(Q2b, B0 + 8192, B0 + 16384, wsf + 32, O2, m2, l2, k0, 0, tq, need_mask, krow, kswz, vswz, r32, hi);
            if (k0 + 32 <= qw0 + 31) {
                diff_map_half(Q1b, B0, B0 + 16384, wsf, O1, m1, l1, k0 + 32, 1, tq, need_mask, krow, kswz, vswz, r32, hi);
                diff_map_half(Q2b, B0 + 8192, B0 + 16384, wsf + 32, O2, m2, l2, k0 + 32, 1, tq, need_mask, krow, kswz, vswz, r32, hi);
            }
        }
        __syncthreads();
    }
    l1 += __shfl_xor(l1, 32); l2 += __shfl_xor(l2, 32);
    int r32e = r32; asm volatile("" : "+v"(r32e));
    if (hi == 0) { wsf[r32] = __builtin_amdgcn_rcpf(l1); wsf[32 + r32] = lam * __builtin_amdgcn_rcpf(l2); }
    const float* sg = G_(P->subln_g) + jl * 128; const float post = 1.0f - P->lam_init[jl];
    f32x4 gsc;
#pragma unroll
    for (int dd = 0; dd < 4; ++dd) gsc[dd] = sg[32 * dd + r32e] * post;
#pragma unroll
    for (int r = 0; r < 16; ++r) {
        const int qr_ = crow(r, hi); const float i1 = wsf[qr_], i2 = wsf[32 + qr_];
        f32x4 v; float sq = 0.f;
#pragma unroll
        for (int dd = 0; dd < 4; ++dd) { v[dd] = O1[dd][r] * i1 - O2[dd][r] * i2; sq += v[dd] * v[dd]; }
        sq += __shfl_xor(sq, 1); sq += __shfl_xor(sq, 2); sq += __shfl_xor(sq, 4); sq += __shfl_xor(sq, 8); sq += __shfl_xor(sq, 16);
        const float rn = __builtin_amdgcn_rsqf(sq * (1.0f / 128.0f) + 1e-6f);
        const size_t tok = rowbase + qw0 + qr_;
#pragma unroll
        for (int dd = 0; dd < 4; ++dd) { const float g = bf2f(Y[tok * LDY_O + 2048 + h * 128 + 32 * dd + r32e]);
            OM[tok * 1024 + h * 128 + 32 * dd + r32e] = f2bf(v[dd] * rn * gsc[dd] * g * __builtin_amdgcn_rcpf(1.0f + __expf(-g))); }
    }
    __syncthreads();
}

#define XB_TMO      128
#define XB_XCNT(j)  (256  + 64 * (j))
#define XB_XSUB(j)  (1280 + 64 * (j))
#define XB_XGEN(j)  (2304 + 64 * (j))
#define XB_TOP      3328
#define XB_TOPGEN   3392
#define XCD_BAR_WORDS 3456
#define XB_SPIN_CAP (1u << 18)

__device__ __forceinline__ unsigned xb_ld(unsigned* p)              { return __hip_atomic_load(p, __ATOMIC_RELAXED, __HIP_MEMORY_SCOPE_AGENT); }
__device__ __forceinline__ unsigned xb_add(unsigned* p, unsigned v) { return __hip_atomic_fetch_add(p, v, __ATOMIC_RELAXED, __HIP_MEMORY_SCOPE_AGENT); }
__device__ __forceinline__ unsigned xb_xcc_id() { return (unsigned)__builtin_amdgcn_s_getreg((3 << 11) | 20) & 0xFu; }
#define XB_SPIN(cond, bar) do { unsigned _sp = 0; while (cond) { __builtin_amdgcn_s_sleep(1); \
    if ((++_sp & 255u) == 0u) { if (xb_ld(&(bar)[XB_TMO])) break; if (_sp > XB_SPIN_CAP) { atomicAdd(&(bar)[XB_TMO], 1u); break; } } } } while (0)

struct XcdBarrier {
    unsigned* bar; unsigned x;
    volatile LAS unsigned* st;
};

__device__ __forceinline__ XcdBarrier xcd_barrier_post(unsigned* bar, volatile LAS unsigned* st) {
    XcdBarrier b; b.bar = bar; b.x = xb_xcc_id(); b.st = st;
    if (threadIdx.x == 0) (void)xb_add(&bar[XB_XCNT(b.x)], 1u);
    return b;
}
__device__ __forceinline__ void xcd_barrier_complete(unsigned* bar, unsigned x, unsigned& nloc, unsigned& nx) {
    const unsigned G = gridDim.x * gridDim.y * gridDim.z;
    unsigned sum, cnt, mine, sp = 0u;
    for (;;) {
        sum = 0u; cnt = 0u; mine = 0u;
#pragma unroll
        for (unsigned j = 0; j < 16; ++j) { const unsigned c = xb_ld(&bar[XB_XCNT(j)]); sum += c; cnt += (c > 0u) ? 1u : 0u; mine = (j == x) ? c : mine; }
        if (sum == G) break;
        __builtin_amdgcn_s_sleep(1);
        if ((++sp & 255u) == 0u) { if (xb_ld(&bar[XB_TMO])) break; if (sp > XB_SPIN_CAP) { atomicAdd(&bar[XB_TMO], 1u); break; } }
    }
    nloc = mine > 0u ? mine : 1u; nx = cnt > 0u ? cnt : 1u;
}

__device__ __forceinline__ void xcd_barrier(const XcdBarrier& b) {
    asm volatile("s_waitcnt vmcnt(0)" ::: "memory");
    __syncthreads();
    if (threadIdx.x == 0) {
        unsigned* bar = b.bar;
        __builtin_amdgcn_s_waitcnt(0);
        unsigned nloc = b.st[0], nx = b.st[1];
        if (nloc == 0u) { xcd_barrier_complete(bar, b.x, nloc, nx); b.st[0] = nloc; b.st[1] = nx; }
        const unsigned old = xb_add(&bar[XB_XSUB(b.x)], 1u);
        const unsigned gen = old / nloc;
        if (old + 1u == (gen + 1u) * nloc) {
            __builtin_amdgcn_fence(__ATOMIC_RELEASE, "agent");
            asm volatile("s_waitcnt vmcnt(0)" ::: "memory");
            const unsigned og = xb_add(&bar[XB_TOP], 1u);
            const unsigned tg = og / nx;
            if (og + 1u == (tg + 1u) * nx) xb_add(&bar[XB_TOPGEN], 1u);
            else XB_SPIN(xb_ld(&bar[XB_TOPGEN]) == tg, bar);
            __builtin_amdgcn_fence(__ATOMIC_ACQUIRE, "agent");
            xb_add(&bar[XB_XGEN(b.x)], 1u);
            asm volatile("s_waitcnt vmcnt(0)" ::: "memory");
        } else {
            XB_SPIN(xb_ld(&bar[XB_XGEN(b.x)]) == gen, bar);
            __builtin_amdgcn_fence(__ATOMIC_ACQUIRE, "agent");
            asm volatile("s_waitcnt vmcnt(0)" ::: "memory");
        }
    }
    __syncthreads();
}

#ifndef DUP_MASK
#define DUP_MASK 0
#endif
#define GSYNC() do { xcd_barrier(xbar); if (DUP_MASK & 128) xcd_barrier(xbar); } while (0)
__global__ void __launch_bounds__(NTHREADS, 2) trunk_fwd(Params Pv) {
    extern __shared__ __attribute__((aligned(16))) unsigned char lds_raw[];
    LAS unsigned char* lds = (LAS unsigned char*)lds_raw;
    cg::grid_group grid = cg::this_grid();
    const int tid0 = threadIdx.x, lane0 = tid0 & 63, wave0 = __builtin_amdgcn_readfirstlane(tid0 >> 6);
    const int G = gridDim.x, bx = blockIdx.x, vcu = (G % 8 == 0) ? (bx % 8) * (G / 8) + bx / 8 : bx;

    volatile LAS unsigned* bst = (volatile LAS unsigned*)(lds + LDS_BYTES - 64);
    if (tid0 < 2) bst[tid0] = 0u;
    __syncthreads();
    XcdBarrier xbar;
    { KPtr P = KP_GET(); xbar = xcd_barrier_post((unsigned*)G_(P->ws), bst);
      prologue(P, lds, vcu, G, wave0, lane0);
      convert_p(P, G_(P->ws), 0, vcu, G, tid0); }
    grid.sync();

    for (int layer = 0; layer < 4; ++layer) {
        const int jl = layer >> 1; const bool odd = layer & 1;
        int tid = threadIdx.x; asm volatile("" : "+v"(tid));
        KPtr P = KP_GET();
        unsigned char* ws = P->ws; asm volatile("" : "+s"(ws)); ws = G_(ws);
        pg8::ss_t* SS = (pg8::ss_t*)(ws + WS_SS);
        bf16* HB0 = (bf16*)(ws + WS_HB0); bf16* HB1 = (bf16*)(ws + WS_HB1); bf16* OMIX = (bf16*)(ws + WS_OMIX); bf16* Yb = (bf16*)(ws + WS_Y); bf16* VTb = (bf16*)(ws + WS_VT); bf16* PPb = (bf16*)(ws + WS_PP); bf16* PBb = (bf16*)(ws + WS_PB);
        const int lane = tid & 63, wave = __builtin_amdgcn_readfirstlane(tid >> 6);
        const pg8::ss_t* ss_mix = SS + (size_t)layer * MT; pg8::ss_t* ss_ple = SS + (size_t)(4 + layer) * MT; pg8::ss_t* ss_next = SS + (size_t)(layer < 3 ? layer + 1 : 8) * MT;
        {
            const bf16* Wt = odd ? (const bf16*)(ws + WS_WINO) + (size_t)jl * 4096 * 1024 : (const bf16*)(ws + WS_WINE) + (size_t)jl * 3072 * 1024;
            const int nmain = odd ? 3072 : 2560, nv = odd ? 1024 : 512;
            for (int rep = 0; rep < ((DUP_MASK & 1) ? 2 : 1); ++rep) {
            { pg8::Gemm g{HB0, Wt, MT, nmain, 1024}; pg8::StaticOrder S; S.init(MT, nmain, G, bx);
              pg8::EpiY E{Yb, nmain, ss_mix, (const float*)(ws + WS_ROPE), odd ? 8 : 0};
              pg8::gemm_phase<pg8::EpiY, pg8::StaticOrder, true, true>(lds, g, S, E); }
            { pg8::Gemm g{Wt + (size_t)nmain * 1024, HB0, nv, MT, 1024}; pg8::StaticOrder S; S.init(nv, MT, G, bx);
              pg8::EpiVt E{VTb, odd ? 7 : 6, ss_mix};
              pg8::gemm_phase<pg8::EpiVt, pg8::StaticOrder, true, true>(lds, g, S, E); }
            }
        }
        GSYNC();
        if (!odd) {
            LAS unsigned char* xct = lds + wave * 4096;
            for (int rep = 0; rep < ((DUP_MASK & 2) ? 2 : 1); ++rep)
            for (int u = vcu * 8 + wave; u < 4096; u += G * 8) lru_unit(P, ws, jl, u, 0, xct, lane);
            if (layer > 0) convert_p(P, ws, layer, vcu, G, tid);
            GSYNC();
            for (int rep = 0; rep < ((DUP_MASK & 2) ? 2 : 1); ++rep)
            for (int u = vcu * 8 + wave; u < 4096; u += G * 8) lru_unit(P, ws, jl, u, 1, xct, lane);
            __syncthreads();
            for (int rep = 0; rep < ((DUP_MASK & 8) ? 2 : 1); ++rep)
            for (int vv = vcu; vv < 256; vv += G)
                for (int i = 0; i < 4; ++i) { const int li = vv & 31, bh = 8 * (vv >> 5) + 2 * i + (li >> 4), qb = (i & 1) ? 15 - (li & 15) : (li & 15); sb_unit(P, ws, bh >> 3, bh & 7, qb, lds, tid, wave, lane); }
        } else {
            float lam;
            { const float a = wave_sum(lane < 64 ? G_(P->lq1)[jl * 64 + lane] * G_(P->lk1)[jl * 64 + lane] : 0.f), c = wave_sum(G_(P->lq2)[jl * 64 + lane] * G_(P->lk2)[jl * 64 + lane]); lam = __expf(a) - __expf(c) + P->lam_init[jl]; }
            convert_p(P, ws, layer, vcu, G, tid);
            for (int rep = 0; rep < ((DUP_MASK & 16) ? 2 : 1); ++rep)
            for (int vv = vcu; vv < 256; vv += G)
                for (int i = 0; i < 4; ++i) { const int li = vv & 31, bh = 8 * (vv >> 5) + 2 * i + (li >> 4), qb = (i & 1) ? 15 - (li & 15) : (li & 15); diff_unit(P, ws, jl, lam, bh >> 3, bh & 7, qb, lds, tid, wave, lane); }
        }
        GSYNC();
        {
            { pg8::Gemm g{OMIX, (const bf16*)(ws + WS_WOUT) + (size_t)layer * 1024 * 1024, MT, 1024, 1024}; pg8::StaticOrder S; S.init(MT, 1024, G, bx);
              pg8::EpiRes E{layer == 0 ? G_(P->x) : G_(P->out), G_(P->out), HB1, ss_ple};
              pg8::gemm_phase<pg8::EpiRes, pg8::StaticOrder, true, true>(lds, g, S, E); }
            { pg8::Gemm g{PBb, (const bf16*)(ws + WS_WP) + (size_t)layer * 1024 * 256, MT, 1024, 256}; pg8::StaticOrder S; S.init(MT, 1024, G, bx);
              pg8::EpiPlain E{PPb, 1024};
              pg8::gemm_phase<pg8::EpiPlain, pg8::StaticOrder, false, true>(lds, g, S, E); }
        }
        GSYNC();
        {
            pg8::Gemm g{HB1, (const bf16*)(ws + WS_WG) + (size_t)layer * 1024 * 1024, MT, 1024, 1024}; pg8::StaticOrder S; S.init(MT, 1024, G, bx);
            pg8::EpiGate E{ss_ple, HB1, G_(P->out), PPb, HB0, ss_next};
            pg8::gemm_phase<pg8::EpiGate, pg8::StaticOrder, true, true>(lds, g, S, E);
        }
        GSYNC();
    }
    { KPtr P = KP_GET(); final_norm(P, vcu, G, wave0, lane0); }
}

extern "C" void kernel_launch(void* const* d_in, const int* in_sizes, int n_in, void* d_out, int out_size, void* d_ws, size_t ws_size, hipStream_t stream) {
    static int grid = 0;
    if (grid == 0) {
        if (n_in != 24 || out_size != MT * DM || ws_size < WS_END) { fprintf(stderr, "kernel_launch: unexpected problem (n_in %d out %d ws %zu)\n", n_in, out_size, ws_size); grid = -1; return; }
        int dev = 0, cus = 0, per_cu = 0;
        hipGetDevice(&dev); hipDeviceGetAttribute(&cus, hipDeviceAttributeMultiprocessorCount, dev);
        hipFuncSetAttribute((const void*)trunk_fwd, hipFuncAttributeMaxDynamicSharedMemorySize, LDS_BYTES);
        hipOccupancyMaxActiveBlocksPerMultiprocessor(&per_cu, (const void*)trunk_fwd, NTHREADS, LDS_BYTES);
        (void)hipGetLastError();
        if (per_cu < 1) per_cu = 1;
        grid = cus;
        if (grid > 256) grid = 256;
        grid &= ~7;
    }
    if (grid <= 0) return;
    Params P{};
    P.x = (const float*)d_in[0]; P.p = (const float*)d_in[1]; P.pos = (const int*)d_in[2]; P.norm_mix = (const float*)d_in[3]; P.norm_ple = (const float*)d_in[4];
    P.w_ple_gate = (const float*)d_in[5]; P.w_ple_proj = (const float*)d_in[6]; P.w_in_e = (const float*)d_in[7]; P.conv_w = (const float*)d_in[8]; P.conv_b = (const float*)d_in[9];
    P.lru_wa = (const float*)d_in[10]; P.lru_ba = (const float*)d_in[11]; P.lru_wx = (const float*)d_in[12]; P.lru_bx = (const float*)d_in[13]; P.lru_lambda = (const float*)d_in[14];
    P.w_out_e = (const float*)d_in[15]; P.w_in_o = (const float*)d_in[16]; P.lq1 = (const float*)d_in[17]; P.lk1 = (const float*)d_in[18]; P.lq2 = (const float*)d_in[19]; P.lk2 = (const float*)d_in[20];
    P.subln_g = (const float*)d_in[21]; P.w_out_o = (const float*)d_in[22]; P.final_norm = (const float*)d_in[23];
    P.out = (float*)d_out; P.ws = (unsigned char*)d_ws;
    P.lam_init[0] = (float)(0.8 - 0.6 * exp(-0.3 * 1.0)); P.lam_init[1] = (float)(0.8 - 0.6 * exp(-0.3 * 3.0));
    if (hipMemsetAsync(d_ws, 0, 65536, stream) != hipSuccess) { fprintf(stderr, "kernel_launch: memset of the barrier words failed\n"); return; }
    void* args[] = {&P};
    hipError_t e = hipLaunchCooperativeKernel((const void*)trunk_fwd, dim3(grid), dim3(NTHREADS), args, LDS_BYTES, stream);
    if (e != hipSuccess) fprintf(stderr, "cooperative launch failed: %s (grid %d)\n", hipGetErrorString(e), grid);
}
```

```cpp
#include <hip/hip_runtime.h>
#include <hip/hip_cooperative_groups.h>
#include <cstdio>
#include <cstdint>
#include <cmath>
namespace pg8 {
#define PG8_LAS __attribute__((address_space(3)))
typedef unsigned short bf16_t;
typedef short bf16x8 __attribute__((ext_vector_type(8)));
typedef float f32x4 __attribute__((ext_vector_type(4)));
typedef unsigned u32x4 __attribute__((ext_vector_type(4)));
constexpr int BM = 256, BK = 64, HALF = 128, HTB = HALF * BK * 2  , STAGE_BYTES = 8 * HTB, NXCD = 8, WGM = 8;

__host__ __device__ __forceinline__ int lds_byte(int r, int c) { const int st = (r >> 4) * 2 + (c >> 5), rr = r & 15, cc = c & 31, ob = rr * 64 + cc * 2; return st * 1024 + (ob ^ (((ob >> 9) & 1) << 5)); }
__host__ __device__ __forceinline__ void stage_rc(int b, int& R, int& C) { const int st = b / 1024, sb = b % 1024, swz = sb ^ (((sb >> 9) & 1) << 5); R = (st >> 1) * 16 + swz / 64; C = (st & 1) * 32 + (swz % 64) / 2; }
__host__ __device__ __forceinline__ int perm32(int rho) { const int n = rho >> 4, i = rho & 15; return 8 * (i >> 2) + 4 * n + (i & 3); }

struct Unit { int pm, pn; };
struct Gemm { const bf16_t* A; const bf16_t* Bt; int M, N, K; };

struct StaticOrder {
    int nM, nN, nwg, G, c;
    __host__ __device__ void init(int M, int N, int G_, int c_) { nM = M / BM; nN = N / BM; nwg = nM * nN; G = G_; c = c_; }
    __host__ __device__ bool next(int i, Unit& u) const {
        const long L = (long)i * G + c; if (L >= nwg) return false;
        int wgid = (int)L; { const int q = nwg / NXCD, r = nwg % NXCD, xcd = wgid % NXCD, off = wgid / NXCD; wgid = (xcd < r ? xcd * (q + 1) : r * (q + 1) + (xcd - r) * q) + off; }
        const int nig = WGM * nN, gid = wgid / nig, fm = gid * WGM, gsz = (nM - fm) < WGM ? (nM - fm) : WGM;
        u.pm = fm + ((wgid % nig) % gsz); u.pn = (wgid % nig) / gsz; return true;
    }
    __device__ __forceinline__ void a_ready(const Unit&) const {}
    __device__ __forceinline__ void done(const Unit&) const {}
};

__device__ __forceinline__ unsigned cvt_pk_bf16(float lo, float hi) { unsigned r; asm volatile("v_cvt_pk_bf16_f32 %0, %1, %2" : "=v"(r) : "v"(lo), "v"(hi)); return r; }
__device__ __forceinline__ float bf2f(unsigned short u) { return __uint_as_float((unsigned)u << 16); }
__device__ __forceinline__ u32x4 pack8(const f32x4& v0, const f32x4& v1) { u32x4 w; w.x = cvt_pk_bf16(v0[0], v0[1]); w.y = cvt_pk_bf16(v0[2], v0[3]); w.z = cvt_pk_bf16(v1[0], v1[1]); w.w = cvt_pk_bf16(v1[2], v1[3]); return w; }
constexpr float RMS_EPS = 1e-6f;
typedef unsigned long long ss_t;
__device__ __forceinline__ float ss_rstd(ss_t v) { return __builtin_amdgcn_rsqf((float)v * (2.3283064365386963e-10f / 1024.0f) + RMS_EPS); }
__device__ __forceinline__ void ss_add(ss_t* p, float sq) { atomicAdd(p, (ss_t)(sq * 4294967296.0f)); }

struct EpiY {
    static constexpr bool PERM = true, AFTER_DRAIN = false;
    bf16_t* O; int ldc; const ss_t* ss; const float* rope; int rope_pn;
    __device__ __forceinline__ void operator()(const f32x4 (&acc)[2][2][4][2], const Unit& u, int wr, int wc, int fr, int fq) const {
        asm volatile("" : "+v"(fr), "+v"(fq));
        const int row0 = u.pm * BM + wr * 64 + fr, col0 = u.pn * BM + wc * 32 + 8 * fq;
        const bool do_rope = u.pn < rope_pn;
#pragma unroll
        for (int ai = 0; ai < 2; ++ai)
#pragma unroll
            for (int m = 0; m < 4; ++m) {
                const int row = row0 + ai * HALF + m * 16;
                const float rstd = ss_rstd(ss[row]);
                f32x4 cs0 = {1.f, 0.f, 1.f, 0.f}, cs1 = {1.f, 0.f, 1.f, 0.f};
                if (do_rope) { const float* rp = rope + (size_t)row * 64 + ((wc & 1) * 16 + 4 * fq) * 2; cs0 = *(const f32x4*)rp; cs1 = *(const f32x4*)(rp + 4); }
                bf16_t* rowp = O + (size_t)row * ldc + col0;
#pragma unroll
                for (int bj = 0; bj < 2; ++bj) {
                    f32x4 v0 = acc[ai][bj][m][0] * rstd, v1 = acc[ai][bj][m][1] * rstd;
                    if (do_rope) {
                        const f32x4 c = {cs0[0], cs0[2], cs1[0], cs1[2]}, s = {cs0[1], cs0[3], cs1[1], cs1[3]};
                        const f32x4 o0 = v0 * c - v1 * s, o1 = v1 * c + v0 * s; v0 = o0; v1 = o1;
                    }
                    *(u32x4*)(rowp + bj * HALF) = pack8(v0, v1);
                }
                if (do_rope && (m & 1)) asm volatile("" ::: "memory");
            }
    }
};
struct EpiVt {
    static constexpr bool PERM = true, AFTER_DRAIN = false;
    bf16_t* O; int dvs; const ss_t* ss;
    __device__ __forceinline__ void operator()(const f32x4 (&acc)[2][2][4][2], const Unit& u, int wr, int wc, int fr, int fq) const {
        asm volatile("" : "+v"(fr), "+v"(fq));
        const int row0 = u.pm * BM + wr * 64 + fr, col0 = u.pn * BM + wc * 32 + 8 * fq;
        f32x4 r0[2], r1[2];
#pragma unroll
        for (int bj = 0; bj < 2; ++bj) {
#pragma unroll
            for (int i = 0; i < 4; ++i) { r0[bj][i] = ss_rstd(ss[col0 + bj * HALF + i]); r1[bj][i] = ss_rstd(ss[col0 + bj * HALF + 4 + i]); }
        }
#pragma unroll
        for (int ai = 0; ai < 2; ++ai)
#pragma unroll
            for (int m = 0; m < 4; ++m) {
                const int c = row0 + ai * HALF + m * 16, hh = c >> dvs, d = c & ((1 << dvs) - 1);
#pragma unroll
                for (int bj = 0; bj < 2; ++bj) { const int tok = col0 + bj * HALF, b = tok >> 12, s = tok & 4095;
                    *(u32x4*)(O + ((((size_t)(b * 8 + hh) * 64 + (s >> 6)) << dvs) + d) * 64 + (s & 63)) = pack8(acc[ai][bj][m][0] * r0[bj], acc[ai][bj][m][1] * r1[bj]); }
            }
    }
};
struct EpiPlain {
    static constexpr bool PERM = true, AFTER_DRAIN = false;
    bf16_t* O; int ldc;
    __device__ __forceinline__ void operator()(const f32x4 (&acc)[2][2][4][2], const Unit& u, int wr, int wc, int fr, int fq) const {
        asm volatile("" : "+v"(fr), "+v"(fq));
        const int row0 = u.pm * BM + wr * 64 + fr, col0 = u.pn * BM + wc * 32 + 8 * fq;
#pragma unroll
        for (int ai = 0; ai < 2; ++ai)
#pragma unroll
            for (int m = 0; m < 4; ++m) {
                bf16_t* rowp = O + (size_t)(row0 + ai * HALF + m * 16) * ldc + col0;
#pragma unroll
                for (int bj = 0; bj < 2; ++bj) *(u32x4*)(rowp + bj * HALF) = pack8(acc[ai][bj][m][0], acc[ai][bj][m][1]);
            }
    }
};
struct EpiRes {
    static constexpr bool PERM = true, AFTER_DRAIN = false;
    const float* base; float* out; bf16_t* hb; ss_t* ssacc;
    __device__ __forceinline__ void operator()(const f32x4 (&acc)[2][2][4][2], const Unit& u, int wr, int wc, int fr, int fq) const {
        asm volatile("" : "+v"(fr), "+v"(fq));
        const int row0 = u.pm * BM + wr * 64 + fr, col0 = u.pn * BM + wc * 32 + 8 * fq;
#pragma unroll
        for (int ai = 0; ai < 2; ++ai)
#pragma unroll
            for (int m = 0; m < 4; ++m) {
                const int row = row0 + ai * HALF + m * 16; float sq = 0.f;
#pragma unroll
                for (int bj = 0; bj < 2; ++bj) {
                    const size_t off = (size_t)row * 1024 + col0 + bj * HALF;
                    const f32x4 v0 = *(const f32x4*)(base + off) + acc[ai][bj][m][0], v1 = *(const f32x4*)(base + off + 4) + acc[ai][bj][m][1];
                    *(u32x4*)(hb + off) = pack8(v0, v1);
                    sq += (v0[0] * v0[0] + v0[1] * v0[1]) + (v0[2] * v0[2] + v0[3] * v0[3]) + (v1[0] * v1[0] + v1[1] * v1[1]) + (v1[2] * v1[2] + v1[3] * v1[3]);
                }
                sq += __shfl_xor(sq, 16); sq += __shfl_xor(sq, 32);
                if (fq == 0) ss_add(ssacc + row, sq);
                if (m & 1) asm volatile("" ::: "memory");
            }
    }
};
struct EpiGate {
    static constexpr bool PERM = true, AFTER_DRAIN = false;
    const ss_t* ss; const bf16_t* h1b; float* h; const bf16_t* pp; bf16_t* hb; ss_t* ssacc;
    __device__ __forceinline__ void operator()(const f32x4 (&acc)[2][2][4][2], const Unit& u, int wr, int wc, int fr, int fq) const {
        asm volatile("" : "+v"(fr), "+v"(fq));
        const int row0 = u.pm * BM + wr * 64 + fr, col0 = u.pn * BM + wc * 32 + 8 * fq;
#pragma unroll
        for (int ai = 0; ai < 2; ++ai)
#pragma unroll
            for (int m = 0; m < 4; ++m) {
                const int row = row0 + ai * HALF + m * 16; float sq = 0.f;
                const float rstd = ss_rstd(ss[row]) * -1.4426950408889634f;
#pragma unroll
                for (int bj = 0; bj < 2; ++bj) {
                    const size_t off = (size_t)row * 1024 + col0 + bj * HALF;
                    const u32x4 pw = *(const u32x4*)(pp + off);
                    const f32x4 p0 = {__uint_as_float(pw.x << 16), __uint_as_float(pw.x & 0xffff0000u), __uint_as_float(pw.y << 16), __uint_as_float(pw.y & 0xffff0000u)};
                    const f32x4 p1 = {__uint_as_float(pw.z << 16), __uint_as_float(pw.z & 0xffff0000u), __uint_as_float(pw.w << 16), __uint_as_float(pw.w & 0xffff0000u)};
                    f32x4 g0, g1;
#pragma unroll
                    for (int i = 0; i < 4; ++i) { g0[i] = __builtin_amdgcn_rcpf(1.0f + __builtin_amdgcn_exp2f(acc[ai][bj][m][0][i] * rstd)); g1[i] = __builtin_amdgcn_rcpf(1.0f + __builtin_amdgcn_exp2f(acc[ai][bj][m][1][i] * rstd)); }
                    const u32x4 hw = *(const u32x4*)(h1b + off);
                    const f32x4 h0 = {__uint_as_float(hw.x << 16), __uint_as_float(hw.x & 0xffff0000u), __uint_as_float(hw.y << 16), __uint_as_float(hw.y & 0xffff0000u)};
                    const f32x4 h1 = {__uint_as_float(hw.z << 16), __uint_as_float(hw.z & 0xffff0000u), __uint_as_float(hw.w << 16), __uint_as_float(hw.w & 0xffff0000u)};
                    const f32x4 v0 = h0 + g0 * p0, v1 = h1 + g1 * p1;
                    *(f32x4*)(h + off) = v0; *(f32x4*)(h + off + 4) = v1; *(u32x4*)(hb + off) = pack8(v0, v1);
                    sq += (v0[0] * v0[0] + v0[1] * v0[1]) + (v0[2] * v0[2] + v0[3] * v0[3]) + (v1[0] * v1[0] + v1[1] * v1[1]) + (v1[2] * v1[2] + v1[3] * v1[3]);
                }
                sq += __shfl_xor(sq, 16); sq += __shfl_xor(sq, 32);
                if (fq == 0) ss_add(ssacc + row, sq);
                if (m & 1) asm volatile("" ::: "memory");
            }
    }
};
template <class Epi, class Sched, bool ALIGN_EPI = false, bool SP2 = false>
__device__ __forceinline__ void gemm_phase(PG8_LAS unsigned char* lds, const Gemm g, const Sched& S, const Epi& E) {
    int tid_ = threadIdx.x; asm volatile("" : "+v"(tid_));
    const int tid = tid_, wid = __builtin_amdgcn_readfirstlane(tid >> 6), lane = tid & 63, wr = wid >> 2, wc = wid & 3, fr = lane & 15, fq = lane >> 4;
    const int K = g.K, nt = K / BK;
    unsigned voffA[2], voffB[2];
#pragma unroll
    for (int i = 0; i < 2; ++i) { int R, C; stage_rc(tid * 16 + i * 8192, R, C); const int Rb = Epi::PERM ? ((R & ~31) + perm32(R & 31)) : R;
        voffA[i] = (unsigned)(R * K + C) * 2u; voffB[i] = (unsigned)(Rb * K + C) * 2u; }
    const size_t kstep = (size_t)(BK * 2);
    const size_t hstep = (size_t)HALF * K * 2;
    const size_t tstep = 2 * hstep;
    const unsigned ldsw = (unsigned)wid * 1024u;
    const int aoff = lds_byte(wr * 64 + fr, fq * 8), boff = lds_byte(wc * 32 + fr, fq * 8);
#define PG8_SA(b, h) (((b) * 2 + (h)) * HTB)
#define PG8_SB(b, h) ((4 + (b) * 2 + (h)) * HTB)
#define PG8_STAGE(bufoff, gbase, voff) do { _Pragma("unroll") for (int _i = 0; _i < 2; ++_i) \
        __builtin_amdgcn_global_load_lds((const unsigned*)((const char*)(gbase) + (voff)[_i]), (PG8_LAS unsigned*)(lds + (bufoff) + ldsw + _i * 8192), 16, 0, 0); } while (0)
#define PG8_LDA(dst, b, h) do { _Pragma("unroll") for (int m = 0; m < 4; ++m) _Pragma("unroll") for (int k = 0; k < 2; ++k) dst[m][k] = *(const PG8_LAS bf16x8*)(lds + PG8_SA(b, h) + aoff + m * 2048 + k * 1024); } while (0)
#define PG8_LDB(dst, b, h) do { _Pragma("unroll") for (int n = 0; n < 2; ++n) _Pragma("unroll") for (int k = 0; k < 2; ++k) dst[n][k] = *(const PG8_LAS bf16x8*)(lds + PG8_SB(b, h) + boff + n * 2048 + k * 1024); } while (0)
#define PG8_MMA(ai, bj, At, Bt) do { __builtin_amdgcn_s_setprio(1); _Pragma("unroll") for (int m = 0; m < 4; ++m) _Pragma("unroll") for (int n = 0; n < 2; ++n) _Pragma("unroll") for (int k = 0; k < 2; ++k) \
        acc[ai][bj][m][n] = __builtin_amdgcn_mfma_f32_16x16x32_bf16(Bt[n][k], At[m][k], acc[ai][bj][m][n], 0, 0, 0); __builtin_amdgcn_s_setprio(0); } while (0)
#define PG8_WAIT_V(n) asm volatile("s_waitcnt vmcnt(" #n ")" ::: "memory")
#define PG8_WAIT_L(n) asm volatile("s_waitcnt lgkmcnt(" #n ")" ::: "memory")
#define PG8_BAR __builtin_amdgcn_s_barrier()
#define PG8_SCHED __builtin_amdgcn_sched_barrier(0)
    Unit cur, nxt; int ui = 0;
    if (!S.next(0, cur)) return;
    f32x4 acc[2][2][4][2];
#pragma unroll
    for (int a = 0; a < 2; ++a)
#pragma unroll
        for (int b = 0; b < 2; ++b)
#pragma unroll
            for (int m = 0; m < 4; ++m)
#pragma unroll
                for (int n = 0; n < 2; ++n) acc[a][b][m][n] = (f32x4){0.f, 0.f, 0.f, 0.f};
    bf16x8 At[4][2], B0[2][2], B1[2][2];
    const char* cA = (const char*)g.A + (size_t)cur.pm * tstep; const char* cB = (const char*)g.Bt + (size_t)cur.pn * tstep;
    S.a_ready(cur);
    if constexpr (SP2) {
        PG8_STAGE(PG8_SB(0, 0), cB, voffB); PG8_STAGE(PG8_SB(0, 1), cB + hstep, voffB); PG8_STAGE(PG8_SA(0, 0), cA, voffA); PG8_STAGE(PG8_SA(0, 1), cA + hstep, voffA);
        if (wr == 1) PG8_BAR;
        PG8_WAIT_V(2); PG8_BAR;
        PG8_STAGE(PG8_SB(1, 0), cB + kstep, voffB); PG8_STAGE(PG8_SA(1, 0), cA + kstep, voffA); PG8_STAGE(PG8_SB(1, 1), cB + hstep + kstep, voffB);
        PG8_WAIT_V(6); PG8_BAR;
    } else {
        PG8_STAGE(PG8_SB(0, 0), cB, voffB); PG8_STAGE(PG8_SA(0, 0), cA, voffA); PG8_STAGE(PG8_SB(0, 1), cB + hstep, voffB); PG8_STAGE(PG8_SA(0, 1), cA + hstep, voffA);
        if (wr == 1) PG8_BAR;
        PG8_WAIT_V(4); PG8_BAR;
        PG8_STAGE(PG8_SB(1, 0), cB + kstep, voffB); PG8_STAGE(PG8_SA(1, 0), cA + kstep, voffA); PG8_STAGE(PG8_SB(1, 1), cB + hstep + kstep, voffB);
        PG8_WAIT_V(6); PG8_BAR;
    }
    for (;;) {
        const bool has_next = S.next(ui + 1, nxt);
        const char* nA = has_next ? (const char*)g.A + (size_t)nxt.pm * tstep : cA; const char* nB = has_next ? (const char*)g.Bt + (size_t)nxt.pn * tstep : cB;
        for (int t = 0; t < nt; t += 2) {
            const bool last = (t == nt - 2);
            const char* a1 = cA + (size_t)(t + 1) * kstep;
            const char* a2 = last ? nA : cA + (size_t)(t + 2) * kstep; const char* b2 = last ? nB : cB + (size_t)(t + 2) * kstep;
            const char* a3 = a2 + kstep; const char* b3 = b2 + kstep;
            if (last && has_next) S.a_ready(nxt);
            if constexpr (SP2) {
            PG8_LDB(B0, 0, 0); PG8_LDB(B1, 0, 1); PG8_SCHED; PG8_LDA(At, 0, 0); PG8_STAGE(PG8_SA(1, 1), a1 + hstep, voffA);
            PG8_WAIT_V(8); PG8_WAIT_L(0); PG8_BAR; PG8_MMA(0, 0, At, B0); PG8_MMA(0, 1, At, B1); PG8_BAR; PG8_SCHED;
            PG8_LDA(At, 0, 1); PG8_STAGE(PG8_SB(0, 0), b2, voffB); PG8_STAGE(PG8_SB(0, 1), b2 + hstep, voffB); PG8_STAGE(PG8_SA(0, 0), a2, voffA);
            PG8_WAIT_V(8); PG8_WAIT_L(0); PG8_BAR; PG8_MMA(1, 0, At, B0); PG8_MMA(1, 1, At, B1); PG8_BAR; PG8_SCHED;
            PG8_LDB(B0, 1, 0); PG8_LDB(B1, 1, 1); PG8_SCHED; PG8_LDA(At, 1, 0); PG8_STAGE(PG8_SA(0, 1), a2 + hstep, voffA);
            PG8_WAIT_V(8); PG8_WAIT_L(0); PG8_BAR; PG8_MMA(0, 0, At, B0); PG8_MMA(0, 1, At, B1); PG8_BAR; PG8_SCHED;
            PG8_LDA(At, 1, 1); PG8_STAGE(PG8_SB(1, 0), b3, voffB); PG8_STAGE(PG8_SB(1, 1), b3 + hstep, voffB); PG8_STAGE(PG8_SA(1, 0), a3, voffA);
            PG8_WAIT_V(8); PG8_WAIT_L(0); PG8_BAR; PG8_MMA(1, 0, At, B0); PG8_MMA(1, 1, At, B1); PG8_BAR; PG8_SCHED;
            } else {
            PG8_LDB(B0, 0, 0); PG8_SCHED; PG8_LDA(At, 0, 0); PG8_STAGE(PG8_SA(1, 1), a1 + hstep, voffA);
            PG8_WAIT_L(8); PG8_BAR; PG8_WAIT_L(0); PG8_MMA(0, 0, At, B0); PG8_BAR; PG8_SCHED;
            PG8_LDB(B1, 0, 1); PG8_STAGE(PG8_SB(0, 0), b2, voffB);
            PG8_BAR; PG8_WAIT_L(0); PG8_MMA(0, 1, At, B1); PG8_BAR;
            PG8_LDA(At, 0, 1); PG8_STAGE(PG8_SA(0, 0), a2, voffA);
            PG8_BAR; PG8_WAIT_L(0); PG8_MMA(1, 0, At, B0); PG8_BAR; PG8_SCHED;
            PG8_STAGE(PG8_SB(0, 1), b2 + hstep, voffB);
            PG8_WAIT_V(6); PG8_BAR; PG8_MMA(1, 1, At, B1); PG8_BAR;
            PG8_LDB(B0, 1, 0); PG8_SCHED; PG8_LDA(At, 1, 0); PG8_STAGE(PG8_SA(0, 1), a2 + hstep, voffA);
            PG8_WAIT_L(8); PG8_BAR; PG8_WAIT_L(0); PG8_MMA(0, 0, At, B0); PG8_BAR; PG8_SCHED;
            PG8_LDB(B1, 1, 1); PG8_STAGE(PG8_SB(1, 0), b3, voffB);
            PG8_BAR; PG8_WAIT_L(0); PG8_MMA(0, 1, At, B1); PG8_BAR;
            PG8_LDA(At, 1, 1); PG8_STAGE(PG8_SA(1, 0), a3, voffA);
            PG8_BAR; PG8_WAIT_L(0); PG8_MMA(1, 0, At, B0); PG8_BAR; PG8_SCHED;
            PG8_STAGE(PG8_SB(1, 1), b3 + hstep, voffB);
            PG8_WAIT_V(6); PG8_BAR; PG8_MMA(1, 1, At, B1); PG8_BAR;
            }
        }
        if constexpr (ALIGN_EPI) { if (wr == 0) PG8_BAR; }
        if constexpr (!Epi::AFTER_DRAIN) { E(acc, cur, wr, wc, fr, fq); S.done(cur); }
        if (!has_next) break;
#pragma unroll
        for (int a = 0; a < 2; ++a)
#pragma unroll
            for (int b = 0; b < 2; ++b)
#pragma unroll
                for (int m = 0; m < 4; ++m)
#pragma unroll
                    for (int n = 0; n < 2; ++n) acc[a][b][m][n] = (f32x4){0.f, 0.f, 0.f, 0.f};
        cur = nxt; cA = nA; cB = nB; ++ui;
        if constexpr (ALIGN_EPI) { if (wr == 1) PG8_BAR; }
    }
    PG8_WAIT_V(0);
    if constexpr (!ALIGN_EPI) { if (wr == 0) PG8_BAR; }
    PG8_BAR;
    if constexpr (Epi::AFTER_DRAIN) { E.fused(acc, cur, wr, wc, fr, fq, lds, wid, lane); S.done(cur); }
#undef PG8_SA
#undef PG8_SB
#undef PG8_STAGE
#undef PG8_LDA
#undef PG8_LDB
#undef PG8_MMA
#undef PG8_WAIT_V
#undef PG8_WAIT_L
#undef PG8_BAR
#undef PG8_SCHED
}
}

namespace cg = cooperative_groups;
#define LAS __attribute__((address_space(3)))
typedef unsigned short bf16;
typedef short bf16x8 __attribute__((ext_vector_type(8)));
typedef float f32x4 __attribute__((ext_vector_type(4)));
typedef float f32x16 __attribute__((ext_vector_type(16)));
typedef unsigned u32x4 __attribute__((ext_vector_type(4)));

constexpr int NB = 8, SEQ = 4096, DM = 1024, MT = NB * SEQ;
constexpr int LDY_E = 2560, LDY_O = 3072;
constexpr float QSCALE = 0.125f * 1.4426950408889634f;
constexpr size_t MiB = 1u << 20;
constexpr size_t WS_SS = 5 * MiB + 512 * 1024;
constexpr size_t WS_SUM = 3 * MiB;
constexpr size_t WS_LRUW = 5 * MiB;
constexpr size_t WS_ROPE = 8 * MiB;
constexpr size_t WS_WINE = 16 * MiB;
constexpr size_t WS_WINO = 28 * MiB;
constexpr size_t WS_WOUT = 44 * MiB;
constexpr size_t WS_WG = 52 * MiB;
constexpr size_t WS_WP = 60 * MiB;
constexpr size_t WS_PB = 64 * MiB;
constexpr size_t WS_HB0 = 80 * MiB;
constexpr size_t WS_OMIX = 144 * MiB;
constexpr size_t WS_Y = 208 * MiB;
constexpr size_t WS_PP = WS_Y, WS_HB1 = WS_Y + 64 * MiB;
constexpr size_t WS_VT = 400 * MiB;
constexpr size_t WS_END = 464 * MiB;
constexpr int LDS_BYTES = 147456;
constexpr int NTHREADS = 512;

struct Params {
    const float* x; const float* p; const int* pos; const float* norm_mix; const float* norm_ple; const float* w_ple_gate; const float* w_ple_proj;
    const float* w_in_e; const float* conv_w; const float* conv_b; const float* lru_wa; const float* lru_ba; const float* lru_wx; const float* lru_bx; const float* lru_lambda; const float* w_out_e;
    const float* w_in_o; const float* lq1; const float* lk1; const float* lq2; const float* lk2; const float* subln_g; const float* w_out_o; const float* final_norm;
    float* out; unsigned char* ws;
    float lam_init[2]; float pad[2];
};

typedef const __attribute__((address_space(4))) Params* KPtr;
#define KP_GET() ({ KPtr kp_ = (KPtr)__builtin_amdgcn_kernarg_segment_ptr(); asm volatile("" : "+s"(kp_)); kp_; })
template <class T> __device__ __forceinline__ T* G_(T* p) { __attribute__((address_space(1))) T* g = (__attribute__((address_space(1))) T*)p; asm("" : "+s"(g)); return (T*)g; }
__device__ const float INV_FREQ[32] = {1.000000000e+00f, 7.498942018e-01f, 5.623413324e-01f, 4.216965139e-01f, 3.162277639e-01f, 2.371373773e-01f, 1.778279394e-01f, 1.333521456e-01f, 1.000000015e-01f, 7.498942316e-02f, 5.623413250e-02f, 4.216964915e-02f, 3.162277490e-02f, 2.371373773e-02f, 1.778279431e-02f, 1.333521400e-02f, 9.999999776e-03f, 7.498942316e-03f, 5.623413250e-03f, 4.216964822e-03f, 3.162277630e-03f, 2.371373819e-03f, 1.778279431e-03f, 1.333521446e-03f, 1.000000047e-03f, 7.498941850e-04f, 5.623413017e-04f, 4.216965172e-04f, 3.162277571e-04f, 2.371373703e-04f, 1.778279402e-04f, 1.333521504e-04f};
__device__ __forceinline__ float bf2f(bf16 u) { return __uint_as_float((unsigned)u << 16); }
typedef float f32x2_t __attribute__((ext_vector_type(2))); typedef __bf16 bf16x2_t __attribute__((ext_vector_type(2)));
__device__ __forceinline__ unsigned cvtpk(float lo, float hi) { f32x2_t v = {lo, hi}; bf16x2_t b = __builtin_convertvector(v, bf16x2_t); return __builtin_bit_cast(unsigned, b); }
__device__ __forceinline__ bf16 f2bf(float f) { return (bf16)(cvtpk(f, 0.f) & 0xffffu); }
__device__ __forceinline__ float wave_sum(float v) {
#pragma unroll
    for (int o = 1; o < 64; o <<= 1) v += __shfl_xor(v, o);
    return v;
}
__device__ __forceinline__ int crow(int r, int hi) { return (r & 3) + 8 * (r >> 2) + 4 * hi; }
#define GLDS16(gptr, ldsptr) __builtin_amdgcn_global_load_lds((const unsigned*)(gptr), (LAS unsigned*)(ldsptr), 16, 0, 0)
#define MFMA32(a, b, c) __builtin_amdgcn_mfma_f32_32x32x16_bf16((a), (b), (c), 0, 0, 0)

__device__ __forceinline__ void colmap(int kind, int np, int& src, float& sc) {
    src = np; sc = 1.f;
    if (kind == 2) {
        if (np >= 1024 && np < 1536) sc = QSCALE;
        else if (np >= 2048 && np < 2560) src = np + 512;
        else if (np >= 2560) src = np - 512;
    } else if (kind == 3) {
        if (np < 2048) { const int head = np >> 6, s = np & 63, w = s >> 5, fq = (s >> 3) & 3, n = (s >> 2) & 1, i = s & 3; src = head * 64 + 16 * w + 4 * fq + i + 32 * n; if (np < 1024) sc = QSCALE; }
        else if (np < 3072) src = np + 1024;
        else src = np - 1024;
    }
}
__device__ __forceinline__ void wt_item(const float* W, int K, int N, bf16* WT, int nrows, int kind, const float* gk, LAS float* scr, int item, int lane) {
    const int nblk = nrows / 32, kb = item / nblk, nb = item % nblk, k0 = 64 * kb, n0 = 32 * nb;
    int src; float sc; colmap(kind, n0 + (lane & 31), src, sc);
#pragma unroll 8
    for (int i = 0; i < 32; ++i) { const int kk = 2 * i + (lane >> 5); const float g = gk ? gk[k0 + kk] : 1.f; scr[kk * 33 + (lane & 31)] = W[(size_t)(k0 + kk) * N + src] * (g * sc); }
    const int c = lane & 7;
#pragma unroll
    for (int j = 0; j < 4; ++j) { const int n = (lane >> 3) + 8 * j; const LAS float* s = scr + (8 * c) * 33 + n;
        u32x4 o; o.x = cvtpk(s[0 * 33], s[1 * 33]); o.y = cvtpk(s[2 * 33], s[3 * 33]); o.z = cvtpk(s[4 * 33], s[5 * 33]); o.w = cvtpk(s[6 * 33], s[7 * 33]);
        *(u32x4*)(WT + (size_t)(n0 + n) * K + k0 + 8 * c) = o; }
}
__device__ __forceinline__ void sincos_acc(float af, float& s, float& c) {
    const double a = (double)af; const double q = rint(a * 0.63661977236758134308); const double r = fma(-q, 1.57079632679489661923, a) - q * 6.123233995736766e-17;
    const double r2 = r * r;
    const double sp = r * (1.0 + r2 * (-1.0 / 6 + r2 * (1.0 / 120 + r2 * (-1.0 / 5040 + r2 * (1.0 / 362880 + r2 * (-1.0 / 39916800 + r2 * (1.0 / 6227020800.0)))))));
    const double cp = 1.0 + r2 * (-0.5 + r2 * (1.0 / 24 + r2 * (-1.0 / 720 + r2 * (1.0 / 40320 + r2 * (-1.0 / 3628800 + r2 * (1.0 / 479001600.0 + r2 * (-1.0 / 87178291200.0)))))));
    const int qi = ((int)q) & 3;
    const double ss = (qi == 0) ? sp : (qi == 1) ? cp : (qi == 2) ? -sp : -cp;
    const double cc = (qi == 0) ? cp : (qi == 1) ? -sp : (qi == 2) ? -cp : sp;
    s = (float)ss; c = (float)cc;
}

__device__ __forceinline__ void prologue(KPtr P, LAS unsigned char* lds, int vcu, int G, int wave, int lane) {
    unsigned char* ws = G_(P->ws);
    LAS float* scr = (LAS float*)(lds + wave * 16384);
    const int gw = vcu * 8 + wave, NGW = G * 8;
    constexpr int I_E = 16 * 96, I_O = 16 * 128, I_S = 16 * 32, I_P = 4 * 32;
    constexpr int I_L = 2 * 16 * 2;
    constexpr int NITEMS = 2 * I_E + 2 * I_O + 4 * I_S + 4 * I_S + 4 * I_P + I_L;
    for (int it = gw; it < NITEMS; it += NGW) {
        int r = it;
        if (r < 2 * I_E) { const int j = r / I_E; wt_item(G_(P->w_in_e) + (size_t)j * 1024 * 3072, 1024, 3072, (bf16*)(ws + WS_WINE) + (size_t)j * 3072 * 1024, 3072, 2, G_(P->norm_mix) + (2 * j) * 1024, scr, r % I_E, lane); continue; } r -= 2 * I_E;
        if (r < 2 * I_O) { const int j = r / I_O; wt_item(G_(P->w_in_o) + (size_t)j * 1024 * 4096, 1024, 4096, (bf16*)(ws + WS_WINO) + (size_t)j * 4096 * 1024, 4096, 3, G_(P->norm_mix) + (2 * j + 1) * 1024, scr, r % I_O, lane); continue; } r -= 2 * I_O;
        if (r < 4 * I_S) { const int i = r / I_S; const float* src = (i & 1) ? G_(P->w_out_o) + (size_t)(i >> 1) * 1024 * 1024 : G_(P->w_out_e) + (size_t)(i >> 1) * 1024 * 1024;
            wt_item(src, 1024, 1024, (bf16*)(ws + WS_WOUT) + (size_t)i * 1024 * 1024, 1024, 0, nullptr, scr, r % I_S, lane); continue; } r -= 4 * I_S;
        if (r < 4 * I_S) { const int i = r / I_S; wt_item(G_(P->w_ple_gate) + (size_t)i * 1024 * 1024, 1024, 1024, (bf16*)(ws + WS_WG) + (size_t)i * 1024 * 1024, 1024, 1, G_(P->norm_ple) + i * 1024, scr, r % I_S, lane); continue; } r -= 4 * I_S;
        if (r < 4 * I_P) { const int i = r / I_P; wt_item(G_(P->w_ple_proj) + (size_t)i * 256 * 1024, 256, 1024, (bf16*)(ws + WS_WP) + (size_t)i * 1024 * 256, 1024, 0, nullptr, scr, r % I_P, lane); continue; } r -= 4 * I_P;
        { const int gate = r >> 5, blk = (r >> 1) & 15; wt_item((gate ? G_(P->lru_wx) : G_(P->lru_wa)) + (size_t)blk * 4096, 64, 64, (bf16*)(ws + WS_LRUW) + (size_t)(gate * 16 + blk) * 4096, 64, 0, nullptr, scr, r & 1, lane); }
    }
    pg8::ss_t* SS = (pg8::ss_t*)(ws + WS_SS);
    for (int m0 = 4 * gw; m0 < MT; m0 += 4 * NGW) {
        f32x4 v[4][4];
#pragma unroll
        for (int q = 0; q < 4; ++q) { const f32x4* xr = (const f32x4*)(G_(P->x) + (size_t)(m0 + q) * DM) + lane;
#pragma unroll
            for (int j = 0; j < 4; ++j) v[q][j] = xr[64 * j]; }
#pragma unroll
        for (int q = 0; q < 4; ++q) { float s = 0.f; unsigned long long* o8 = (unsigned long long*)((bf16*)(ws + WS_HB0) + (size_t)(m0 + q) * DM) + lane;
#pragma unroll
            for (int j = 0; j < 4; ++j) { const f32x4 w = v[q][j]; s += (w.x * w.x + w.y * w.y) + (w.z * w.z + w.w * w.w);
                o8[64 * j] = (unsigned long long)cvtpk(w.x, w.y) | ((unsigned long long)cvtpk(w.z, w.w) << 32); }
            s = wave_sum(s); if (lane == 0) SS[m0 + q] = (pg8::ss_t)(s * 4294967296.0f); }
    }
    { const int gt = gw * 64 + lane, NT = NGW * 64; for (int i = gt; i < 8 * MT; i += NT) SS[MT + i] = 0ull; }
    { const int gt = gw * 64 + lane, NT = NGW * 64; float* R = (float*)(ws + WS_ROPE);
      for (int i = gt; i < MT * 32; i += NT) { const int m = i >> 5, f = i & 31; const float ang = (float)G_(P->pos)[m] * INV_FREQ[f]; float s, c; sincos_acc(ang, s, c); R[2 * i] = c; R[2 * i + 1] = s; } }
}
__device__ __forceinline__ void convert_p(KPtr P, unsigned char* wsb, int layer, int vcu, int G, int tid) {
    const f32x4* src = (const f32x4*)(G_(P->p) + (size_t)layer * MT * 256); u32x4* dst = (u32x4*)(wsb + WS_PB);
    const int gt = vcu * NTHREADS + tid, NT = G * NTHREADS;
    for (int i = gt; i < MT * 256 / 8; i += NT) { const f32x4 a = src[2 * i], b = src[2 * i + 1]; u32x4 o; o.x = cvtpk(a.x, a.y); o.y = cvtpk(a.z, a.w); o.z = cvtpk(b.x, b.y); o.w = cvtpk(b.z, b.w); dst[i] = o; }
}
__device__ __forceinline__ void final_norm(KPtr P, int vcu, int G, int wave, int lane) {
    const pg8::ss_t* SS = (const pg8::ss_t*)(G_(P->ws) + WS_SS) + 8 * (size_t)MT;
    const int gw = vcu * 8 + wave, NGW = G * 8;
    f32x4 g[4];
#pragma unroll
    for (int j = 0; j < 4; ++j) g[j] = ((const f32x4*)G_(P->final_norm))[lane + 64 * j];
    for (int m0 = 4 * gw; m0 < MT; m0 += 4 * NGW) {
        f32x4 v[4][4]; float rs[4];
#pragma unroll
        for (int q = 0; q < 4; ++q) { const f32x4* xr = (const f32x4*)(G_(P->out) + (size_t)(m0 + q) * DM) + lane; rs[q] = pg8::ss_rstd(SS[m0 + q]);
#pragma unroll
            for (int j = 0; j < 4; ++j) v[q][j] = xr[64 * j]; }
#pragma unroll
        for (int q = 0; q < 4; ++q) { f32x4* xr = (f32x4*)(G_(P->out) + (size_t)(m0 + q) * DM) + lane;
#pragma unroll
            for (int j = 0; j < 4; ++j) xr[64 * j] = v[q][j] * rs[q] * g[j]; }
    }
}

__device__ __forceinline__ int tperm(int i) { return ((i & 4) << 2) | ((i & 16) >> 1) | ((i & 8) >> 1) | (i & 3); }
__device__ __forceinline__ void lru_unit(KPtr P, unsigned char* wsb, int j, int u, int pass, LAS unsigned char* xct, int lane) {
    asm volatile("" : "+v"(lane));
    const int ch = u & 63, n = (u >> 6) & 7, b = u >> 9, c32 = lane & 31, hi = lane >> 5, cg0 = 64 * n + c32;
    const bf16* Y = (const bf16*)(wsb + WS_Y); bf16* OM = (bf16*)(wsb + WS_OMIX);
    float* SA = (float*)(wsb + WS_SUM); float* SH = SA + 8 * 64 * 512;
    const float* cw = G_(P->conv_w) + j * 4 * 512;
    float w0[2], w1[2], w2[2], w3[2], cbi[2], ba[2], bx[2], c8[2];
    bf16x8 Ba[2][4], Bx[2][4];
#pragma unroll
    for (int cb = 0; cb < 2; ++cb) {
        const int cgi = cg0 + 32 * cb;
        w0[cb] = cw[cgi]; w1[cb] = cw[512 + cgi]; w2[cb] = cw[1024 + cgi]; w3[cb] = cw[1536 + cgi]; cbi[cb] = G_(P->conv_b)[j * 512 + cgi];
        ba[cb] = G_(P->lru_ba)[j * 512 + cgi]; bx[cb] = G_(P->lru_bx)[j * 512 + cgi];
        const float lam = G_(P->lru_lambda)[j * 512 + cgi];
        c8[cb] = 8.0f * (fminf(lam, 0.f) - log1pf(__expf(-fabsf(lam))));
        const bf16* wa = (const bf16*)(wsb + WS_LRUW) + ((size_t)((j * 8 + n) * 64 + c32 + 32 * cb)) * 64 + 8 * hi; const bf16* wx = wa + 16 * 4096;
#pragma unroll
        for (int kk = 0; kk < 4; ++kk) { Ba[cb][kk] = *(const bf16x8*)(wa + 16 * kk); Bx[cb][kk] = *(const bf16x8*)(wx + 16 * kk); }
    }
    const size_t tok0 = (size_t)b * SEQ + ch * 64;
    float hc[2] = {0.f, 0.f}; float Ap[2] = {1.f, 1.f};
    if (pass == 1) {
#pragma unroll
        for (int cb = 0; cb < 2; ++cb) { const float* sa = SA + (size_t)b * 64 * 512 + cg0 + 32 * cb; const float* sh = SH + (size_t)b * 64 * 512 + cg0 + 32 * cb; float h = 0.f;
#pragma unroll 16
            for (int c = 0; c < ch; ++c) h = sa[c * 512] * h + sh[c * 512];
            hc[cb] = h; }
    }
    const int arow = tperm(c32), aswz = (arow >> 1) & 7;
    for (int sub = 0; sub < 2; ++sub) {
        const size_t t0 = tok0 + sub * 32 + 16 * hi;
        const bool first = (ch == 0) && (sub == 0) && (hi == 0);
        f32x16 xc[2];
#pragma unroll
        for (int cb = 0; cb < 2; ++cb) {
            const bf16* yp = Y + t0 * LDY_E + cg0 + 32 * cb;
            float x0 = 0.f, x1 = 0.f, x2 = 0.f;
            if (!first) { x0 = bf2f(*(yp - 3 * (ptrdiff_t)LDY_E)); x1 = bf2f(*(yp - 2 * (ptrdiff_t)LDY_E)); x2 = bf2f(*(yp - (ptrdiff_t)LDY_E)); }
#pragma unroll
            for (int r = 0; r < 16; ++r) { const float xv = bf2f(yp[(size_t)r * LDY_E]); xc[cb][r] = cbi[cb] + w0[cb] * x0 + w1[cb] * x1 + w2[cb] * x2 + w3[cb] * xv; x0 = x1; x1 = x2; x2 = xv; }
#pragma unroll
            for (int r = 0; r < 16; ++r) { const int tt = 16 * hi + r, col = c32 + 32 * cb;
                *(LAS bf16*)(xct + tt * 128 + ((((col >> 3) ^ ((tt >> 1) & 7))) << 4) + (col & 7) * 2) = f2bf(xc[cb][r]); }
        }
        f32x16 pa[2], px[2];
        pa[0] = (f32x16){}; pa[1] = (f32x16){}; px[0] = (f32x16){}; px[1] = (f32x16){};
#pragma unroll
        for (int kk = 0; kk < 4; ++kk) {
            const bf16x8 af = *(const LAS bf16x8*)(xct + arow * 128 + (((2 * kk + hi) ^ aswz) << 4));
            pa[0] = MFMA32(af, Ba[0][kk], pa[0]); pa[1] = MFMA32(af, Ba[1][kk], pa[1]); px[0] = MFMA32(af, Bx[0][kk], px[0]); px[1] = MFMA32(af, Bx[1][kk], px[1]);
        }
        float Al[2], Hl[2];
#pragma unroll
        for (int cb = 0; cb < 2; ++cb) {
            float al = 1.f, hl = 0.f;
#pragma unroll
            for (int r = 0; r < 16; ++r) {
                const float rg = __builtin_amdgcn_rcpf(1.0f + __expf(-(pa[cb][r] + ba[cb]))), ig = __builtin_amdgcn_rcpf(1.0f + __expf(-(px[cb][r] + bx[cb])));
                const float la = c8[cb] * rg, a = __expf(la), x2 = 2.0f * la;
                const float ems = -x2 * (1.0f + x2 * (0.5f + x2 * ((1.0f / 6) + x2 * ((1.0f / 24) + x2 * ((1.0f / 120) + x2 * (1.0f / 720))))));
                const float em = (x2 > -0.5f) ? ems : 1.0f - a * a;
                const float uu = sqrtf(em) * (ig * xc[cb][r]);
                pa[cb][r] = a; px[cb][r] = uu; hl = a * hl + uu; al *= a;
            }
            Al[cb] = al; Hl[cb] = hl;
        }
#pragma unroll
        for (int cb = 0; cb < 2; ++cb) {
            const float oA = __shfl_xor(Al[cb], 32), oH = __shfl_xor(Hl[cb], 32);
            const float hmid = hi ? (oA * hc[cb] + oH) : (Al[cb] * hc[cb] + Hl[cb]);
            const float hin = hi ? hmid : hc[cb];
            const float hend = hi ? (Al[cb] * hmid + Hl[cb]) : (oA * hmid + oH);
            Ap[cb] *= Al[cb] * oA;
            if (pass == 1) {
                const bf16* gp = Y + t0 * LDY_E + 512 + cg0 + 32 * cb; bf16* op = OM + t0 * 1024 + cg0 + 32 * cb;
                float h = hin;
#pragma unroll
                for (int r = 0; r < 16; ++r) { h = pa[cb][r] * h + px[cb][r]; const float g = bf2f(gp[(size_t)r * LDY_E]); op[(size_t)r * 1024] = f2bf(h * g * __builtin_amdgcn_rcpf(1.0f + __expf(-g))); }
            }
            hc[cb] = hend;
        }
    }
    if (pass == 0 && hi == 0) {
#pragma unroll
        for (int cb = 0; cb < 2; ++cb) { SA[((size_t)b * 64 + ch) * 512 + cg0 + 32 * cb] = Ap[cb]; SH[((size_t)b * 64 + ch) * 512 + cg0 + 32 * cb] = hc[cb]; }
    }
}

__device__ __forceinline__ int tile_off(int row, int chunk) { return row * 128 + ((chunk ^ ((row >> 1) & 7)) << 4); }
__device__ __forceinline__ int kperm(int i) { return (i & 0x13) | ((i & 4) << 1) | ((i & 8) >> 1); }

__device__ __forceinline__ void sb_unit(KPtr P, unsigned char* wsb, int b, int h, int qb, LAS unsigned char* lds, int tid, int wave, int lane) {
    const bf16* Y = (const bf16*)(wsb + WS_Y); const bf16* VT = (const bf16*)(wsb + WS_VT); bf16* OM = (bf16*)(wsb + WS_OMIX);
    asm volatile("" : "+v"(lane));
    const int r32 = lane & 31, hi = lane >> 5;
    const size_t rowbase = (size_t)b * SEQ; const int q0 = qb * 256, qw0 = q0 + wave * 32;
    const int srow = wave * 8 + (lane >> 3), sch = (lane & 7) ^ ((srow >> 1) & 7);
    const bf16* kg = Y + (rowbase + srow) * LDY_E + 1536 + h * 64 + sch * 8;
    const bf16* vg = VT + ((size_t)(b * 8 + h) * 64) * 4096 + srow * 64 + sch * 8;
    bf16x8 qr[4];
#pragma unroll
    for (int d0 = 0; d0 < 4; ++d0) qr[d0] = *(const bf16x8*)(Y + (rowbase + qw0 + r32) * LDY_E + 1024 + h * 64 + d0 * 16 + hi * 8);
    const int krow = kperm(r32), kswz = (krow >> 1) & 7, vswz = (r32 >> 1) & 7;
    f32x16 o0 = {}, o1 = {};
    float R = 1.0f;
    const int jmax = (q0 + 255) >> 6;
    GLDS16(kg + (size_t)(jmax * 64) * LDY_E, lds + wave * 1024); GLDS16(vg + (size_t)jmax * 4096, lds + 8192 + wave * 1024);
    LAS unsigned* alive = (LAS unsigned*)(lds + 32768);
    if (tid < 3) alive[tid] = 0u;
    __syncthreads();
    int it = 0, aw = 0; bool walive = true;
    for (int j = jmax; j >= 0; --j, ++it) {
        LAS unsigned char* Kb = lds + (it & 1) * 16384; LAS unsigned char* Vb = Kb + 8192;
        if (j > 0) { LAS unsigned char* Kn = lds + ((it + 1) & 1) * 16384 + wave * 1024; GLDS16(kg + (size_t)((j - 1) * 64) * LDY_E, Kn); GLDS16(vg + (size_t)(j - 1) * 4096, Kn + 8192); }
        const int k0 = j * 64;
        if (k0 < qw0 + 31 && walive) {
            f32x16 p0 = {}, p1 = {};
#pragma unroll
            for (int d0 = 0; d0 < 4; ++d0) {
                const int co = ((2 * d0 + hi) ^ kswz) << 4;
                const bf16x8 a0 = *(const LAS bf16x8*)(Kb + krow * 128 + co), a1 = *(const LAS bf16x8*)(Kb + (krow + 32) * 128 + co);
                p0 = MFMA32(a0, qr[d0], p0); p1 = MFMA32(a1, qr[d0], p1);
            }
            const int tq = qw0 + r32; const bool need_mask = (k0 + 63 >= qw0);
            if (need_mask) {
                asm volatile("" ::: );
#pragma unroll
                for (int r = 0; r < 16; ++r) { const int s = k0 + 16 * (r >> 3) + 8 * hi + (r & 7); if (s >= tq) p0[r] = -INFINITY; if (s + 32 >= tq) p1[r] = -INFINITY; }
            }
            f32x16 b0, b1;
#pragma unroll
            for (int r = 0; r < 16; ++r) {
                { const float om = __builtin_amdgcn_rcpf(1.0f + __builtin_amdgcn_exp2f(p0[r])); p0[r] = om; b0[r] = 1.0f - om; }
                { const float om = __builtin_amdgcn_rcpf(1.0f + __builtin_amdgcn_exp2f(p1[r])); p1[r] = om; b1[r] = 1.0f - om; }
            }
            f32x4 own;
            own[0] = ((p0[0] * p0[1]) * (p0[2] * p0[3])) * ((p0[4] * p0[5]) * (p0[6] * p0[7]));
            own[1] = ((p0[8] * p0[9]) * (p0[10] * p0[11])) * ((p0[12] * p0[13]) * (p0[14] * p0[15]));
            own[2] = ((p1[0] * p1[1]) * (p1[2] * p1[3])) * ((p1[4] * p1[5]) * (p1[6] * p1[7]));
            own[3] = ((p1[8] * p1[9]) * (p1[10] * p1[11])) * ((p1[12] * p1[13]) * (p1[14] * p1[15]));
            const float t0 = __shfl_xor(own[0], 32), t1 = __shfl_xor(own[1], 32), t2 = __shfl_xor(own[2], 32), t3 = __shfl_xor(own[3], 32);
            const float a0 = hi ? t0 : own[0], a1 = hi ? own[0] : t0, a2 = hi ? t1 : own[1], a3 = hi ? own[1] : t1, a4 = hi ? t2 : own[2], a5 = hi ? own[2] : t2, a6 = hi ? t3 : own[3], a7 = hi ? own[3] : t3;
            const float s7 = 1.0f, s6 = a7, s5 = s6 * a6, s4 = s5 * a5, s3 = s4 * a4, s2 = s3 * a3, s1 = s2 * a2, s0 = s1 * a1;
            const float total = s0 * a0;
            { float run = (hi ? s1 : s0) * R;
#pragma unroll
              for (int jj = 7; jj >= 0; --jj) { const float w = b0[jj] * run; run *= p0[jj]; b0[jj] = w; } }
            { float run = (hi ? s3 : s2) * R;
#pragma unroll
              for (int jj = 7; jj >= 0; --jj) { const float w = b0[8 + jj] * run; run *= p0[8 + jj]; b0[8 + jj] = w; } }
            { float run = (hi ? s5 : s4) * R;
#pragma unroll
              for (int jj = 7; jj >= 0; --jj) { const float w = b1[jj] * run; run *= p1[jj]; b1[jj] = w; } }
            { float run = (hi ? s7 : s6) * R;
#pragma unroll
              for (int jj = 7; jj >= 0; --jj) { const float w = b1[8 + jj] * run; run *= p1[8 + jj]; b1[8 + jj] = w; } }
            R *= total;
            const u32x4 pw0 = {cvtpk(b0[0], b0[1]), cvtpk(b0[2], b0[3]), cvtpk(b0[4], b0[5]), cvtpk(b0[6], b0[7])}, pw1 = {cvtpk(b0[8], b0[9]), cvtpk(b0[10], b0[11]), cvtpk(b0[12], b0[13]), cvtpk(b0[14], b0[15])};
            const u32x4 pw2 = {cvtpk(b1[0], b1[1]), cvtpk(b1[2], b1[3]), cvtpk(b1[4], b1[5]), cvtpk(b1[6], b1[7])}, pw3 = {cvtpk(b1[8], b1[9]), cvtpk(b1[10], b1[11]), cvtpk(b1[12], b1[13]), cvtpk(b1[14], b1[15])};
#define SB_PV(kk, pw) { const int co = ((2 * (kk) + hi) ^ vswz) << 4; const bf16x8 v0 = *(const LAS bf16x8*)(Vb + r32 * 128 + co), v1 = *(const LAS bf16x8*)(Vb + (r32 + 32) * 128 + co); \
                o0 = MFMA32(__builtin_bit_cast(bf16x8, pw), v0, o0); o1 = MFMA32(__builtin_bit_cast(bf16x8, pw), v1, o1); }
            SB_PV(0, pw0) SB_PV(1, pw1) SB_PV(2, pw2) SB_PV(3, pw3)
#undef SB_PV
        }
        const int an = (aw == 2) ? 0 : aw + 1;
        walive = __any(R != 0.0f);
        if (walive && lane == 0) alive[aw] = 1u;
        if (tid == 0) alive[an] = 0u;
        __syncthreads();
        if (alive[aw] == 0u) break;
        aw = an;
    }
    int r32e = r32; asm volatile("" : "+v"(r32e));
    bf16 gr0[16], gr1[16];
#pragma unroll
    for (int r = 0; r < 16; ++r) { const size_t tok = rowbase + qw0 + crow(r, hi); gr0[r] = Y[tok * LDY_E + 2048 + h * 64 + r32e]; gr1[r] = Y[tok * LDY_E + 2048 + h * 64 + 32 + r32e]; }
#pragma unroll
    for (int r = 0; r < 16; ++r) {
        const size_t tok = rowbase + qw0 + crow(r, hi);
        const float g0 = bf2f(gr0[r]), g1 = bf2f(gr1[r]);
        OM[tok * 1024 + 512 + h * 64 + r32e] = f2bf(o0[r] * g0 * __builtin_amdgcn_rcpf(1.0f + __expf(-g0)));
        OM[tok * 1024 + 512 + h * 64 + 32 + r32e] = f2bf(o1[r] * g1 * __builtin_amdgcn_rcpf(1.0f + __expf(-g1)));
    }
    __syncthreads();
}

__device__ __forceinline__ void diff_map_half(LAS unsigned char* Qb  , LAS unsigned char* Kb, LAS unsigned char* Vb, LAS float* wsf, f32x16 (&O)[4], float& mrow, float& lrow,
                                              int kbase  , int p, int tq, bool need_mask, int krow, int kswz, int vswz, int r32, int hi) {
    f32x16 s = {};
#pragma unroll
    for (int d0 = 0; d0 < 4; ++d0) {
        const int co = ((2 * d0 + hi) ^ kswz) << 4;
        const bf16x8 a0 = *(const LAS bf16x8*)(Kb + (krow + 32 * p) * 128 + co);
        const bf16x8 qf = *(const LAS bf16x8*)(Qb + r32 * 128 + (((2 * d0 + hi) ^ vswz) << 4));
        s = MFMA32(a0, qf, s);
    }
    if (need_mask) {
        asm volatile("" ::: );
#pragma unroll
        for (int r = 0; r < 16; ++r) { const int key = kbase + 16 * (r >> 3) + 8 * hi + (r & 7); if (key > tq) s[r] = -INFINITY; }
    }
    float mx = fmaxf(s[0], s[1]);
#pragma unroll
    for (int r = 2; r < 16; ++r) mx = fmaxf(mx, s[r]);
    { const auto rr = __builtin_amdgcn_permlane32_swap(__float_as_uint(mx), __float_as_uint(mx), false, false); mx = fmaxf(__uint_as_float(rr[0]), __uint_as_float(rr[1])); }
    constexpr float DIFF_THR = 8.0f;
    float mnew = mrow;
    if (__any(mx > mrow + DIFF_THR)) {
        mnew = fmaxf(mrow, mx);
        const float alpha = __builtin_amdgcn_exp2f(mrow - mnew);
        lrow *= alpha;
        if (hi == 0) wsf[r32] = alpha;
#pragma unroll
        for (int r = 0; r < 16; ++r) { const float al = wsf[crow(r, hi)];
#pragma unroll
            for (int dd = 0; dd < 4; ++dd) O[dd][r] *= al; }
    }
    mrow = mnew;
    float sum = 0.f;
#pragma unroll
    for (int r = 0; r < 16; ++r) { s[r] = __builtin_amdgcn_exp2f(s[r] - mnew); sum += s[r]; }
    lrow += sum;
    const u32x4 pw0 = {cvtpk(s[0], s[1]), cvtpk(s[2], s[3]), cvtpk(s[4], s[5]), cvtpk(s[6], s[7])}, pw1 = {cvtpk(s[8], s[9]), cvtpk(s[10], s[11]), cvtpk(s[12], s[13]), cvtpk(s[14], s[15])};
#pragma unroll
    for (int dd = 0; dd < 4; ++dd) {
        const bf16x8 v0 = *(const LAS bf16x8*)(Vb + (r32 + 32 * dd) * 128 + (((4 * p + hi) ^ vswz) << 4)), v1 = *(const LAS bf16x8*)(Vb + (r32 + 32 * dd) * 128 + (((4 * p + 2 + hi) ^ vswz) << 4));
        O[dd] = MFMA32(__builtin_bit_cast(bf16x8, pw0), v0, O[dd]); O[dd] = MFMA32(__builtin_bit_cast(bf16x8, pw1), v1, O[dd]);
    }
}

__device__ __forceinline__ void diff_unit(KPtr P, unsigned char* wsb, int jl, float lam, int b, int h, int qb, LAS unsigned char* lds, int tid, int wave, int lane) {
    const bf16* Y = (const bf16*)(wsb + WS_Y); const bf16* VT = (const bf16*)(wsb + WS_VT); bf16* OM = (bf16*)(wsb + WS_OMIX);
    asm volatile("" : "+v"(lane));
    const int r32 = lane & 31, hi = lane >> 5;
    const size_t rowbase = (size_t)b * SEQ; const int q0 = qb * 256, qw0 = q0 + wave * 32;
    const int srow = wave * 8 + (lane >> 3), sch = (lane & 7) ^ ((srow >> 1) & 7);
    const bf16* k1g = Y + (rowbase + srow) * LDY_O + 1024 + (2 * h) * 64 + sch * 8;
    const bf16* k2g = k1g + 64;
    const bf16* vg = VT + ((size_t)(b * 8 + h) * 64) * 8192 + srow * 64 + sch * 8;
    constexpr int BUF = 32768;
    LAS float* wsf = (LAS float*)(lds + 2 * BUF) + wave * 64;
    LAS unsigned char* Q1b = lds + 2 * BUF + 2048 + wave * 8192; LAS unsigned char* Q2b = Q1b + 4096;
#pragma unroll
    for (int i = 0; i < 4; ++i) { const int qrow = 8 * i + (lane >> 3), qch = (lane & 7) ^ ((qrow >> 1) & 7); const bf16* qp = Y + (rowbase + qw0 + qrow) * LDY_O + (2 * h) * 64 + qch * 8;
        GLDS16(qp, Q1b + i * 1024); GLDS16(qp + 64, Q2b + i * 1024); }
    const int krow = kperm(r32), kswz = (krow >> 1) & 7, vswz = (r32 >> 1) & 7;
    f32x16 O1[4], O2[4];
#pragma unroll
    for (int dd = 0; dd < 4; ++dd) { O1[dd] = (f32x16){}; O2[dd] = (f32x16){}; }
    float m1 = -INFINITY, m2 = -INFINITY, l1 = 0.f, l2 = 0.f;
    const int jmax = (q0 + 255) >> 6;
    { LAS unsigned char* Bn = lds + wave * 1024; GLDS16(k1g, Bn); GLDS16(k2g, Bn + 8192); GLDS16(vg, Bn + 16384); GLDS16(vg + 4096, Bn + 24576); }
    __syncthreads();
    const int tq = qw0 + r32;
    for (int j = 0; j <= jmax; ++j) {
        LAS unsigned char* B0 = lds + (j & 1) * BUF;
        if (j < jmax) { const size_t ko = (size_t)(j + 1) * 64; LAS unsigned char* Bn = lds + ((j + 1) & 1) * BUF + wave * 1024; GLDS16(k1g + ko * LDY_O, Bn); GLDS16(k2g + ko * LDY_O, Bn + 8192); GLDS16(vg + (size_t)(j + 1) * 8192, Bn + 16384); GLDS16(vg + (size_t)(j + 1) * 8192 + 4096, Bn + 24576); }
        const int k0 = j * 64;
        if (k0 <= qw0 + 31) {
            const bool need_mask = (k0 + 63 > qw0);
            diff_map_half(Q1b, B0, B0 + 16384, wsf, O1, m1, l1, k0, 0, tq, need_mask, krow, kswz, vswz, r32, hi);
            diff_map_half(Q2b, B0 + 8192, B0 + 16384, wsf + 32, O2, m2, l2, k0, 0, tq, need_mask, krow, kswz, vswz, r32, hi);
            if (k0 + 32 <= qw0 + 31) {
                diff_map_half(Q1b, B0, B0 + 16384, wsf, O1, m1, l1, k0 + 32, 1, tq, need_mask, krow, kswz, vswz, r32, hi);
                diff_map_half(Q2b, B0 + 8192, B0 + 16384, wsf + 32, O2, m2, l2, k0 + 32, 1, tq, need_mask, krow, kswz, vswz, r32, hi);
            }
        }
        __syncthreads();
    }
    l1 += __shfl_xor(l1, 32); l2 += __shfl_xor(l2, 32);
    int r32e = r32; asm volatile("" : "+v"(r32e));
    if (hi == 0) { wsf[r32] = __builtin_amdgcn_rcpf(l1); wsf[32 + r32] = lam * __builtin_amdgcn_rcpf(l2); }
    const float* sg = G_(P->subln_g) + jl * 128; const float post = 1.0f - P->lam_init[jl];
    f32x4 gsc;
#pragma unroll
    for (int dd = 0; dd < 4; ++dd) gsc[dd] = sg[32 * dd + r32e] * post;
#pragma unroll
    for (int rh = 0; rh < 16; rh += 4) {
        bf16 graw[4][4];
#pragma unroll
        for (int r = 0; r < 4; ++r)
#pragma unroll
            for (int dd = 0; dd < 4; ++dd) graw[r][dd] = Y[(rowbase + qw0 + crow(rh + r, hi)) * LDY_O + 2048 + h * 128 + 32 * dd + r32e];
#pragma unroll
        for (int r8 = 0; r8 < 4; ++r8) {
            const int r = rh + r8;
            const int qr_ = crow(r, hi); const float i1 = wsf[qr_], i2 = wsf[32 + qr_];
            f32x4 v; float sq = 0.f;
#pragma unroll
            for (int dd = 0; dd < 4; ++dd) { v[dd] = O1[dd][r] * i1 - O2[dd][r] * i2; sq += v[dd] * v[dd]; }
            sq += __shfl_xor(sq, 1); sq += __shfl_xor(sq, 2); sq += __shfl_xor(sq, 4); sq += __shfl_xor(sq, 8); sq += __shfl_xor(sq, 16);
            const float rn = __builtin_amdgcn_rsqf(sq * (1.0f / 128.0f) + 1e-6f);
            const size_t tok = rowbase + qw0 + qr_;
#pragma unroll
            for (int dd = 0; dd < 4; ++dd) { const float g = bf2f(graw[r8][dd]);
                OM[tok * 1024 + h * 128 + 32 * dd + r32e] = f2bf(v[dd] * rn * gsc[dd] * g * __builtin_amdgcn_rcpf(1.0f + __expf(-g))); }
        }
    }
    __syncthreads();
}

#define XB_TMO      128
#define XB_XCNT(j)  (256  + 64 * (j))
#define XB_XSUB(j)  (1280 + 64 * (j))
#define XB_XGEN(j)  (2304 + 64 * (j))
#define XB_TOP      3328
#define XB_TOPGEN   3392
#define XCD_BAR_WORDS 3456
#define XB_SPIN_CAP (1u << 18)

__device__ __forceinline__ unsigned xb_ld(unsigned* p)              { return __hip_atomic_load(p, __ATOMIC_RELAXED, __HIP_MEMORY_SCOPE_AGENT); }
__device__ __forceinline__ unsigned xb_add(unsigned* p, unsigned v) { return __hip_atomic_fetch_add(p, v, __ATOMIC_RELAXED, __HIP_MEMORY_SCOPE_AGENT); }
__device__ __forceinline__ unsigned xb_xcc_id() { return (unsigned)__builtin_amdgcn_s_getreg((3 << 11) | 20) & 0xFu; }
#define XB_SPIN(cond, bar) do { unsigned _sp = 0; while (cond) { __builtin_amdgcn_s_sleep(1); \
    if ((++_sp & 255u) == 0u) { if (xb_ld(&(bar)[XB_TMO])) break; if (_sp > XB_SPIN_CAP) { atomicAdd(&(bar)[XB_TMO], 1u); break; } } } } while (0)

struct XcdBarrier {
    unsigned* bar; unsigned x;
    volatile LAS unsigned* st;
};

__device__ __forceinline__ XcdBarrier xcd_barrier_post(unsigned* bar, volatile LAS unsigned* st) {
    XcdBarrier b; b.bar = bar; b.x = xb_xcc_id(); b.st = st;
    if (threadIdx.x == 0) (void)xb_add(&bar[XB_XCNT(b.x)], 1u);
    return b;
}
__device__ __forceinline__ void xcd_barrier_complete(unsigned* bar, unsigned x, unsigned& nloc, unsigned& nx) {
    const unsigned G = gridDim.x * gridDim.y * gridDim.z;
    unsigned sum, cnt, mine, sp = 0u;
    for (;;) {
        sum = 0u; cnt = 0u; mine = 0u;
#pragma unroll
        for (unsigned j = 0; j < 16; ++j) { const unsigned c = xb_ld(&bar[XB_XCNT(j)]); sum += c; cnt += (c > 0u) ? 1u : 0u; mine = (j == x) ? c : mine; }
        if (sum == G) break;
        __builtin_amdgcn_s_sleep(1);
        if ((++sp & 255u) == 0u) { if (xb_ld(&bar[XB_TMO])) break; if (sp > XB_SPIN_CAP) { atomicAdd(&bar[XB_TMO], 1u); break; } }
    }
    nloc = mine > 0u ? mine : 1u; nx = cnt > 0u ? cnt : 1u;
}

__device__ __forceinline__ void xcd_barrier(const XcdBarrier& b) {
    asm volatile("s_waitcnt vmcnt(0)" ::: "memory");
    __syncthreads();
    if (threadIdx.x == 0) {
        unsigned* bar = b.bar;
        __builtin_amdgcn_s_waitcnt(0);
        unsigned nloc = b.st[0], nx = b.st[1];
        if (nloc == 0u) { xcd_barrier_complete(bar, b.x, nloc, nx); b.st[0] = nloc; b.st[1] = nx; }
        const unsigned old = xb_add(&bar[XB_XSUB(b.x)], 1u);
        const unsigned gen = old / nloc;
        if (old + 1u == (gen + 1u) * nloc) {
            __builtin_amdgcn_fence(__ATOMIC_RELEASE, "agent");
            asm volatile("s_waitcnt vmcnt(0)" ::: "memory");
            const unsigned og = xb_add(&bar[XB_TOP], 1u);
            const unsigned tg = og / nx;
            if (og + 1u == (tg + 1u) * nx) xb_add(&bar[XB_TOPGEN], 1u);
            else XB_SPIN(xb_ld(&bar[XB_TOPGEN]) == tg, bar);
            __builtin_amdgcn_fence(__ATOMIC_ACQUIRE, "agent");
            xb_add(&bar[XB_XGEN(b.x)], 1u);
            asm volatile("s_waitcnt vmcnt(0)" ::: "memory");
        } else {
            XB_SPIN(xb_ld(&bar[XB_XGEN(b.x)]) == gen, bar);
            __builtin_amdgcn_fence(__ATOMIC_ACQUIRE, "agent");
            asm volatile("s_waitcnt vmcnt(0)" ::: "memory");
        }
    }
    __syncthreads();
}

#ifndef DUP_MASK
#define DUP_MASK 0
#endif
#define GSYNC() do { xcd_barrier(xbar); if (DUP_MASK & 128) xcd_barrier(xbar); } while (0)
__global__ void __launch_bounds__(NTHREADS, 2) trunk_fwd(Params Pv) {
    extern __shared__ __attribute__((aligned(16))) unsigned char lds_raw[];
    LAS unsigned char* lds = (LAS unsigned char*)lds_raw;
    cg::grid_group grid = cg::this_grid();
    const int tid0 = threadIdx.x, lane0 = tid0 & 63, wave0 = __builtin_amdgcn_readfirstlane(tid0 >> 6);
    const int G = gridDim.x, bx = blockIdx.x, vcu = (G % 8 == 0) ? (bx % 8) * (G / 8) + bx / 8 : bx;

    volatile LAS unsigned* bst = (volatile LAS unsigned*)(lds + LDS_BYTES - 64);
    if (tid0 < 2) bst[tid0] = 0u;
    __syncthreads();
    XcdBarrier xbar;
    { KPtr P = KP_GET(); xbar = xcd_barrier_post((unsigned*)G_(P->ws), bst);
      prologue(P, lds, vcu, G, wave0, lane0);
      convert_p(P, G_(P->ws), 0, vcu, G, tid0); }
    grid.sync();

    for (int layer = 0; layer < 4; ++layer) {
        const int jl = layer >> 1; const bool odd = layer & 1;
        int tid = threadIdx.x; asm volatile("" : "+v"(tid));
        KPtr P = KP_GET();
        unsigned char* ws = P->ws; asm volatile("" : "+s"(ws)); ws = G_(ws);
        pg8::ss_t* SS = (pg8::ss_t*)(ws + WS_SS);
        bf16* HB0 = (bf16*)(ws + WS_HB0); bf16* HB1 = (bf16*)(ws + WS_HB1); bf16* OMIX = (bf16*)(ws + WS_OMIX); bf16* Yb = (bf16*)(ws + WS_Y); bf16* VTb = (bf16*)(ws + WS_VT); bf16* PPb = (bf16*)(ws + WS_PP); bf16* PBb = (bf16*)(ws + WS_PB);
        const int lane = tid & 63, wave = __builtin_amdgcn_readfirstlane(tid >> 6);
        const pg8::ss_t* ss_mix = SS + (size_t)layer * MT; pg8::ss_t* ss_ple = SS + (size_t)(4 + layer) * MT; pg8::ss_t* ss_next = SS + (size_t)(layer < 3 ? layer + 1 : 8) * MT;
        {
            const bf16* Wt = odd ? (const bf16*)(ws + WS_WINO) + (size_t)jl * 4096 * 1024 : (const bf16*)(ws + WS_WINE) + (size_t)jl * 3072 * 1024;
            const int nmain = odd ? 3072 : 2560, nv = odd ? 1024 : 512;
            for (int rep = 0; rep < ((DUP_MASK & 1) ? 2 : 1); ++rep) {
            { pg8::Gemm g{HB0, Wt, MT, nmain, 1024}; pg8::StaticOrder S; S.init(MT, nmain, G, bx);
              pg8::EpiY E{Yb, nmain, ss_mix, (const float*)(ws + WS_ROPE), odd ? 8 : 0};
              pg8::gemm_phase<pg8::EpiY, pg8::StaticOrder, true, true>(lds, g, S, E); }
            { pg8::Gemm g{Wt + (size_t)nmain * 1024, HB0, nv, MT, 1024}; pg8::StaticOrder S; S.init(nv, MT, G, bx);
              pg8::EpiVt E{VTb, odd ? 7 : 6, ss_mix};
              pg8::gemm_phase<pg8::EpiVt, pg8::StaticOrder, true, true>(lds, g, S, E); }
            }
        }
        GSYNC();
        if (!odd) {
            LAS unsigned char* xct = lds + wave * 4096;
            for (int rep = 0; rep < ((DUP_MASK & 2) ? 2 : 1); ++rep)
            for (int u = vcu * 8 + wave; u < 4096; u += G * 8) lru_unit(P, ws, jl, u, 0, xct, lane);
            if (layer > 0) convert_p(P, ws, layer, vcu, G, tid);
            GSYNC();
            for (int rep = 0; rep < ((DUP_MASK & 2) ? 2 : 1); ++rep)
            for (int u = vcu * 8 + wave; u < 4096; u += G * 8) lru_unit(P, ws, jl, u, 1, xct, lane);
            __syncthreads();
            for (int rep = 0; rep < ((DUP_MASK & 8) ? 2 : 1); ++rep)
            for (int vv = vcu; vv < 256; vv += G)
                for (int i = 0; i < 4; ++i) { const int li = vv & 31, bh = 8 * (vv >> 5) + 2 * i + (li >> 4), qb = (i & 1) ? 15 - (li & 15) : (li & 15); sb_unit(P, ws, bh >> 3, bh & 7, qb, lds, tid, wave, lane); }
        } else {
            float lam;
            { const float a = wave_sum(lane < 64 ? G_(P->lq1)[jl * 64 + lane] * G_(P->lk1)[jl * 64 + lane] : 0.f), c = wave_sum(G_(P->lq2)[jl * 64 + lane] * G_(P->lk2)[jl * 64 + lane]); lam = __expf(a) - __expf(c) + P->lam_init[jl]; }
            convert_p(P, ws, layer, vcu, G, tid);
            for (int rep = 0; rep < ((DUP_MASK & 16) ? 2 : 1); ++rep)
            for (int vv = vcu; vv < 256; vv += G)
                for (int i = 0; i < 4; ++i) { const int li = vv & 31, bh = 8 * (vv >> 5) + 2 * i + (li >> 4), qb = (i & 1) ? 15 - (li & 15) : (li & 15); diff_unit(P, ws, jl, lam, bh >> 3, bh & 7, qb, lds, tid, wave, lane); }
        }
        GSYNC();
        {
            { pg8::Gemm g{OMIX, (const bf16*)(ws + WS_WOUT) + (size_t)layer * 1024 * 1024, MT, 1024, 1024}; pg8::StaticOrder S; S.init(MT, 1024, G, bx);
              pg8::EpiRes E{layer == 0 ? G_(P->x) : G_(P->out), G_(P->out), HB1, ss_ple};
              pg8::gemm_phase<pg8::EpiRes, pg8::StaticOrder, true, true>(lds, g, S, E); }
            { pg8::Gemm g{PBb, (const bf16*)(ws + WS_WP) + (size_t)layer * 1024 * 256, MT, 1024, 256}; pg8::StaticOrder S; S.init(MT, 1024, G, bx);
              pg8::EpiPlain E{PPb, 1024};
              pg8::gemm_phase<pg8::EpiPlain, pg8::StaticOrder, false, true>(lds, g, S, E); }
        }
        GSYNC();
        {
            pg8::Gemm g{HB1, (const bf16*)(ws + WS_WG) + (size_t)layer * 1024 * 1024, MT, 1024, 1024}; pg8::StaticOrder S; S.init(MT, 1024, G, bx);
            pg8::EpiGate E{ss_ple, HB1, G_(P->out), PPb, HB0, ss_next};
            pg8::gemm_phase<pg8::EpiGate, pg8::StaticOrder, true, true>(lds, g, S, E);
        }
        GSYNC();
    }
    { KPtr P = KP_GET(); final_norm(P, vcu, G, wave0, lane0); }
}

extern "C" void kernel_launch(void* const* d_in, const int* in_sizes, int n_in, void* d_out, int out_size, void* d_ws, size_t ws_size, hipStream_t stream) {
    static int grid = 0;
    if (grid == 0) {
        if (n_in != 24 || out_size != MT * DM || ws_size < WS_END) { fprintf(stderr, "kernel_launch: unexpected problem (n_in %d out %d ws %zu)\n", n_in, out_size, ws_size); grid = -1; return; }
        int dev = 0, cus = 0, per_cu = 0;
        hipGetDevice(&dev); hipDeviceGetAttribute(&cus, hipDeviceAttributeMultiprocessorCount, dev);
        hipFuncSetAttribute((const void*)trunk_fwd, hipFuncAttributeMaxDynamicSharedMemorySize, LDS_BYTES);
        hipOccupancyMaxActiveBlocksPerMultiprocessor(&per_cu, (const void*)trunk_fwd, NTHREADS, LDS_BYTES);
        (void)hipGetLastError();
        if (per_cu < 1) per_cu = 1;
        grid = cus;
        if (grid > 256) grid = 256;
        grid &= ~7;
    }
    if (grid <= 0) return;
    Params P{};
    P.x = (const float*)d_in[0]; P.p = (const float*)d_in[1]; P.pos = (const int*)d_in[2]; P.norm_mix = (const float*)d_in[3]; P.norm_ple = (const float*)d_in[4];
    P.w_ple_gate = (const float*)d_in[5]; P.w_ple_proj = (const float*)d_in[6]; P.w_in_e = (const float*)d_in[7]; P.conv_w = (const float*)d_in[8]; P.conv_b = (const float*)d_in[9];
    P.lru_wa = (const float*)d_in[10]; P.lru_ba = (const float*)d_in[11]; P.lru_wx = (const float*)d_in[12]; P.lru_bx = (const float*)d_in[13]; P.lru_lambda = (const float*)d_in[14];
    P.w_out_e = (const float*)d_in[15]; P.w_in_o = (const float*)d_in[16]; P.lq1 = (const float*)d_in[17]; P.lk1 = (const float*)d_in[18]; P.lq2 = (const float*)d_in[19]; P.lk2 = (const float*)d_in[20];
    P.subln_g = (const float*)d_in[21]; P.w_out_o = (const float*)d_in[22]; P.final_norm = (const float*)d_in[23];
    P.out = (float*)d_out; P.ws = (unsigned char*)d_ws;
    P.lam_init[0] = (float)(0.8 - 0.6 * exp(-0.3 * 1.0)); P.lam_init[1] = (float)(0.8 - 0.6 * exp(-0.3 * 3.0));
    if (hipMemsetAsync(d_ws, 0, 65536, stream) != hipSuccess) { fprintf(stderr, "kernel_launch: memset of the barrier words failed\n"); return; }
    void* args[] = {&P};
    hipError_t e = hipLaunchCooperativeKernel((const void*)trunk_fwd, dim3(grid), dim3(NTHREADS), args, LDS_BYTES, stream);
    if (e != hipSuccess) fprintf(stderr, "cooperative launch failed: %s (grid %d)\n", hipGetErrorString(e), grid);
}
```

```cpp
#include <hip/hip_runtime.h>
#include <hip/hip_cooperative_groups.h>
#include <cstdio>
#include <cstdint>
#include <cmath>
namespace pg8 {
#define PG8_LAS __attribute__((address_space(3)))
typedef unsigned short bf16_t;
typedef short bf16x8 __attribute__((ext_vector_type(8)));
typedef float f32x4 __attribute__((ext_vector_type(4)));
typedef unsigned u32x4 __attribute__((ext_vector_type(4)));
constexpr int BM = 256, BK = 64, HALF = 128, HTB = HALF * BK * 2  , STAGE_BYTES = 8 * HTB, NXCD = 8, WGM = 8;

__host__ __device__ __forceinline__ int lds_byte(int r, int c) { const int st = (r >> 4) * 2 + (c >> 5), rr = r & 15, cc = c & 31, ob = rr * 64 + cc * 2; return st * 1024 + (ob ^ (((ob >> 9) & 1) << 5)); }
__host__ __device__ __forceinline__ void stage_rc(int b, int& R, int& C) { const int st = b / 1024, sb = b % 1024, swz = sb ^ (((sb >> 9) & 1) << 5); R = (st >> 1) * 16 + swz / 64; C = (st & 1) * 32 + (swz % 64) / 2; }
__host__ __device__ __forceinline__ int perm32(int rho) { const int n = rho >> 4, i = rho & 15; return 8 * (i >> 2) + 4 * n + (i & 3); }

struct Unit { int pm, pn; };
struct Gemm { const bf16_t* A; const bf16_t* Bt; int M, N, K; };

struct StaticOrder {
    int nM, nN, nwg, G, c;
    __host__ __device__ void init(int M, int N, int G_, int c_) { nM = M / BM; nN = N / BM; nwg = nM * nN; G = G_; c = c_; }
    __host__ __device__ bool next(int i, Unit& u) const {
        const long L = (long)i * G + c; if (L >= nwg) return false;
        int wgid = (int)L; { const int q = nwg / NXCD, r = nwg % NXCD, xcd = wgid % NXCD, off = wgid / NXCD; wgid = (xcd < r ? xcd * (q + 1) : r * (q + 1) + (xcd - r) * q) + off; }
        const int nig = WGM * nN, gid = wgid / nig, fm = gid * WGM, gsz = (nM - fm) < WGM ? (nM - fm) : WGM;
        u.pm = fm + ((wgid % nig) % gsz); u.pn = (wgid % nig) / gsz; return true;
    }
    __device__ __forceinline__ void a_ready(const Unit&) const {}
    __device__ __forceinline__ void done(const Unit&) const {}
};

__device__ __forceinline__ unsigned cvt_pk_bf16(float lo, float hi) { unsigned r; asm volatile("v_cvt_pk_bf16_f32 %0, %1, %2" : "=v"(r) : "v"(lo), "v"(hi)); return r; }
__device__ __forceinline__ float bf2f(unsigned short u) { return __uint_as_float((unsigned)u << 16); }
__device__ __forceinline__ u32x4 pack8(const f32x4& v0, const f32x4& v1) { u32x4 w; w.x = cvt_pk_bf16(v0[0], v0[1]); w.y = cvt_pk_bf16(v0[2], v0[3]); w.z = cvt_pk_bf16(v1[0], v1[1]); w.w = cvt_pk_bf16(v1[2], v1[3]); return w; }
constexpr float RMS_EPS = 1e-6f;
typedef unsigned long long ss_t;
__device__ __forceinline__ float ss_rstd(ss_t v) { return __builtin_amdgcn_rsqf((float)v * (2.3283064365386963e-10f / 1024.0f) + RMS_EPS); }
__device__ __forceinline__ void ss_add(ss_t* p, float sq) { atomicAdd(p, (ss_t)(sq * 4294967296.0f)); }

struct EpiY {
    static constexpr bool PERM = true, AFTER_DRAIN = false;
    bf16_t* O; int ldc; const ss_t* ss; const float* rope; int rope_pn;
    __device__ __forceinline__ void operator()(const f32x4 (&acc)[2][2][4][2], const Unit& u, int wr, int wc, int fr, int fq) const {
        asm volatile("" : "+v"(fr), "+v"(fq));
        const int row0 = u.pm * BM + wr * 64 + fr, col0 = u.pn * BM + wc * 32 + 8 * fq;
        const bool do_rope = u.pn < rope_pn;
#pragma unroll
        for (int ai = 0; ai < 2; ++ai)
#pragma unroll
            for (int m = 0; m < 4; ++m) {
                const int row = row0 + ai * HALF + m * 16;
                const float rstd = ss_rstd(ss[row]);
                f32x4 cs0 = {1.f, 0.f, 1.f, 0.f}, cs1 = {1.f, 0.f, 1.f, 0.f};
                if (do_rope) { const float* rp = rope + (size_t)row * 64 + ((wc & 1) * 16 + 4 * fq) * 2; cs0 = *(const f32x4*)rp; cs1 = *(const f32x4*)(rp + 4); }
                bf16_t* rowp = O + (size_t)row * ldc + col0;
#pragma unroll
                for (int bj = 0; bj < 2; ++bj) {
                    f32x4 v0 = acc[ai][bj][m][0] * rstd, v1 = acc[ai][bj][m][1] * rstd;
                    if (do_rope) {
                        const f32x4 c = {cs0[0], cs0[2], cs1[0], cs1[2]}, s = {cs0[1], cs0[3], cs1[1], cs1[3]};
                        const f32x4 o0 = v0 * c - v1 * s, o1 = v1 * c + v0 * s; v0 = o0; v1 = o1;
                    }
                    *(u32x4*)(rowp + bj * HALF) = pack8(v0, v1);
                }
                if (do_rope && (m & 1)) asm volatile("" ::: "memory");
            }
    }
};
struct EpiVt {
    static constexpr bool PERM = true, AFTER_DRAIN = false;
    bf16_t* O; int dvs; const ss_t* ss;
    __device__ __forceinline__ void operator()(const f32x4 (&acc)[2][2][4][2], const Unit& u, int wr, int wc, int fr, int fq) const {
        asm volatile("" : "+v"(fr), "+v"(fq));
        const int row0 = u.pm * BM + wr * 64 + fr, col0 = u.pn * BM + wc * 32 + 8 * fq;
        f32x4 r0[2], r1[2];
#pragma unroll
        for (int bj = 0; bj < 2; ++bj) {
#pragma unroll
            for (int i = 0; i < 4; ++i) { r0[bj][i] = ss_rstd(ss[col0 + bj * HALF + i]); r1[bj][i] = ss_rstd(ss[col0 + bj * HALF + 4 + i]); }
        }
#pragma unroll
        for (int ai = 0; ai < 2; ++ai)
#pragma unroll
            for (int m = 0; m < 4; ++m) {
                const int c = row0 + ai * HALF + m * 16, hh = c >> dvs, d = c & ((1 << dvs) - 1);
#pragma unroll
                for (int bj = 0; bj < 2; ++bj) { const int tok = col0 + bj * HALF, b = tok >> 12, s = tok & 4095;
                    *(u32x4*)(O + ((((size_t)(b * 8 + hh) * 64 + (s >> 6)) << dvs) + d) * 64 + (s & 63)) = pack8(acc[ai][bj][m][0] * r0[bj], acc[ai][bj][m][1] * r1[bj]); }
            }
    }
};
struct EpiPlain {
    static constexpr bool PERM = true, AFTER_DRAIN = false;
    bf16_t* O; int ldc;
    __device__ __forceinline__ void operator()(const f32x4 (&acc)[2][2][4][2], const Unit& u, int wr, int wc, int fr, int fq) const {
        asm volatile("" : "+v"(fr), "+v"(fq));
        const int row0 = u.pm * BM + wr * 64 + fr, col0 = u.pn * BM + wc * 32 + 8 * fq;
#pragma unroll
        for (int ai = 0; ai < 2; ++ai)
#pragma unroll
            for (int m = 0; m < 4; ++m) {
                bf16_t* rowp = O + (size_t)(row0 + ai * HALF + m * 16) * ldc + col0;
#pragma unroll
                for (int bj = 0; bj < 2; ++bj) *(u32x4*)(rowp + bj * HALF) = pack8(acc[ai][bj][m][0], acc[ai][bj][m][1]);
            }
    }
};
struct EpiRes {
    static constexpr bool PERM = true, AFTER_DRAIN = false;
    const float* base; float* out; bf16_t* hb; ss_t* ssacc;
    __device__ __forceinline__ void operator()(const f32x4 (&acc)[2][2][4][2], const Unit& u, int wr, int wc, int fr, int fq) const {
        asm volatile("" : "+v"(fr), "+v"(fq));
        const int row0 = u.pm * BM + wr * 64 + fr, col0 = u.pn * BM + wc * 32 + 8 * fq;
#pragma unroll
        for (int ai = 0; ai < 2; ++ai)
#pragma unroll
            for (int m = 0; m < 4; ++m) {
                const int row = row0 + ai * HALF + m * 16; float sq = 0.f;
#pragma unroll
                for (int bj = 0; bj < 2; ++bj) {
                    const size_t off = (size_t)row * 1024 + col0 + bj * HALF;
                    const f32x4 v0 = *(const f32x4*)(base + off) + acc[ai][bj][m][0], v1 = *(const f32x4*)(base + off + 4) + acc[ai][bj][m][1];
                    *(u32x4*)(hb + off) = pack8(v0, v1);
                    sq += (v0[0] * v0[0] + v0[1] * v0[1]) + (v0[2] * v0[2] + v0[3] * v0[3]) + (v1[0] * v1[0] + v1[1] * v1[1]) + (v1[2] * v1[2] + v1[3] * v1[3]);
                }
                sq += __shfl_xor(sq, 16); sq += __shfl_xor(sq, 32);
                if (fq == 0) ss_add(ssacc + row, sq);
                if (m & 1) asm volatile("" ::: "memory");
            }
    }
};
struct EpiGate {
    static constexpr bool PERM = true, AFTER_DRAIN = false;
    const ss_t* ss; const bf16_t* h1b; float* h; const bf16_t* pp; bf16_t* hb; ss_t* ssacc;
    __device__ __forceinline__ void operator()(const f32x4 (&acc)[2][2][4][2], const Unit& u, int wr, int wc, int fr, int fq) const {
        asm volatile("" : "+v"(fr), "+v"(fq));
        const int row0 = u.pm * BM + wr * 64 + fr, col0 = u.pn * BM + wc * 32 + 8 * fq;
#pragma unroll
        for (int ai = 0; ai < 2; ++ai)
#pragma unroll
            for (int m = 0; m < 4; ++m) {
                const int row = row0 + ai * HALF + m * 16; float sq = 0.f;
                const float rstd = ss_rstd(ss[row]) * -1.4426950408889634f;
#pragma unroll
                for (int bj = 0; bj < 2; ++bj) {
                    const size_t off = (size_t)row * 1024 + col0 + bj * HALF;
                    const u32x4 pw = *(const u32x4*)(pp + off);
                    const f32x4 p0 = {__uint_as_float(pw.x << 16), __uint_as_float(pw.x & 0xffff0000u), __uint_as_float(pw.y << 16), __uint_as_float(pw.y & 0xffff0000u)};
                    const f32x4 p1 = {__uint_as_float(pw.z << 16), __uint_as_float(pw.z & 0xffff0000u), __uint_as_float(pw.w << 16), __uint_as_float(pw.w & 0xffff0000u)};
                    f32x4 g0, g1;
#pragma unroll
                    for (int i = 0; i < 4; ++i) { g0[i] = __builtin_amdgcn_rcpf(1.0f + __builtin_amdgcn_exp2f(acc[ai][bj][m][0][i] * rstd)); g1[i] = __builtin_amdgcn_rcpf(1.0f + __builtin_amdgcn_exp2f(acc[ai][bj][m][1][i] * rstd)); }
                    const u32x4 hw = *(const u32x4*)(h1b + off);
                    const f32x4 h0 = {__uint_as_float(hw.x << 16), __uint_as_float(hw.x & 0xffff0000u), __uint_as_float(hw.y << 16), __uint_as_float(hw.y & 0xffff0000u)};
                    const f32x4 h1 = {__uint_as_float(hw.z << 16), __uint_as_float(hw.z & 0xffff0000u), __uint_as_float(hw.w << 16), __uint_as_float(hw.w & 0xffff0000u)};
                    const f32x4 v0 = h0 + g0 * p0, v1 = h1 + g1 * p1;
                    *(f32x4*)(h + off) = v0; *(f32x4*)(h + off + 4) = v1; *(u32x4*)(hb + off) = pack8(v0, v1);
                    sq += (v0[0] * v0[0] + v0[1] * v0[1]) + (v0[2] * v0[2] + v0[3] * v0[3]) + (v1[0] * v1[0] + v1[1] * v1[1]) + (v1[2] * v1[2] + v1[3] * v1[3]);
                }
                sq += __shfl_xor(sq, 16); sq += __shfl_xor(sq, 32);
                if (fq == 0) ss_add(ssacc + row, sq);
                if (m & 1) asm volatile("" ::: "memory");
            }
    }
};
template <class Epi, class Sched, bool ALIGN_EPI = false, bool SP2 = false>
__device__ __forceinline__ void gemm_phase(PG8_LAS unsigned char* lds, const Gemm g, const Sched& S, const Epi& E) {
    int tid_ = threadIdx.x; asm volatile("" : "+v"(tid_));
    const int tid = tid_, wid = __builtin_amdgcn_readfirstlane(tid >> 6), lane = tid & 63, wr = wid >> 2, wc = wid & 3, fr = lane & 15, fq = lane >> 4;
    const int K = g.K, nt = K / BK;
    unsigned voffA[2], voffB[2];
#pragma unroll
    for (int i = 0; i < 2; ++i) { int R, C; stage_rc(tid * 16 + i * 8192, R, C); const int Rb = Epi::PERM ? ((R & ~31) + perm32(R & 31)) : R;
        voffA[i] = (unsigned)(R * K + C) * 2u; voffB[i] = (unsigned)(Rb * K + C) * 2u; }
    const size_t kstep = (size_t)(BK * 2);
    const size_t hstep = (size_t)HALF * K * 2;
    const size_t tstep = 2 * hstep;
    const unsigned ldsw = (unsigned)wid * 1024u;
    const int aoff = lds_byte(wr * 64 + fr, fq * 8), boff = lds_byte(wc * 32 + fr, fq * 8);
#define PG8_SA(b, h) (((b) * 2 + (h)) * HTB)
#define PG8_SB(b, h) ((4 + (b) * 2 + (h)) * HTB)
#define PG8_STAGE(bufoff, gbase, voff) do { _Pragma("unroll") for (int _i = 0; _i < 2; ++_i) \
        __builtin_amdgcn_global_load_lds((const unsigned*)((const char*)(gbase) + (voff)[_i]), (PG8_LAS unsigned*)(lds + (bufoff) + ldsw + _i * 8192), 16, 0, 0); } while (0)
#define PG8_LDA(dst, b, h) do { _Pragma("unroll") for (int m = 0; m < 4; ++m) _Pragma("unroll") for (int k = 0; k < 2; ++k) dst[m][k] = *(const PG8_LAS bf16x8*)(lds + PG8_SA(b, h) + aoff + m * 2048 + k * 1024); } while (0)
#define PG8_LDB(dst, b, h) do { _Pragma("unroll") for (int n = 0; n < 2; ++n) _Pragma("unroll") for (int k = 0; k < 2; ++k) dst[n][k] = *(const PG8_LAS bf16x8*)(lds + PG8_SB(b, h) + boff + n * 2048 + k * 1024); } while (0)
#define PG8_MMA(ai, bj, At, Bt) do { __builtin_amdgcn_s_setprio(1); _Pragma("unroll") for (int m = 0; m < 4; ++m) _Pragma("unroll") for (int n = 0; n < 2; ++n) _Pragma("unroll") for (int k = 0; k < 2; ++k) \
        acc[ai][bj][m][n] = __builtin_amdgcn_mfma_f32_16x16x32_bf16(Bt[n][k], At[m][k], acc[ai][bj][m][n], 0, 0, 0); __builtin_amdgcn_s_setprio(0); } while (0)
#define PG8_WAIT_V(n) asm volatile("s_waitcnt vmcnt(" #n ")" ::: "memory")
#define PG8_WAIT_L(n) asm volatile("s_waitcnt lgkmcnt(" #n ")" ::: "memory")
#define PG8_BAR __builtin_amdgcn_s_barrier()
#define PG8_SCHED __builtin_amdgcn_sched_barrier(0)
    Unit cur, nxt; int ui = 0;
    if (!S.next(0, cur)) return;
    f32x4 acc[2][2][4][2];
#pragma unroll
    for (int a = 0; a < 2; ++a)
#pragma unroll
        for (int b = 0; b < 2; ++b)
#pragma unroll
            for (int m = 0; m < 4; ++m)
#pragma unroll
                for (int n = 0; n < 2; ++n) acc[a][b][m][n] = (f32x4){0.f, 0.f, 0.f, 0.f};
    bf16x8 At[4][2], B0[2][2], B1[2][2];
    const char* cA = (const char*)g.A + (size_t)cur.pm * tstep; const char* cB = (const char*)g.Bt + (size_t)cur.pn * tstep;
    S.a_ready(cur);
    if constexpr (SP2) {
        PG8_STAGE(PG8_SB(0, 0), cB, voffB); PG8_STAGE(PG8_SB(0, 1), cB + hstep, voffB); PG8_STAGE(PG8_SA(0, 0), cA, voffA); PG8_STAGE(PG8_SA(0, 1), cA + hstep, voffA);
        if (wr == 1) PG8_BAR;
        PG8_WAIT_V(2); PG8_BAR;
        PG8_STAGE(PG8_SB(1, 0), cB + kstep, voffB); PG8_STAGE(PG8_SA(1, 0), cA + kstep, voffA); PG8_STAGE(PG8_SB(1, 1), cB + hstep + kstep, voffB);
        PG8_WAIT_V(6); PG8_BAR;
    } else {
        PG8_STAGE(PG8_SB(0, 0), cB, voffB); PG8_STAGE(PG8_SA(0, 0), cA, voffA); PG8_STAGE(PG8_SB(0, 1), cB + hstep, voffB); PG8_STAGE(PG8_SA(0, 1), cA + hstep, voffA);
        if (wr == 1) PG8_BAR;
        PG8_WAIT_V(4); PG8_BAR;
        PG8_STAGE(PG8_SB(1, 0), cB + kstep, voffB); PG8_STAGE(PG8_SA(1, 0), cA + kstep, voffA); PG8_STAGE(PG8_SB(1, 1), cB + hstep + kstep, voffB);
        PG8_WAIT_V(6); PG8_BAR;
    }
    for (;;) {
        const bool has_next = S.next(ui + 1, nxt);
        const char* nA = has_next ? (const char*)g.A + (size_t)nxt.pm * tstep : cA; const char* nB = has_next ? (const char*)g.Bt + (size_t)nxt.pn * tstep : cB;
        for (int t = 0; t < nt; t += 2) {
            const bool last = (t == nt - 2);
            const char* a1 = cA + (size_t)(t + 1) * kstep;
            const char* a2 = last ? nA : cA + (size_t)(t + 2) * kstep; const char* b2 = last ? nB : cB + (size_t)(t + 2) * kstep;
            const char* a3 = a2 + kstep; const char* b3 = b2 + kstep;
            if (last && has_next) S.a_ready(nxt);
            if constexpr (SP2) {
            PG8_LDB(B0, 0, 0); PG8_LDB(B1, 0, 1); PG8_SCHED; PG8_LDA(At, 0, 0); PG8_STAGE(PG8_SA(1, 1), a1 + hstep, voffA);
            PG8_WAIT_V(8); PG8_WAIT_L(0); PG8_BAR; PG8_MMA(0, 0, At, B0); PG8_MMA(0, 1, At, B1); PG8_BAR; PG8_SCHED;
            PG8_LDA(At, 0, 1); PG8_STAGE(PG8_SB(0, 0), b2, voffB); PG8_STAGE(PG8_SB(0, 1), b2 + hstep, voffB); PG8_STAGE(PG8_SA(0, 0), a2, voffA);
            PG8_WAIT_V(8); PG8_WAIT_L(0); PG8_BAR; PG8_MMA(1, 0, At, B0); PG8_MMA(1, 1, At, B1); PG8_BAR; PG8_SCHED;
            PG8_LDB(B0, 1, 0); PG8_LDB(B1, 1, 1); PG8_SCHED; PG8_LDA(At, 1, 0); PG8_STAGE(PG8_SA(0, 1), a2 + hstep, voffA);
            PG8_WAIT_V(8); PG8_WAIT_L(0); PG8_BAR; PG8_MMA(0, 0, At, B0); PG8_MMA(0, 1, At, B1); PG8_BAR; PG8_SCHED;
            PG8_LDA(At, 1, 1); PG8_STAGE(PG8_SB(1, 0), b3, voffB); PG8_STAGE(PG8_SB(1, 1), b3 + hstep, voffB); PG8_STAGE(PG8_SA(1, 0), a3, voffA);
            PG8_WAIT_V(8); PG8_WAIT_L(0); PG8_BAR; PG8_MMA(1, 0, At, B0); PG8_MMA(1, 1, At, B1); PG8_BAR; PG8_SCHED;
            } else {
            PG8_LDB(B0, 0, 0); PG8_SCHED; PG8_LDA(At, 0, 0); PG8_STAGE(PG8_SA(1, 1), a1 + hstep, voffA);
            PG8_WAIT_L(8); PG8_BAR; PG8_WAIT_L(0); PG8_MMA(0, 0, At, B0); PG8_BAR; PG8_SCHED;
            PG8_LDB(B1, 0, 1); PG8_STAGE(PG8_SB(0, 0), b2, voffB);
            PG8_BAR; PG8_WAIT_L(0); PG8_MMA(0, 1, At, B1); PG8_BAR;
            PG8_LDA(At, 0, 1); PG8_STAGE(PG8_SA(0, 0), a2, voffA);
            PG8_BAR; PG8_WAIT_L(0); PG8_MMA(1, 0, At, B0); PG8_BAR; PG8_SCHED;
            PG8_STAGE(PG8_SB(0, 1), b2 + hstep, voffB);
            PG8_WAIT_V(6); PG8_BAR; PG8_MMA(1, 1, At, B1); PG8_BAR;
            PG8_LDB(B0, 1, 0); PG8_SCHED; PG8_LDA(At, 1, 0); PG8_STAGE(PG8_SA(0, 1), a2 + hstep, voffA);
            PG8_WAIT_L(8); PG8_BAR; PG8_WAIT_L(0); PG8_MMA(0, 0, At, B0); PG8_BAR; PG8_SCHED;
            PG8_LDB(B1, 1, 1); PG8_STAGE(PG8_SB(1, 0), b3, voffB);
            PG8_BAR; PG8_WAIT_L(0); PG8_MMA(0, 1, At, B1); PG8_BAR;
            PG8_LDA(At, 1, 1); PG8_STAGE(PG8_SA(1, 0), a3, voffA);
            PG8_BAR; PG8_WAIT_L(0); PG8_MMA(1, 0, At, B0); PG8_BAR; PG8_SCHED;
            PG8_STAGE(PG8_SB(1, 1), b3 + hstep, voffB);
            PG8_WAIT_V(6); PG8_BAR; PG8_MMA(1, 1, At, B1); PG8_BAR;
            }
        }
        if constexpr (ALIGN_EPI) { if (wr == 0) PG8_BAR; }
        if constexpr (!Epi::AFTER_DRAIN) { E(acc, cur, wr, wc, fr, fq); S.done(cur); }
        if (!has_next) break;
#pragma unroll
        for (int a = 0; a < 2; ++a)
#pragma unroll
            for (int b = 0; b < 2; ++b)
#pragma unroll
                for (int m = 0; m < 4; ++m)
#pragma unroll
                    for (int n = 0; n < 2; ++n) acc[a][b][m][n] = (f32x4){0.f, 0.f, 0.f, 0.f};
        cur = nxt; cA = nA; cB = nB; ++ui;
        if constexpr (ALIGN_EPI) { if (wr == 1) PG8_BAR; }
    }
    PG8_WAIT_V(0);
    if constexpr (!ALIGN_EPI) { if (wr == 0) PG8_BAR; }
    PG8_BAR;
    if constexpr (Epi::AFTER_DRAIN) { E.fused(acc, cur, wr, wc, fr, fq, lds, wid, lane); S.done(cur); }
#undef PG8_SA
#undef PG8_SB
#undef PG8_STAGE
#undef PG8_LDA
#undef PG8_LDB
#undef PG8_MMA
#undef PG8_WAIT_V
#undef PG8_WAIT_L
#undef PG8_BAR
#undef PG8_SCHED
}
}

namespace cg = cooperative_groups;
#define LAS __attribute__((address_space(3)))
typedef unsigned short bf16;
typedef short bf16x8 __attribute__((ext_vector_type(8)));
typedef float f32x4 __attribute__((ext_vector_type(4)));
typedef float f32x16 __attribute__((ext_vector_type(16)));
typedef unsigned u32x4 __attribute__((ext_vector_type(4)));

constexpr int NB = 8, SEQ = 4096, DM = 1024, MT = NB * SEQ;
constexpr int LDY_E = 2560, LDY_O = 3072;
constexpr float QSCALE = 0.125f * 1.4426950408889634f;
constexpr size_t MiB = 1u << 20;
constexpr size_t WS_SS = 5 * MiB + 512 * 1024;
constexpr size_t WS_SUM = 3 * MiB;
constexpr size_t WS_LRUW = 5 * MiB;
constexpr size_t WS_ROPE = 8 * MiB;
constexpr size_t WS_WINE = 16 * MiB;
constexpr size_t WS_WINO = 28 * MiB;
constexpr size_t WS_WOUT = 44 * MiB;
constexpr size_t WS_WG = 52 * MiB;
constexpr size_t WS_WP = 60 * MiB;
constexpr size_t WS_PB = 64 * MiB;
constexpr size_t WS_HB0 = 80 * MiB;
constexpr size_t WS_OMIX = 144 * MiB;
constexpr size_t WS_Y = 208 * MiB;
constexpr size_t WS_PP = WS_Y, WS_HB1 = WS_Y + 64 * MiB;
constexpr size_t WS_VT = 400 * MiB;
constexpr size_t WS_END = 464 * MiB;
constexpr int LDS_BYTES = 147456;
constexpr int NTHREADS = 512;

struct Params {
    const float* x; const float* p; const int* pos; const float* norm_mix; const float* norm_ple; const float* w_ple_gate; const float* w_ple_proj;
    const float* w_in_e; const float* conv_w; const float* conv_b; const float* lru_wa; const float* lru_ba; const float* lru_wx; const float* lru_bx; const float* lru_lambda; const float* w_out_e;
    const float* w_in_o; const float* lq1; const float* lk1; const float* lq2; const float* lk2; const float* subln_g; const float* w_out_o; const float* final_norm;
    float* out; unsigned char* ws;
    float lam_init[2]; float pad[2];
};

typedef const __attribute__((address_space(4))) Params* KPtr;
#define KP_GET() ({ KPtr kp_ = (KPtr)__builtin_amdgcn_kernarg_segment_ptr(); asm volatile("" : "+s"(kp_)); kp_; })
template <class T> __device__ __forceinline__ T* G_(T* p) { __attribute__((address_space(1))) T* g = (__attribute__((address_space(1))) T*)p; asm("" : "+s"(g)); return (T*)g; }
__device__ const float INV_FREQ[32] = {1.000000000e+00f, 7.498942018e-01f, 5.623413324e-01f, 4.216965139e-01f, 3.162277639e-01f, 2.371373773e-01f, 1.778279394e-01f, 1.333521456e-01f, 1.000000015e-01f, 7.498942316e-02f, 5.623413250e-02f, 4.216964915e-02f, 3.162277490e-02f, 2.371373773e-02f, 1.778279431e-02f, 1.333521400e-02f, 9.999999776e-03f, 7.498942316e-03f, 5.623413250e-03f, 4.216964822e-03f, 3.162277630e-03f, 2.371373819e-03f, 1.778279431e-03f, 1.333521446e-03f, 1.000000047e-03f, 7.498941850e-04f, 5.623413017e-04f, 4.216965172e-04f, 3.162277571e-04f, 2.371373703e-04f, 1.778279402e-04f, 1.333521504e-04f};
__device__ __forceinline__ float bf2f(bf16 u) { return __uint_as_float((unsigned)u << 16); }
typedef float f32x2_t __attribute__((ext_vector_type(2))); typedef __bf16 bf16x2_t __attribute__((ext_vector_type(2)));
__device__ __forceinline__ unsigned cvtpk(float lo, float hi) { f32x2_t v = {lo, hi}; bf16x2_t b = __builtin_convertvector(v, bf16x2_t); return __builtin_bit_cast(unsigned, b); }
__device__ __forceinline__ bf16 f2bf(float f) { return (bf16)(cvtpk(f, 0.f) & 0xffffu); }
__device__ __forceinline__ float wave_sum(float v) {
#pragma unroll
    for (int o = 1; o < 64; o <<= 1) v += __shfl_xor(v, o);
    return v;
}
__device__ __forceinline__ int crow(int r, int hi) { return (r & 3) + 8 * (r >> 2) + 4 * hi; }
#define GLDS16(gptr, ldsptr) __builtin_amdgcn_global_load_lds((const unsigned*)(gptr), (LAS unsigned*)(ldsptr), 16, 0, 0)
#define MFMA32(a, b, c) __builtin_amdgcn_mfma_f32_32x32x16_bf16((a), (b), (c), 0, 0, 0)

__device__ __forceinline__ void colmap(int kind, int np, int& src, float& sc) {
    src = np; sc = 1.f;
    if (kind == 2) {
        if (np >= 1024 && np < 1536) sc = QSCALE;
        else if (np >= 2048 && np < 2560) src = np + 512;
        else if (np >= 2560) src = np - 512;
    } else if (kind == 3) {
        if (np < 2048) { const int head = np >> 6, s = np & 63, w = s >> 5, fq = (s >> 3) & 3, n = (s >> 2) & 1, i = s & 3; src = head * 64 + 16 * w + 4 * fq + i + 32 * n; if (np < 1024) sc = QSCALE; }
        else if (np < 3072) src = np + 1024;
        else src = np - 1024;
    }
}
__device__ __forceinline__ void wt_item(const float* W, int K, int N, bf16* WT, int nrows, int kind, const float* gk, LAS float* scr, int item, int lane) {
    const int nblk = nrows / 32, kb = item / nblk, nb = item % nblk, k0 = 64 * kb, n0 = 32 * nb;
    int src; float sc; colmap(kind, n0 + (lane & 31), src, sc);
#pragma unroll 8
    for (int i = 0; i < 32; ++i) { const int kk = 2 * i + (lane >> 5); const float g = gk ? gk[k0 + kk] : 1.f; scr[kk * 33 + (lane & 31)] = W[(size_t)(k0 + kk) * N + src] * (g * sc); }
    const int c = lane & 7;
#pragma unroll
    for (int j = 0; j < 4; ++j) { const int n = (lane >> 3) + 8 * j; const LAS float* s = scr + (8 * c) * 33 + n;
        u32x4 o; o.x = cvtpk(s[0 * 33], s[1 * 33]); o.y = cvtpk(s[2 * 33], s[3 * 33]); o.z = cvtpk(s[4 * 33], s[5 * 33]); o.w = cvtpk(s[6 * 33], s[7 * 33]);
        *(u32x4*)(WT + (size_t)(n0 + n) * K + k0 + 8 * c) = o; }
}
__device__ __forceinline__ void sincos_acc(float af, float& s, float& c) {
    const double a = (double)af; const double q = rint(a * 0.63661977236758134308); const double r = fma(-q, 1.57079632679489661923, a) - q * 6.123233995736766e-17;
    const double r2 = r * r;
    const double sp = r * (1.0 + r2 * (-1.0 / 6 + r2 * (1.0 / 120 + r2 * (-1.0 / 5040 + r2 * (1.0 / 362880 + r2 * (-1.0 / 39916800 + r2 * (1.0 / 6227020800.0)))))));
    const double cp = 1.0 + r2 * (-0.5 + r2 * (1.0 / 24 + r2 * (-1.0 / 720 + r2 * (1.0 / 40320 + r2 * (-1.0 / 3628800 + r2 * (1.0 / 479001600.0 + r2 * (-1.0 / 87178291200.0)))))));
    const int qi = ((int)q) & 3;
    const double ss = (qi == 0) ? sp : (qi == 1) ? cp : (qi == 2) ? -sp : -cp;
    const double cc = (qi == 0) ? cp : (qi == 1) ? -sp : (qi == 2) ? -cp : sp;
    s = (float)ss; c = (float)cc;
}

__device__ __forceinline__ void prologue(KPtr P, LAS unsigned char* lds, int vcu, int G, int wave, int lane) {
    unsigned char* ws = G_(P->ws);
    LAS float* scr = (LAS float*)(lds + wave * 16384);
    const int gw = vcu * 8 + wave, NGW = G * 8;
    constexpr int I_E = 16 * 96, I_O = 16 * 128, I_S = 16 * 32, I_P = 4 * 32;
    constexpr int I_L = 2 * 16 * 2;
    constexpr int NITEMS = 2 * I_E + 2 * I_O + 4 * I_S + 4 * I_S + 4 * I_P + I_L;
    for (int it = gw; it < NITEMS; it += NGW) {
        int r = it;
        if (r < 2 * I_E) { const int j = r / I_E; wt_item(G_(P->w_in_e) + (size_t)j * 1024 * 3072, 1024, 3072, (bf16*)(ws + WS_WINE) + (size_t)j * 3072 * 1024, 3072, 2, G_(P->norm_mix) + (2 * j) * 1024, scr, r % I_E, lane); continue; } r -= 2 * I_E;
        if (r < 2 * I_O) { const int j = r / I_O; wt_item(G_(P->w_in_o) + (size_t)j * 1024 * 4096, 1024, 4096, (bf16*)(ws + WS_WINO) + (size_t)j * 4096 * 1024, 4096, 3, G_(P->norm_mix) + (2 * j + 1) * 1024, scr, r % I_O, lane); continue; } r -= 2 * I_O;
        if (r < 4 * I_S) { const int i = r / I_S; const float* src = (i & 1) ? G_(P->w_out_o) + (size_t)(i >> 1) * 1024 * 1024 : G_(P->w_out_e) + (size_t)(i >> 1) * 1024 * 1024;
            wt_item(src, 1024, 1024, (bf16*)(ws + WS_WOUT) + (size_t)i * 1024 * 1024, 1024, 0, nullptr, scr, r % I_S, lane); continue; } r -= 4 * I_S;
        if (r < 4 * I_S) { const int i = r / I_S; wt_item(G_(P->w_ple_gate) + (size_t)i * 1024 * 1024, 1024, 1024, (bf16*)(ws + WS_WG) + (size_t)i * 1024 * 1024, 1024, 1, G_(P->norm_ple) + i * 1024, scr, r % I_S, lane); continue; } r -= 4 * I_S;
        if (r < 4 * I_P) { const int i = r / I_P; wt_item(G_(P->w_ple_proj) + (size_t)i * 256 * 1024, 256, 1024, (bf16*)(ws + WS_WP) + (size_t)i * 1024 * 256, 1024, 0, nullptr, scr, r % I_P, lane); continue; } r -= 4 * I_P;
        { const int gate = r >> 5, blk = (r >> 1) & 15; wt_item((gate ? G_(P->lru_wx) : G_(P->lru_wa)) + (size_t)blk * 4096, 64, 64, (bf16*)(ws + WS_LRUW) + (size_t)(gate * 16 + blk) * 4096, 64, 0, nullptr, scr, r & 1, lane); }
    }
    pg8::ss_t* SS = (pg8::ss_t*)(ws + WS_SS);
    for (int m0 = 4 * gw; m0 < MT; m0 += 4 * NGW) {
        f32x4 v[4][4];
#pragma unroll
        for (int q = 0; q < 4; ++q) { const f32x4* xr = (const f32x4*)(G_(P->x) + (size_t)(m0 + q) * DM) + lane;
#pragma unroll
            for (int j = 0; j < 4; ++j) v[q][j] = xr[64 * j]; }
#pragma unroll
        for (int q = 0; q < 4; ++q) { float s = 0.f; unsigned long long* o8 = (unsigned long long*)((bf16*)(ws + WS_HB0) + (size_t)(m0 + q) * DM) + lane;
#pragma unroll
            for (int j = 0; j < 4; ++j) { const f32x4 w = v[q][j]; s += (w.x * w.x + w.y * w.y) + (w.z * w.z + w.w * w.w);
                o8[64 * j] = (unsigned long long)cvtpk(w.x, w.y) | ((unsigned long long)cvtpk(w.z, w.w) << 32); }
            s = wave_sum(s); if (lane == 0) SS[m0 + q] = (pg8::ss_t)(s * 4294967296.0f); }
    }
    { const int gt = gw * 64 + lane, NT = NGW * 64; for (int i = gt; i < 8 * MT; i += NT) SS[MT + i] = 0ull; }
    { const int gt = gw * 64 + lane, NT = NGW * 64; float* R = (float*)(ws + WS_ROPE);
      for (int i = gt; i < MT * 32; i += NT) { const int m = i >> 5, f = i & 31; const float ang = (float)G_(P->pos)[m] * INV_FREQ[f]; float s, c; sincos_acc(ang, s, c); R[2 * i] = c; R[2 * i + 1] = s; } }
}
__device__ __forceinline__ void convert_p(KPtr P, unsigned char* wsb, int layer, int vcu, int G, int tid) {
    const f32x4* src = (const f32x4*)(G_(P->p) + (size_t)layer * MT * 256); u32x4* dst = (u32x4*)(wsb + WS_PB);
    const int gt = vcu * NTHREADS + tid, NT = G * NTHREADS;
    for (int i = gt; i < MT * 256 / 8; i += NT) { const f32x4 a = src[2 * i], b = src[2 * i + 1]; u32x4 o; o.x = cvtpk(a.x, a.y); o.y = cvtpk(a.z, a.w); o.z = cvtpk(b.x, b.y); o.w = cvtpk(b.z, b.w); dst[i] = o; }
}
__device__ __forceinline__ void final_norm(KPtr P, int vcu, int G, int wave, int lane) {
    const pg8::ss_t* SS = (const pg8::ss_t*)(G_(P->ws) + WS_SS) + 8 * (size_t)MT;
    const int gw = vcu * 8 + wave, NGW = G * 8;
    f32x4 g[4];
#pragma unroll
    for (int j = 0; j < 4; ++j) g[j] = ((const f32x4*)G_(P->final_norm))[lane + 64 * j];
    for (int m0 = 4 * gw; m0 < MT; m0 += 4 * NGW) {
        f32x4 v[4][4]; float rs[4];
#pragma unroll
        for (int q = 0; q < 4; ++q) { const f32x4* xr = (const f32x4*)(G_(P->out) + (size_t)(m0 + q) * DM) + lane; rs[q] = pg8::ss_rstd(SS[m0 + q]);
#pragma unroll
            for (int j = 0; j < 4; ++j) v[q][j] = xr[64 * j]; }
#pragma unroll
        for (int q = 0; q < 4; ++q) { f32x4* xr = (f32x4*)(G_(P->out) + (size_t)(m0 + q) * DM) + lane;
#pragma unroll
            for (int j = 0; j < 4; ++j) xr[64 * j] = v[q][j] * rs[q] * g[j]; }
    }
}

__device__ __forceinline__ int tperm(int i) { return ((i & 4) << 2) | ((i & 16) >> 1) | ((i & 8) >> 1) | (i & 3); }
__device__ __forceinline__ void lru_unit(KPtr P, unsigned char* wsb, int j, int u, int pass, LAS unsigned char* xct, int lane) {
    asm volatile("" : "+v"(lane));
    const int ch = u & 63, n = (u >> 6) & 7, b = u >> 9, c32 = lane & 31, hi = lane >> 5, cg0 = 64 * n + c32;
    const bf16* Y = (const bf16*)(wsb + WS_Y); bf16* OM = (bf16*)(wsb + WS_OMIX);
    float* SA = (float*)(wsb + WS_SUM); float* SH = SA + 8 * 64 * 512;
    const float* cw = G_(P->conv_w) + j * 4 * 512;
    float w0[2], w1[2], w2[2], w3[2], cbi[2], ba[2], bx[2], c8[2];
    bf16x8 Ba[2][4], Bx[2][4];
#pragma unroll
    for (int cb = 0; cb < 2; ++cb) {
        const int cgi = cg0 + 32 * cb;
        w0[cb] = cw[cgi]; w1[cb] = cw[512 + cgi]; w2[cb] = cw[1024 + cgi]; w3[cb] = cw[1536 + cgi]; cbi[cb] = G_(P->conv_b)[j * 512 + cgi];
        ba[cb] = G_(P->lru_ba)[j * 512 + cgi]; bx[cb] = G_(P->lru_bx)[j * 512 + cgi];
        const float lam = G_(P->lru_lambda)[j * 512 + cgi];
        c8[cb] = 8.0f * (fminf(lam, 0.f) - log1pf(__expf(-fabsf(lam))));
        const bf16* wa = (const bf16*)(wsb + WS_LRUW) + ((size_t)((j * 8 + n) * 64 + c32 + 32 * cb)) * 64 + 8 * hi; const bf16* wx = wa + 16 * 4096;
#pragma unroll
        for (int kk = 0; kk < 4; ++kk) { Ba[cb][kk] = *(const bf16x8*)(wa + 16 * kk); Bx[cb][kk] = *(const bf16x8*)(wx + 16 * kk); }
    }
    const size_t tok0 = (size_t)b * SEQ + ch * 64;
    float hc[2] = {0.f, 0.f}; float Ap[2] = {1.f, 1.f};
    if (pass == 1) {
#pragma unroll
        for (int cb = 0; cb < 2; ++cb) { const float* sa = SA + (size_t)b * 64 * 512 + cg0 + 32 * cb; const float* sh = SH + (size_t)b * 64 * 512 + cg0 + 32 * cb; float h = 0.f;
#pragma unroll 16
            for (int c = 0; c < ch; ++c) h = sa[c * 512] * h + sh[c * 512];
            hc[cb] = h; }
    }
    const int arow = tperm(c32), aswz = (arow >> 1) & 7;
    for (int sub = 0; sub < 2; ++sub) {
        const size_t t0 = tok0 + sub * 32 + 16 * hi;
        const bool first = (ch == 0) && (sub == 0) && (hi == 0);
        f32x16 xc[2];
#pragma unroll
        for (int cb = 0; cb < 2; ++cb) {
            const bf16* yp = Y + t0 * LDY_E + cg0 + 32 * cb;
            float x0 = 0.f, x1 = 0.f, x2 = 0.f;
            if (!first) { x0 = bf2f(*(yp - 3 * (ptrdiff_t)LDY_E)); x1 = bf2f(*(yp - 2 * (ptrdiff_t)LDY_E)); x2 = bf2f(*(yp - (ptrdiff_t)LDY_E)); }
#pragma unroll
            for (int r = 0; r < 16; ++r) { const float xv = bf2f(yp[(size_t)r * LDY_E]); xc[cb][r] = cbi[cb] + w0[cb] * x0 + w1[cb] * x1 + w2[cb] * x2 + w3[cb] * xv; x0 = x1; x1 = x2; x2 = xv; }
#pragma unroll
            for (int r = 0; r < 16; ++r) { const int tt = 16 * hi + r, col = c32 + 32 * cb;
                *(LAS bf16*)(xct + tt * 128 + ((((col >> 3) ^ ((tt >> 1) & 7))) << 4) + (col & 7) * 2) = f2bf(xc[cb][r]); }
        }
        f32x16 pa[2], px[2];
        pa[0] = (f32x16){}; pa[1] = (f32x16){}; px[0] = (f32x16){}; px[1] = (f32x16){};
#pragma unroll
        for (int kk = 0; kk < 4; ++kk) {
            const bf16x8 af = *(const LAS bf16x8*)(xct + arow * 128 + (((2 * kk + hi) ^ aswz) << 4));
            pa[0] = MFMA32(af, Ba[0][kk], pa[0]); pa[1] = MFMA32(af, Ba[1][kk], pa[1]); px[0] = MFMA32(af, Bx[0][kk], px[0]); px[1] = MFMA32(af, Bx[1][kk], px[1]);
        }
        float Al[2], Hl[2];
#pragma unroll
        for (int cb = 0; cb < 2; ++cb) {
            float al = 1.f, hl = 0.f;
#pragma unroll
            for (int r = 0; r < 16; ++r) {
                const float rg = __builtin_amdgcn_rcpf(1.0f + __expf(-(pa[cb][r] + ba[cb]))), ig = __builtin_amdgcn_rcpf(1.0f + __expf(-(px[cb][r] + bx[cb])));
                const float la = c8[cb] * rg, a = __expf(la), x2 = 2.0f * la;
                const float ems = -x2 * (1.0f + x2 * (0.5f + x2 * ((1.0f / 6) + x2 * ((1.0f / 24) + x2 * ((1.0f / 120) + x2 * (1.0f / 720))))));
                const float em = (x2 > -0.5f) ? ems : 1.0f - a * a;
                const float uu = sqrtf(em) * (ig * xc[cb][r]);
                pa[cb][r] = a; px[cb][r] = uu; hl = a * hl + uu; al *= a;
            }
            Al[cb] = al; Hl[cb] = hl;
        }
#pragma unroll
        for (int cb = 0; cb < 2; ++cb) {
            const float oA = __shfl_xor(Al[cb], 32), oH = __shfl_xor(Hl[cb], 32);
            const float hmid = hi ? (oA * hc[cb] + oH) : (Al[cb] * hc[cb] + Hl[cb]);
            const float hin = hi ? hmid : hc[cb];
            const float hend = hi ? (Al[cb] * hmid + Hl[cb]) : (oA * hmid + oH);
            Ap[cb] *= Al[cb] * oA;
            if (pass == 1) {
                const bf16* gp = Y + t0 * LDY_E + 512 + cg0 + 32 * cb; bf16* op = OM + t0 * 1024 + cg0 + 32 * cb;
                float h = hin;
#pragma unroll
                for (int rh = 0; rh < 16; rh += 8) {
                    bf16 graw[8];
#pragma unroll
                    for (int r = 0; r < 8; ++r) graw[r] = gp[(size_t)(rh + r) * LDY_E];
#pragma unroll
                    for (int r = 0; r < 8; ++r) { h = pa[cb][rh + r] * h + px[cb][rh + r]; const float g = bf2f(graw[r]); op[(size_t)(rh + r) * 1024] = f2bf(h * g * __builtin_amdgcn_rcpf(1.0f + __expf(-g))); }
                }
            }
            hc[cb] = hend;
        }
    }
    if (pass == 0 && hi == 0) {
#pragma unroll
        for (int cb = 0; cb < 2; ++cb) { SA[((size_t)b * 64 + ch) * 512 + cg0 + 32 * cb] = Ap[cb]; SH[((size_t)b * 64 + ch) * 512 + cg0 + 32 * cb] = hc[cb]; }
    }
}

__device__ __forceinline__ int tile_off(int row, int chunk) { return row * 128 + ((chunk ^ ((row >> 1) & 7)) << 4); }
__device__ __forceinline__ int kperm(int i) { return (i & 0x13) | ((i & 4) << 1) | ((i & 8) >> 1); }

__device__ __forceinline__ void sb_unit(KPtr P, unsigned char* wsb, int b, int h, int qb, LAS unsigned char* lds, int tid, int wave, int lane) {
    const bf16* Y = (const bf16*)(wsb + WS_Y); const bf16* VT = (const bf16*)(wsb + WS_VT); bf16* OM = (bf16*)(wsb + WS_OMIX);
    asm volatile("" : "+v"(lane));
    const int r32 = lane & 31, hi = lane >> 5;
    const size_t rowbase = (size_t)b * SEQ; const int q0 = qb * 256, qw0 = q0 + wave * 32;
    const int srow = wave * 8 + (lane >> 3), sch = (lane & 7) ^ ((srow >> 1) & 7);
    const bf16* kg = Y + (rowbase + srow) * LDY_E + 1536 + h * 64 + sch * 8;
    const bf16* vg = VT + ((size_t)(b * 8 + h) * 64) * 4096 + srow * 64 + sch * 8;
    bf16x8 qr[4];
#pragma unroll
    for (int d0 = 0; d0 < 4; ++d0) qr[d0] = *(const bf16x8*)(Y + (rowbase + qw0 + r32) * LDY_E + 1024 + h * 64 + d0 * 16 + hi * 8);
    const int krow = kperm(r32), kswz = (krow >> 1) & 7, vswz = (r32 >> 1) & 7;
    f32x16 o0 = {}, o1 = {};
    float R = 1.0f;
    const int jmax = (q0 + 255) >> 6;
    GLDS16(kg + (size_t)(jmax * 64) * LDY_E, lds + wave * 1024); GLDS16(vg + (size_t)jmax * 4096, lds + 8192 + wave * 1024);
    LAS unsigned* alive = (LAS unsigned*)(lds + 32768);
    if (tid < 3) alive[tid] = 0u;
    __syncthreads();
    int it = 0, aw = 0; bool walive = true;
    for (int j = jmax; j >= 0; --j, ++it) {
        LAS unsigned char* Kb = lds + (it & 1) * 16384; LAS unsigned char* Vb = Kb + 8192;
        if (j > 0) { LAS unsigned char* Kn = lds + ((it + 1) & 1) * 16384 + wave * 1024; GLDS16(kg + (size_t)((j - 1) * 64) * LDY_E, Kn); GLDS16(vg + (size_t)(j - 1) * 4096, Kn + 8192); }
        const int k0 = j * 64;
        if (k0 < qw0 + 31 && walive) {
            f32x16 p0 = {}, p1 = {};
#pragma unroll
            for (int d0 = 0; d0 < 4; ++d0) {
                const int co = ((2 * d0 + hi) ^ kswz) << 4;
                const bf16x8 a0 = *(const LAS bf16x8*)(Kb + krow * 128 + co), a1 = *(const LAS bf16x8*)(Kb + (krow + 32) * 128 + co);
                p0 = MFMA32(a0, qr[d0], p0); p1 = MFMA32(a1, qr[d0], p1);
            }
            const int tq = qw0 + r32; const bool need_mask = (k0 + 63 >= qw0);
            if (need_mask) {
                asm volatile("" ::: );
#pragma unroll
                for (int r = 0; r < 16; ++r) { const int s = k0 + 16 * (r >> 3) + 8 * hi + (r & 7); if (s >= tq) p0[r] = -INFINITY; if (s + 32 >= tq) p1[r] = -INFINITY; }
            }
            f32x16 b0, b1;
#pragma unroll
            for (int r = 0; r < 16; ++r) {
                { const float om = __builtin_amdgcn_rcpf(1.0f + __builtin_amdgcn_exp2f(p0[r])); p0[r] = om; b0[r] = 1.0f - om; }
                { const float om = __builtin_amdgcn_rcpf(1.0f + __builtin_amdgcn_exp2f(p1[r])); p1[r] = om; b1[r] = 1.0f - om; }
            }
            f32x4 own;
            own[0] = ((p0[0] * p0[1]) * (p0[2] * p0[3])) * ((p0[4] * p0[5]) * (p0[6] * p0[7]));
            own[1] = ((p0[8] * p0[9]) * (p0[10] * p0[11])) * ((p0[12] * p0[13]) * (p0[14] * p0[15]));
            own[2] = ((p1[0] * p1[1]) * (p1[2] * p1[3])) * ((p1[4] * p1[5]) * (p1[6] * p1[7]));
            own[3] = ((p1[8] * p1[9]) * (p1[10] * p1[11])) * ((p1[12] * p1[13]) * (p1[14] * p1[15]));
            const float t0 = __shfl_xor(own[0], 32), t1 = __shfl_xor(own[1], 32), t2 = __shfl_xor(own[2], 32), t3 = __shfl_xor(own[3], 32);
            const float a0 = hi ? t0 : own[0], a1 = hi ? own[0] : t0, a2 = hi ? t1 : own[1], a3 = hi ? own[1] : t1, a4 = hi ? t2 : own[2], a5 = hi ? own[2] : t2, a6 = hi ? t3 : own[3], a7 = hi ? own[3] : t3;
            const float s7 = 1.0f, s6 = a7, s5 = s6 * a6, s4 = s5 * a5, s3 = s4 * a4, s2 = s3 * a3, s1 = s2 * a2, s0 = s1 * a1;
            const float total = s0 * a0;
            { float run = (hi ? s1 : s0) * R;
#pragma unroll
              for (int jj = 7; jj >= 0; --jj) { const float w = b0[jj] * run; run *= p0[jj]; b0[jj] = w; } }
            { float run = (hi ? s3 : s2) * R;
#pragma unroll
              for (int jj = 7; jj >= 0; --jj) { const float w = b0[8 + jj] * run; run *= p0[8 + jj]; b0[8 + jj] = w; } }
            { float run = (hi ? s5 : s4) * R;
#pragma unroll
              for (int jj = 7; jj >= 0; --jj) { const float w = b1[jj] * run; run *= p1[jj]; b1[jj] = w; } }
            { float run = (hi ? s7 : s6) * R;
#pragma unroll
              for (int jj = 7; jj >= 0; --jj) { const float w = b1[8 + jj] * run; run *= p1[8 + jj]; b1[8 + jj] = w; } }
            R *= total;
            const u32x4 pw0 = {cvtpk(b0[0], b0[1]), cvtpk(b0[2], b0[3]), cvtpk(b0[4], b0[5]), cvtpk(b0[6], b0[7])}, pw1 = {cvtpk(b0[8], b0[9]), cvtpk(b0[10], b0[11]), cvtpk(b0[12], b0[13]), cvtpk(b0[14], b0[15])};
            const u32x4 pw2 = {cvtpk(b1[0], b1[1]), cvtpk(b1[2], b1[3]), cvtpk(b1[4], b1[5]), cvtpk(b1[6], b1[7])}, pw3 = {cvtpk(b1[8], b1[9]), cvtpk(b1[10], b1[11]), cvtpk(b1[12], b1[13]), cvtpk(b1[14], b1[15])};
#define SB_PV(kk, pw) { const int co = ((2 * (kk) + hi) ^ vswz) << 4; const bf16x8 v0 = *(const LAS bf16x8*)(Vb + r32 * 128 + co), v1 = *(const LAS bf16x8*)(Vb + (r32 + 32) * 128 + co); \
                o0 = MFMA32(__builtin_bit_cast(bf16x8, pw), v0, o0); o1 = MFMA32(__builtin_bit_cast(bf16x8, pw), v1, o1); }
            SB_PV(0, pw0) SB_PV(1, pw1) SB_PV(2, pw2) SB_PV(3, pw3)
#undef SB_PV
        }
        const int an = (aw == 2) ? 0 : aw + 1;
        walive = __any(R != 0.0f);
        if (walive && lane == 0) alive[aw] = 1u;
        if (tid == 0) alive[an] = 0u;
        __syncthreads();
        if (alive[aw] == 0u) break;
        aw = an;
    }
    int r32e = r32; asm volatile("" : "+v"(r32e));
    bf16 gr0[16], gr1[16];
#pragma unroll
    for (int r = 0; r < 16; ++r) { const size_t tok = rowbase + qw0 + crow(r, hi); gr0[r] = Y[tok * LDY_E + 2048 + h * 64 + r32e]; gr1[r] = Y[tok * LDY_E + 2048 + h * 64 + 32 + r32e]; }
#pragma unroll
    for (int r = 0; r < 16; ++r) {
        const size_t tok = rowbase + qw0 + crow(r, hi);
        const float g0 = bf2f(gr0[r]), g1 = bf2f(gr1[r]);
        OM[tok * 1024 + 512 + h * 64 + r32e] = f2bf(o0[r] * g0 * __builtin_amdgcn_rcpf(1.0f + __expf(-g0)));
        OM[tok * 1024 + 512 + h * 64 + 32 + r32e] = f2bf(o1[r] * g1 * __builtin_amdgcn_rcpf(1.0f + __expf(-g1)));
    }
    __syncthreads();
}

__device__ __forceinline__ void diff_map_half(LAS unsigned char* Qb  , LAS unsigned char* Kb, LAS unsigned char* Vb, LAS float* wsf, f32x16 (&O)[4], float& mrow, float& lrow,
                                              int kbase  , int p, int tq, bool need_mask, int krow, int kswz, int vswz, int r32, int hi) {
    f32x16 s = {};
#pragma unroll
    for (int d0 = 0; d0 < 4; ++d0) {
        const int co = ((2 * d0 + hi) ^ kswz) << 4;
        const bf16x8 a0 = *(const LAS bf16x8*)(Kb + (krow + 32 * p) * 128 + co);
        const bf16x8 qf = *(const LAS bf16x8*)(Qb + r32 * 128 + (((2 * d0 + hi) ^ vswz) << 4));
        s = MFMA32(a0, qf, s);
    }
    if (need_mask) {
        asm volatile("" ::: );
#pragma unroll
        for (int r = 0; r < 16; ++r) { const int key = kbase + 16 * (r >> 3) + 8 * hi + (r & 7); if (key > tq) s[r] = -INFINITY; }
    }
    float mx = fmaxf(s[0], s[1]);
#pragma unroll
    for (int r = 2; r < 16; ++r) mx = fmaxf(mx, s[r]);
    { const auto rr = __builtin_amdgcn_permlane32_swap(__float_as_uint(mx), __float_as_uint(mx), false, false); mx = fmaxf(__uint_as_float(rr[0]), __uint_as_float(rr[1])); }
    constexpr float DIFF_THR = 8.0f;
    float mnew = mrow;
    if (__any(mx > mrow + DIFF_THR)) {
        mnew = fmaxf(mrow, mx);
        const float alpha = __builtin_amdgcn_exp2f(mrow - mnew);
        lrow *= alpha;
        if (hi == 0) wsf[r32] = alpha;
#pragma unroll
        for (int r = 0; r < 16; ++r) { const float al = wsf[crow(r, hi)];
#pragma unroll
            for (int dd = 0; dd < 4; ++dd) O[dd][r] *= al; }
    }
    mrow = mnew;
    float sum = 0.f;
#pragma unroll
    for (int r = 0; r < 16; ++r) { s[r] = __builtin_amdgcn_exp2f(s[r] - mnew); sum += s[r]; }
    lrow += sum;
    const u32x4 pw0 = {cvtpk(s[0], s[1]), cvtpk(s[2], s[3]), cvtpk(s[4], s[5]), cvtpk(s[6], s[7])}, pw1 = {cvtpk(s[8], s[9]), cvtpk(s[10], s[11]), cvtpk(s[12], s[13]), cvtpk(s[14], s[15])};
#pragma unroll
    for (int dd = 0; dd < 4; ++dd) {
        const bf16x8 v0 = *(const LAS bf16x8*)(Vb + (r32 + 32 * dd) * 128 + (((4 * p + hi) ^ vswz) << 4)), v1 = *(const LAS bf16x8*)(Vb + (r32 + 32 * dd) * 128 + (((4 * p + 2 + hi) ^ vswz) << 4));
        O[dd] = MFMA32(__builtin_bit_cast(bf16x8, pw0), v0, O[dd]); O[dd] = MFMA32(__builtin_bit_cast(bf16x8, pw1), v1, O[dd]);
    }
}

__device__ __forceinline__ void diff_unit(KPtr P, unsigned char* wsb, int jl, float lam, int b, int h, int qb, LAS unsigned char* lds, int tid, int wave, int lane) {
    const bf16* Y = (const bf16*)(wsb + WS_Y); const bf16* VT = (const bf16*)(wsb + WS_VT); bf16* OM = (bf16*)(wsb + WS_OMIX);
    asm volatile("" : "+v"(lane));
    const int r32 = lane & 31, hi = lane >> 5;
    const size_t rowbase = (size_t)b * SEQ; const int q0 = qb * 256, qw0 = q0 + wave * 32;
    const int srow = wave * 8 + (lane >> 3), sch = (lane & 7) ^ ((srow >> 1) & 7);
    const bf16* k1g = Y + (rowbase + srow) * LDY_O + 1024 + (2 * h) * 64 + sch * 8;
    const bf16* k2g = k1g + 64;
    const bf16* vg = VT + ((size_t)(b * 8 + h) * 64) * 8192 + srow * 64 + sch * 8;
    constexpr int BUF = 32768;
    LAS float* wsf = (LAS float*)(lds + 2 * BUF) + wave * 64;
    LAS unsigned char* Q1b = lds + 2 * BUF + 2048 + wave * 8192; LAS unsigned char* Q2b = Q1b + 4096;
#pragma unroll
    for (int i = 0; i < 4; ++i) { const int qrow = 8 * i + (lane >> 3), qch = (lane & 7) ^ ((qrow >> 1) & 7); const bf16* qp = Y + (rowbase + qw0 + qrow) * LDY_O + (2 * h) * 64 + qch * 8;
        GLDS16(qp, Q1b + i * 1024); GLDS16(qp + 64, Q2b + i * 1024); }
    const int krow = kperm(r32), kswz = (krow >> 1) & 7, vswz = (r32 >> 1) & 7;
    f32x16 O1[4], O2[4];
#pragma unroll
    for (int dd = 0; dd < 4; ++dd) { O1[dd] = (f32x16){}; O2[dd] = (f32x16){}; }
    float m1 = -INFINITY, m2 = -INFINITY, l1 = 0.f, l2 = 0.f;
    const int jmax = (q0 + 255) >> 6;
    { LAS unsigned char* Bn = lds + wave * 1024; GLDS16(k1g, Bn); GLDS16(k2g, Bn + 8192); GLDS16(vg, Bn + 16384); GLDS16(vg + 4096, Bn + 24576); }
    __syncthreads();
    const int tq = qw0 + r32;
    for (int j = 0; j <= jmax; ++j) {
        LAS unsigned char* B0 = lds + (j & 1) * BUF;
        if (j < jmax) { const size_t ko = (size_t)(j + 1) * 64; LAS unsigned char* Bn = lds + ((j + 1) & 1) * BUF + wave * 1024; GLDS16(k1g + ko * LDY_O, Bn); GLDS16(k2g + ko * LDY_O, Bn + 8192); GLDS16(vg + (size_t)(j + 1) * 8192, Bn + 16384); GLDS16(vg + (size_t)(j + 1) * 8192 + 4096, Bn + 24576); }
        const int k0 = j * 64;
        if (k0 <= qw0 + 31) {
            const bool need_mask = (k0 + 63 > qw0);
            diff_map_half(Q1b, B0, B0 + 16384, wsf, O1, m1, l1, k0, 0, tq, need_mask, krow, kswz, vswz, r32, hi);
            diff_map_half(Q2b, B0 + 8192, B0 + 16384, wsf + 32, O2, m2, l2, k0, 0, tq, need_mask, krow, kswz, vswz, r32, hi);
            if (k0 + 32 <= qw0 + 31) {
                diff_map_half(Q1b, B0, B0 + 16384, wsf, O1, m1, l1, k0 + 32, 1, tq, need_mask, krow, kswz, vswz, r32, hi);
                diff_map_half(Q2b, B0 + 8192, B0 + 16384, wsf + 32, O2, m2, l2, k0 + 32, 1, tq, need_mask, krow, kswz, vswz, r32, hi);
            }
        }
        __syncthreads();
    }
    l1 += __shfl_xor(l1, 32); l2 += __shfl_xor(l2, 32);
    int r32e = r32; asm volatile("" : "+v"(r32e));
    if (hi == 0) { wsf[r32] = __builtin_amdgcn_rcpf(l1); wsf[32 + r32] = lam * __builtin_amdgcn_rcpf(l2); }
    const float* sg = G_(P->subln_g) + jl * 128; const float post = 1.0f - P->lam_init[jl];
    f32x4 gsc;
#pragma unroll
    for (int dd = 0; dd < 4; ++dd) gsc[dd] = sg[32 * dd + r32e] * post;
#pragma unroll
    for (int rh = 0; rh < 16; rh += 4) {
        bf16 graw[4][4];
#pragma unroll
        for (int r = 0; r < 4; ++r)
#pragma unroll
            for (int dd = 0; dd < 4; ++dd) graw[r][dd] = Y[(rowbase + qw0 + crow(rh + r, hi)) * LDY_O + 2048 + h * 128 + 32 * dd + r32e];
#pragma unroll
        for (int r8 = 0; r8 < 4; ++r8) {
            const int r = rh + r8;
            const int qr_ = crow(r, hi); const float i1 = wsf[qr_], i2 = wsf[32 + qr_];
            f32x4 v; float sq = 0.f;
#pragma unroll
            for (int dd = 0; dd < 4; ++dd) { v[dd] = O1[dd][r] * i1 - O2[dd][r] * i2; sq += v[dd] * v[dd]; }
            sq += __shfl_xor(sq, 1); sq += __shfl_xor(sq, 2); sq += __shfl_xor(sq, 4); sq += __shfl_xor(sq, 8); sq += __shfl_xor(sq, 16);
            const float rn = __builtin_amdgcn_rsqf(sq * (1.0f / 128.0f) + 1e-6f);
            const size_t tok = rowbase + qw0 + qr_;
#pragma unroll
            for (int dd = 0; dd < 4; ++dd) { const float g = bf2f(graw[r8][dd]);
                OM[tok * 1024 + h * 128 + 32 * dd + r32e] = f2bf(v[dd] * rn * gsc[dd] * g * __builtin_amdgcn_rcpf(1.0f + __expf(-g))); }
        }
    }
    __syncthreads();
}

#define XB_TMO      128
#define XB_XCNT(j)  (256  + 64 * (j))
#define XB_XSUB(j)  (1280 + 64 * (j))
#define XB_XGEN(j)  (2304 + 64 * (j))
#define XB_TOP      3328
#define XB_TOPGEN   3392
#define XCD_BAR_WORDS 3456
#define XB_SPIN_CAP (1u << 18)

__device__ __forceinline__ unsigned xb_ld(unsigned* p)              { return __hip_atomic_load(p, __ATOMIC_RELAXED, __HIP_MEMORY_SCOPE_AGENT); }
__device__ __forceinline__ unsigned xb_add(unsigned* p, unsigned v) { return __hip_atomic_fetch_add(p, v, __ATOMIC_RELAXED, __HIP_MEMORY_SCOPE_AGENT); }
__device__ __forceinline__ unsigned xb_xcc_id() { return (unsigned)__builtin_amdgcn_s_getreg((3 << 11) | 20) & 0xFu; }
#define XB_SPIN(cond, bar) do { unsigned _sp = 0; while (cond) { __builtin_amdgcn_s_sleep(1); \
    if ((++_sp & 255u) == 0u) { if (xb_ld(&(bar)[XB_TMO])) break; if (_sp > XB_SPIN_CAP) { atomicAdd(&(bar)[XB_TMO], 1u); break; } } } } while (0)

struct XcdBarrier {
    unsigned* bar; unsigned x;
    volatile LAS unsigned* st;
};

__device__ __forceinline__ XcdBarrier xcd_barrier_post(unsigned* bar, volatile LAS unsigned* st) {
    XcdBarrier b; b.bar = bar; b.x = xb_xcc_id(); b.st = st;
    if (threadIdx.x == 0) (void)xb_add(&bar[XB_XCNT(b.x)], 1u);
    return b;
}
__device__ __forceinline__ void xcd_barrier_complete(unsigned* bar, unsigned x, unsigned& nloc, unsigned& nx) {
    const unsigned G = gridDim.x * gridDim.y * gridDim.z;
    unsigned sum, cnt, mine, sp = 0u;
    for (;;) {
        sum = 0u; cnt = 0u; mine = 0u;
#pragma unroll
        for (unsigned j = 0; j < 16; ++j) { const unsigned c = xb_ld(&bar[XB_XCNT(j)]); sum += c; cnt += (c > 0u) ? 1u : 0u; mine = (j == x) ? c : mine; }
        if (sum == G) break;
        __builtin_amdgcn_s_sleep(1);
        if ((++sp & 255u) == 0u) { if (xb_ld(&bar[XB_TMO])) break; if (sp > XB_SPIN_CAP) { atomicAdd(&bar[XB_TMO], 1u); break; } }
    }
    nloc = mine > 0u ? mine : 1u; nx = cnt > 0u ? cnt : 1u;
}

__device__ __forceinline__ void xcd_barrier(const XcdBarrier& b) {
    asm volatile("s_waitcnt vmcnt(0)" ::: "memory");
    __syncthreads();
    if (threadIdx.x == 0) {
        unsigned* bar = b.bar;
        __builtin_amdgcn_s_waitcnt(0);
        unsigned nloc = b.st[0], nx = b.st[1];
        if (nloc == 0u) { xcd_barrier_complete(bar, b.x, nloc, nx); b.st[0] = nloc; b.st[1] = nx; }
        const unsigned old = xb_add(&bar[XB_XSUB(b.x)], 1u);
        const unsigned gen = old / nloc;
        if (old + 1u == (gen + 1u) * nloc) {
            __builtin_amdgcn_fence(__ATOMIC_RELEASE, "agent");
            asm volatile("s_waitcnt vmcnt(0)" ::: "memory");
            const unsigned og = xb_add(&bar[XB_TOP], 1u);
            const unsigned tg = og / nx;
            if (og + 1u == (tg + 1u) * nx) xb_add(&bar[XB_TOPGEN], 1u);
            else XB_SPIN(xb_ld(&bar[XB_TOPGEN]) == tg, bar);
            __builtin_amdgcn_fence(__ATOMIC_ACQUIRE, "agent");
            xb_add(&bar[XB_XGEN(b.x)], 1u);
            asm volatile("s_waitcnt vmcnt(0)" ::: "memory");
        } else {
            XB_SPIN(xb_ld(&bar[XB_XGEN(b.x)]) == gen, bar);
            __builtin_amdgcn_fence(__ATOMIC_ACQUIRE, "agent");
            asm volatile("s_waitcnt vmcnt(0)" ::: "memory");
        }
    }
    __syncthreads();
}

#ifndef DUP_MASK
#define DUP_MASK 0
#endif
#define GSYNC() do { xcd_barrier(xbar); if (DUP_MASK & 128) xcd_barrier(xbar); } while (0)
__global__ void __launch_bounds__(NTHREADS, 2) trunk_fwd(Params Pv) {
    extern __shared__ __attribute__((aligned(16))) unsigned char lds_raw[];
    LAS unsigned char* lds = (LAS unsigned char*)lds_raw;
    cg::grid_group grid = cg::this_grid();
    const int tid0 = threadIdx.x, lane0 = tid0 & 63, wave0 = __builtin_amdgcn_readfirstlane(tid0 >> 6);
    const int G = gridDim.x, bx = blockIdx.x, vcu = (G % 8 == 0) ? (bx % 8) * (G / 8) + bx / 8 : bx;

    volatile LAS unsigned* bst = (volatile LAS unsigned*)(lds + LDS_BYTES - 64);
    if (tid0 < 2) bst[tid0] = 0u;
    __syncthreads();
    XcdBarrier xbar;
    { KPtr P = KP_GET(); xbar = xcd_barrier_post((unsigned*)G_(P->ws), bst);
      prologue(P, lds, vcu, G, wave0, lane0);
      convert_p(P, G_(P->ws), 0, vcu, G, tid0); }
    grid.sync();

    for (int layer = 0; layer < 4; ++layer) {
        const int jl = layer >> 1; const bool odd = layer & 1;
        int tid = threadIdx.x; asm volatile("" : "+v"(tid));
        KPtr P = KP_GET();
        unsigned char* ws = P->ws; asm volatile("" : "+s"(ws)); ws = G_(ws);
        pg8::ss_t* SS = (pg8::ss_t*)(ws + WS_SS);
        bf16* HB0 = (bf16*)(ws + WS_HB0); bf16* HB1 = (bf16*)(ws + WS_HB1); bf16* OMIX = (bf16*)(ws + WS_OMIX); bf16* Yb = (bf16*)(ws + WS_Y); bf16* VTb = (bf16*)(ws + WS_VT); bf16* PPb = (bf16*)(ws + WS_PP); bf16* PBb = (bf16*)(ws + WS_PB);
        const int lane = tid & 63, wave = __builtin_amdgcn_readfirstlane(tid >> 6);
        const pg8::ss_t* ss_mix = SS + (size_t)layer * MT; pg8::ss_t* ss_ple = SS + (size_t)(4 + layer) * MT; pg8::ss_t* ss_next = SS + (size_t)(layer < 3 ? layer + 1 : 8) * MT;
        {
            const bf16* Wt = odd ? (const bf16*)(ws + WS_WINO) + (size_t)jl * 4096 * 1024 : (const bf16*)(ws + WS_WINE) + (size_t)jl * 3072 * 1024;
            const int nmain = odd ? 3072 : 2560, nv = odd ? 1024 : 512;
            for (int rep = 0; rep < ((DUP_MASK & 1) ? 2 : 1); ++rep) {
            { pg8::Gemm g{HB0, Wt, MT, nmain, 1024}; pg8::StaticOrder S; S.init(MT, nmain, G, bx);
              pg8::EpiY E{Yb, nmain, ss_mix, (const float*)(ws + WS_ROPE), odd ? 8 : 0};
              pg8::gemm_phase<pg8::EpiY, pg8::StaticOrder, true, true>(lds, g, S, E); }
            { pg8::Gemm g{Wt + (size_t)nmain * 1024, HB0, nv, MT, 1024}; pg8::StaticOrder S; S.init(nv, MT, G, bx);
              pg8::EpiVt E{VTb, odd ? 7 : 6, ss_mix};
              pg8::gemm_phase<pg8::EpiVt, pg8::StaticOrder, true, true>(lds, g, S, E); }
            }
        }
        GSYNC();
        if (!odd) {
            LAS unsigned char* xct = lds + wave * 4096;
            for (int rep = 0; rep < ((DUP_MASK & 2) ? 2 : 1); ++rep)
            for (int u = vcu * 8 + wave; u < 4096; u += G * 8) lru_unit(P, ws, jl, u, 0, xct, lane);
            if (layer > 0) convert_p(P, ws, layer, vcu, G, tid);
            GSYNC();
            for (int rep = 0; rep < ((DUP_MASK & 2) ? 2 : 1); ++rep)
            for (int u = vcu * 8 + wave; u < 4096; u += G * 8) lru_unit(P, ws, jl, u, 1, xct, lane);
            __syncthreads();
            for (int rep = 0; rep < ((DUP_MASK & 8) ? 2 : 1); ++rep)
            for (int vv = vcu; vv < 256; vv += G)
                for (int i = 0; i < 4; ++i) { const int li = vv & 31, bh = 8 * (vv >> 5) + 2 * i + (li >> 4), qb = (i & 1) ? 15 - (li & 15) : (li & 15); sb_unit(P, ws, bh >> 3, bh & 7, qb, lds, tid, wave, lane); }
        } else {
            float lam;
            { const float a = wave_sum(lane < 64 ? G_(P->lq1)[jl * 64 + lane] * G_(P->lk1)[jl * 64 + lane] : 0.f), c = wave_sum(G_(P->lq2)[jl * 64 + lane] * G_(P->lk2)[jl * 64 + lane]); lam = __expf(a) - __expf(c) + P->lam_init[jl]; }
            convert_p(P, ws, layer, vcu, G, tid);
            for (int rep = 0; rep < ((DUP_MASK & 16) ? 2 : 1); ++rep)
            for (int vv = vcu; vv < 256; vv += G)
                for (int i = 0; i < 4; ++i) { const int li = vv & 31, bh = 8 * (vv >> 5) + 2 * i + (li >> 4), qb = (i & 1) ? 15 - (li & 15) : (li & 15); diff_unit(P, ws, jl, lam, bh >> 3, bh & 7, qb, lds, tid, wave, lane); }
        }
        GSYNC();
        {
            { pg8::Gemm g{OMIX, (const bf16*)(ws + WS_WOUT) + (size_t)layer * 1024 * 1024, MT, 1024, 1024}; pg8::StaticOrder S; S.init(MT, 1024, G, bx);
              pg8::EpiRes E{layer == 0 ? G_(P->x) : G_(P->out), G_(P->out), HB1, ss_ple};
              pg8::gemm_phase<pg8::EpiRes, pg8::StaticOrder, true, true>(lds, g, S, E); }
            { pg8::Gemm g{PBb, (const bf16*)(ws + WS_WP) + (size_t)layer * 1024 * 256, MT, 1024, 256}; pg8::StaticOrder S; S.init(MT, 1024, G, bx);
              pg8::EpiPlain E{PPb, 1024};
              pg8::gemm_phase<pg8::EpiPlain, pg8::StaticOrder, false, true>(lds, g, S, E); }
        }
        GSYNC();
        {
            pg8::Gemm g{HB1, (const bf16*)(ws + WS_WG) + (size_t)layer * 1024 * 1024, MT, 1024, 1024}; pg8::StaticOrder S; S.init(MT, 1024, G, bx);
            pg8::EpiGate E{ss_ple, HB1, G_(P->out), PPb, HB0, ss_next};
            pg8::gemm_phase<pg8::EpiGate, pg8::StaticOrder, true, true>(lds, g, S, E);
        }
        GSYNC();
    }
    { KPtr P = KP_GET(); final_norm(P, vcu, G, wave0, lane0); }
}

extern "C" void kernel_launch(void* const* d_in, const int* in_sizes, int n_in, void* d_out, int out_size, void* d_ws, size_t ws_size, hipStream_t stream) {
    static int grid = 0;
    if (grid == 0) {
        if (n_in != 24 || out_size != MT * DM || ws_size < WS_END) { fprintf(stderr, "kernel_launch: unexpected problem (n_in %d out %d ws %zu)\n", n_in, out_size, ws_size); grid = -1; return; }
        int dev = 0, cus = 0, per_cu = 0;
        hipGetDevice(&dev); hipDeviceGetAttribute(&cus, hipDeviceAttributeMultiprocessorCount, dev);
        hipFuncSetAttribute((const void*)trunk_fwd, hipFuncAttributeMaxDynamicSharedMemorySize, LDS_BYTES);
        hipOccupancyMaxActiveBlocksPerMultiprocessor(&per_cu, (const void*)trunk_fwd, NTHREADS, LDS_BYTES);
        (void)hipGetLastError();
        if (per_cu < 1) per_cu = 1;
        grid = cus;
        if (grid > 256) grid = 256;
        grid &= ~7;
    }
    if (grid <= 0) return;
    Params P{};
    P.x = (const float*)d_in[0]; P.p = (const float*)d_in[1]; P.pos = (const int*)d_in[2]; P.norm_mix = (const float*)d_in[3]; P.norm_ple = (const float*)d_in[4];
    P.w_ple_gate = (const float*)d_in[5]; P.w_ple_proj = (const float*)d_in[6]; P.w_in_e = (const float*)d_in[7]; P.conv_w = (const float*)d_in[8]; P.conv_b = (const float*)d_in[9];
    P.lru_wa = (const float*)d_in[10]; P.lru_ba = (const float*)d_in[11]; P.lru_wx = (const float*)d_in[12]; P.lru_bx = (const float*)d_in[13]; P.lru_lambda = (const float*)d_in[14];
    P.w_out_e = (const float*)d_in[15]; P.w_in_o = (const float*)d_in[16]; P.lq1 = (const float*)d_in[17]; P.lk1 = (const float*)d_in[18]; P.lq2 = (const float*)d_in[19]; P.lk2 = (const float*)d_in[20];
    P.subln_g = (const float*)d_in[21]; P.w_out_o = (const float*)d_in[22]; P.final_norm = (const float*)d_in[23];
    P.out = (float*)d_out; P.ws = (unsigned char*)d_ws;
    P.lam_init[0] = (float)(0.8 - 0.6 * exp(-0.3 * 1.0)); P.lam_init[1] = (float)(0.8 - 0.6 * exp(-0.3 * 3.0));
    if (hipMemsetAsync(d_ws, 0, 65536, stream) != hipSuccess) { fprintf(stderr, "kernel_launch: memset of the barrier words failed\n"); return; }
    void* args[] = {&P};
    hipError_t e = hipLaunchCooperativeKernel((const void*)trunk_fwd, dim3(grid), dim3(NTHREADS), args, LDS_BYTES, stream);
    if (e != hipSuccess) fprintf(stderr, "cooperative launch failed: %s (grid %d)\n", hipGetErrorString(e), grid);
}
```

```cpp
#include <hip/hip_runtime.h>
#include <hip/hip_cooperative_groups.h>
#include <cstdio>
#include <cstdint>
#include <cmath>
namespace pg8 {
#define PG8_LAS __attribute__((address_space(3)))
typedef unsigned short bf16_t;
typedef short bf16x8 __attribute__((ext_vector_type(8)));
typedef float f32x4 __attribute__((ext_vector_type(4)));
typedef unsigned u32x4 __attribute__((ext_vector_type(4)));
constexpr int BM = 256, BK = 64, HALF = 128, HTB = HALF * BK * 2  , STAGE_BYTES = 8 * HTB, NXCD = 8, WGM = 8;

__host__ __device__ __forceinline__ int lds_byte(int r, int c) { const int st = (r >> 4) * 2 + (c >> 5), rr = r & 15, cc = c & 31, ob = rr * 64 + cc * 2; return st * 1024 + (ob ^ (((ob >> 9) & 1) << 5)); }
__host__ __device__ __forceinline__ void stage_rc(int b, int& R, int& C) { const int st = b / 1024, sb = b % 1024, swz = sb ^ (((sb >> 9) & 1) << 5); R = (st >> 1) * 16 + swz / 64; C = (st & 1) * 32 + (swz % 64) / 2; }
__host__ __device__ __forceinline__ int perm32(int rho) { const int n = rho >> 4, i = rho & 15; return 8 * (i >> 2) + 4 * n + (i & 3); }

struct Unit { int pm, pn; };
struct Gemm { const bf16_t* A; const bf16_t* Bt; int M, N, K; };

struct StaticOrder {
    int nM, nN, nwg, G, c;
    __host__ __device__ void init(int M, int N, int G_, int c_) { nM = M / BM; nN = N / BM; nwg = nM * nN; G = G_; c = c_; }
    __host__ __device__ bool next(int i, Unit& u) const {
        const long L = (long)i * G + c; if (L >= nwg) return false;
        int wgid = (int)L; { const int q = nwg / NXCD, r = nwg % NXCD, xcd = wgid % NXCD, off = wgid / NXCD; wgid = (xcd < r ? xcd * (q + 1) : r * (q + 1) + (xcd - r) * q) + off; }
        const int nig = WGM * nN, gid = wgid / nig, fm = gid * WGM, gsz = (nM - fm) < WGM ? (nM - fm) : WGM;
        u.pm = fm + ((wgid % nig) % gsz); u.pn = (wgid % nig) / gsz; return true;
    }
    __device__ __forceinline__ void a_ready(const Unit&) const {}
    __device__ __forceinline__ void done(const Unit&) const {}
};

__device__ __forceinline__ unsigned cvt_pk_bf16(float lo, float hi) { unsigned r; asm volatile("v_cvt_pk_bf16_f32 %0, %1, %2" : "=v"(r) : "v"(lo), "v"(hi)); return r; }
__device__ __forceinline__ float bf2f(unsigned short u) { return __uint_as_float((unsigned)u << 16); }
__device__ __forceinline__ u32x4 pack8(const f32x4& v0, const f32x4& v1) { u32x4 w; w.x = cvt_pk_bf16(v0[0], v0[1]); w.y = cvt_pk_bf16(v0[2], v0[3]); w.z = cvt_pk_bf16(v1[0], v1[1]); w.w = cvt_pk_bf16(v1[2], v1[3]); return w; }
constexpr float RMS_EPS = 1e-6f;
typedef unsigned long long ss_t;
__device__ __forceinline__ float ss_rstd(ss_t v) { return __builtin_amdgcn_rsqf((float)v * (2.3283064365386963e-10f / 1024.0f) + RMS_EPS); }
__device__ __forceinline__ void ss_add(ss_t* p, float sq) { atomicAdd(p, (ss_t)(sq * 4294967296.0f)); }

struct EpiY {
    static constexpr bool PERM = true, AFTER_DRAIN = false;
    bf16_t* O; int ldc; const ss_t* ss; const float* rope; int rope_pn;
    __device__ __forceinline__ void operator()(const f32x4 (&acc)[2][2][4][2], const Unit& u, int wr, int wc, int fr, int fq) const {
        asm volatile("" : "+v"(fr), "+v"(fq));
        const int row0 = u.pm * BM + wr * 64 + fr, col0 = u.pn * BM + wc * 32 + 8 * fq;
        const bool do_rope = u.pn < rope_pn;
#pragma unroll
        for (int ai = 0; ai < 2; ++ai) {
            ss_t sv[4]; f32x4 c0[4], c1[4];
#pragma unroll
            for (int m = 0; m < 4; ++m) { const int row = row0 + ai * HALF + m * 16; sv[m] = ss[row]; c0[m] = (f32x4){1.f, 0.f, 1.f, 0.f}; c1[m] = (f32x4){1.f, 0.f, 1.f, 0.f};
                if (do_rope) { const float* rp = rope + (size_t)row * 64 + ((wc & 1) * 16 + 4 * fq) * 2; c0[m] = *(const f32x4*)rp; c1[m] = *(const f32x4*)(rp + 4); } }
#pragma unroll
            for (int m = 0; m < 4; ++m) {
                const int row = row0 + ai * HALF + m * 16;
                const float rstd = ss_rstd(sv[m]);
                const f32x4 cs0 = c0[m], cs1 = c1[m];
                bf16_t* rowp = O + (size_t)row * ldc + col0;
#pragma unroll
                for (int bj = 0; bj < 2; ++bj) {
                    f32x4 v0 = acc[ai][bj][m][0] * rstd, v1 = acc[ai][bj][m][1] * rstd;
                    if (do_rope) {
                        const f32x4 c = {cs0[0], cs0[2], cs1[0], cs1[2]}, s = {cs0[1], cs0[3], cs1[1], cs1[3]};
                        const f32x4 o0 = v0 * c - v1 * s, o1 = v1 * c + v0 * s; v0 = o0; v1 = o1;
                    }
                    *(u32x4*)(rowp + bj * HALF) = pack8(v0, v1);
                }
            }
        }
    }
};
struct EpiVt {
    static constexpr bool PERM = true, AFTER_DRAIN = false;
    bf16_t* O; int dvs; const ss_t* ss;
    __device__ __forceinline__ void operator()(const f32x4 (&acc)[2][2][4][2], const Unit& u, int wr, int wc, int fr, int fq) const {
        asm volatile("" : "+v"(fr), "+v"(fq));
        const int row0 = u.pm * BM + wr * 64 + fr, col0 = u.pn * BM + wc * 32 + 8 * fq;
        f32x4 r0[2], r1[2];
#pragma unroll
        for (int bj = 0; bj < 2; ++bj) {
#pragma unroll
            for (int i = 0; i < 4; ++i) { r0[bj][i] = ss_rstd(ss[col0 + bj * HALF + i]); r1[bj][i] = ss_rstd(ss[col0 + bj * HALF + 4 + i]); }
        }
#pragma unroll
        for (int ai = 0; ai < 2; ++ai)
#pragma unroll
            for (int m = 0; m < 4; ++m) {
                const int c = row0 + ai * HALF + m * 16, hh = c >> dvs, d = c & ((1 << dvs) - 1);
#pragma unroll
                for (int bj = 0; bj < 2; ++bj) { const int tok = col0 + bj * HALF, b = tok >> 12, s = tok & 4095;
                    *(u32x4*)(O + ((((size_t)(b * 8 + hh) * 64 + (s >> 6)) << dvs) + d) * 64 + (s & 63)) = pack8(acc[ai][bj][m][0] * r0[bj], acc[ai][bj][m][1] * r1[bj]); }
            }
    }
};
struct EpiPlain {
    static constexpr bool PERM = true, AFTER_DRAIN = false;
    bf16_t* O; int ldc;
    __device__ __forceinline__ void operator()(const f32x4 (&acc)[2][2][4][2], const Unit& u, int wr, int wc, int fr, int fq) const {
        asm volatile("" : "+v"(fr), "+v"(fq));
        const int row0 = u.pm * BM + wr * 64 + fr, col0 = u.pn * BM + wc * 32 + 8 * fq;
#pragma unroll
        for (int ai = 0; ai < 2; ++ai)
#pragma unroll
            for (int m = 0; m < 4; ++m) {
                bf16_t* rowp = O + (size_t)(row0 + ai * HALF + m * 16) * ldc + col0;
#pragma unroll
                for (int bj = 0; bj < 2; ++bj) *(u32x4*)(rowp + bj * HALF) = pack8(acc[ai][bj][m][0], acc[ai][bj][m][1]);
            }
    }
};
struct EpiRes {
    static constexpr bool PERM = true, AFTER_DRAIN = false;
    const float* base; float* out; bf16_t* hb; ss_t* ssacc;
    __device__ __forceinline__ void operator()(const f32x4 (&acc)[2][2][4][2], const Unit& u, int wr, int wc, int fr, int fq) const {
        asm volatile("" : "+v"(fr), "+v"(fq));
        const int row0 = u.pm * BM + wr * 64 + fr, col0 = u.pn * BM + wc * 32 + 8 * fq;
#pragma unroll
        for (int ai = 0; ai < 2; ++ai)
#pragma unroll
            for (int m = 0; m < 4; ++m) {
                const int row = row0 + ai * HALF + m * 16; float sq = 0.f;
#pragma unroll
                for (int bj = 0; bj < 2; ++bj) {
                    const size_t off = (size_t)row * 1024 + col0 + bj * HALF;
                    const f32x4 v0 = *(const f32x4*)(base + off) + acc[ai][bj][m][0], v1 = *(const f32x4*)(base + off + 4) + acc[ai][bj][m][1];
                    *(u32x4*)(hb + off) = pack8(v0, v1);
                    sq += (v0[0] * v0[0] + v0[1] * v0[1]) + (v0[2] * v0[2] + v0[3] * v0[3]) + (v1[0] * v1[0] + v1[1] * v1[1]) + (v1[2] * v1[2] + v1[3] * v1[3]);
                }
                sq += __shfl_xor(sq, 16); sq += __shfl_xor(sq, 32);
                if (fq == 0) ss_add(ssacc + row, sq);
                if (m & 1) asm volatile("" ::: "memory");
            }
    }
};
struct EpiGate {
    static constexpr bool PERM = true, AFTER_DRAIN = false;
    const ss_t* ss; const bf16_t* h1b; float* h; const bf16_t* pp; bf16_t* hb; ss_t* ssacc;
    __device__ __forceinline__ void operator()(const f32x4 (&acc)[2][2][4][2], const Unit& u, int wr, int wc, int fr, int fq) const {
        asm volatile("" : "+v"(fr), "+v"(fq));
        const int row0 = u.pm * BM + wr * 64 + fr, col0 = u.pn * BM + wc * 32 + 8 * fq;
#pragma unroll
        for (int ai = 0; ai < 2; ++ai)
#pragma unroll
            for (int m = 0; m < 4; ++m) {
                const int row = row0 + ai * HALF + m * 16; float sq = 0.f;
                const float rstd = ss_rstd(ss[row]) * -1.4426950408889634f;
#pragma unroll
                for (int bj = 0; bj < 2; ++bj) {
                    const size_t off = (size_t)row * 1024 + col0 + bj * HALF;
                    const u32x4 pw = *(const u32x4*)(pp + off);
                    const f32x4 p0 = {__uint_as_float(pw.x << 16), __uint_as_float(pw.x & 0xffff0000u), __uint_as_float(pw.y << 16), __uint_as_float(pw.y & 0xffff0000u)};
                    const f32x4 p1 = {__uint_as_float(pw.z << 16), __uint_as_float(pw.z & 0xffff0000u), __uint_as_float(pw.w << 16), __uint_as_float(pw.w & 0xffff0000u)};
                    f32x4 g0, g1;
#pragma unroll
                    for (int i = 0; i < 4; ++i) { g0[i] = __builtin_amdgcn_rcpf(1.0f + __builtin_amdgcn_exp2f(acc[ai][bj][m][0][i] * rstd)); g1[i] = __builtin_amdgcn_rcpf(1.0f + __builtin_amdgcn_exp2f(acc[ai][bj][m][1][i] * rstd)); }
                    const u32x4 hw = *(const u32x4*)(h1b + off);
                    const f32x4 h0 = {__uint_as_float(hw.x << 16), __uint_as_float(hw.x & 0xffff0000u), __uint_as_float(hw.y << 16), __uint_as_float(hw.y & 0xffff0000u)};
                    const f32x4 h1 = {__uint_as_float(hw.z << 16), __uint_as_float(hw.z & 0xffff0000u), __uint_as_float(hw.w << 16), __uint_as_float(hw.w & 0xffff0000u)};
                    const f32x4 v0 = h0 + g0 * p0, v1 = h1 + g1 * p1;
                    *(f32x4*)(h + off) = v0; *(f32x4*)(h + off + 4) = v1; *(u32x4*)(hb + off) = pack8(v0, v1);
                    sq += (v0[0] * v0[0] + v0[1] * v0[1]) + (v0[2] * v0[2] + v0[3] * v0[3]) + (v1[0] * v1[0] + v1[1] * v1[1]) + (v1[2] * v1[2] + v1[3] * v1[3]);
                }
                sq += __shfl_xor(sq, 16); sq += __shfl_xor(sq, 32);
                if (fq == 0) ss_add(ssacc + row, sq);
                if (m & 1) asm volatile("" ::: "memory");
            }
    }
};
template <class Epi, class Sched, bool ALIGN_EPI = false, bool SP2 = false>
__device__ __forceinline__ void gemm_phase(PG8_LAS unsigned char* lds, const Gemm g, const Sched& S, const Epi& E) {
    int tid_ = threadIdx.x; asm volatile("" : "+v"(tid_));
    const int tid = tid_, wid = __builtin_amdgcn_readfirstlane(tid >> 6), lane = tid & 63, wr = wid >> 2, wc = wid & 3, fr = lane & 15, fq = lane >> 4;
    const int K = g.K, nt = K / BK;
    unsigned voffA[2], voffB[2];
#pragma unroll
    for (int i = 0; i < 2; ++i) { int R, C; stage_rc(tid * 16 + i * 8192, R, C); const int Rb = Epi::PERM ? ((R & ~31) + perm32(R & 31)) : R;
        voffA[i] = (unsigned)(R * K + C) * 2u; voffB[i] = (unsigned)(Rb * K + C) * 2u; }
    const size_t kstep = (size_t)(BK * 2);
    const size_t hstep = (size_t)HALF * K * 2;
    const size_t tstep = 2 * hstep;
    const unsigned ldsw = (unsigned)wid * 1024u;
    const int aoff = lds_byte(wr * 64 + fr, fq * 8), boff = lds_byte(wc * 32 + fr, fq * 8);
#define PG8_SA(b, h) (((b) * 2 + (h)) * HTB)
#define PG8_SB(b, h) ((4 + (b) * 2 + (h)) * HTB)
#define PG8_STAGE(bufoff, gbase, voff) do { _Pragma("unroll") for (int _i = 0; _i < 2; ++_i) \
        __builtin_amdgcn_global_load_lds((const unsigned*)((const char*)(gbase) + (voff)[_i]), (PG8_LAS unsigned*)(lds + (bufoff) + ldsw + _i * 8192), 16, 0, 0); } while (0)
#define PG8_LDA(dst, b, h) do { _Pragma("unroll") for (int m = 0; m < 4; ++m) _Pragma("unroll") for (int k = 0; k < 2; ++k) dst[m][k] = *(const PG8_LAS bf16x8*)(lds + PG8_SA(b, h) + aoff + m * 2048 + k * 1024); } while (0)
#define PG8_LDB(dst, b, h) do { _Pragma("unroll") for (int n = 0; n < 2; ++n) _Pragma("unroll") for (int k = 0; k < 2; ++k) dst[n][k] = *(const PG8_LAS bf16x8*)(lds + PG8_SB(b, h) + boff + n * 2048 + k * 1024); } while (0)
#define PG8_MMA(ai, bj, At, Bt) do { __builtin_amdgcn_s_setprio(1); _Pragma("unroll") for (int m = 0; m < 4; ++m) _Pragma("unroll") for (int n = 0; n < 2; ++n) _Pragma("unroll") for (int k = 0; k < 2; ++k) \
        acc[ai][bj][m][n] = __builtin_amdgcn_mfma_f32_16x16x32_bf16(Bt[n][k], At[m][k], acc[ai][bj][m][n], 0, 0, 0); __builtin_amdgcn_s_setprio(0); } while (0)
#define PG8_WAIT_V(n) asm volatile("s_waitcnt vmcnt(" #n ")" ::: "memory")
#define PG8_WAIT_L(n) asm volatile("s_waitcnt lgkmcnt(" #n ")" ::: "memory")
#define PG8_BAR __builtin_amdgcn_s_barrier()
#define PG8_SCHED __builtin_amdgcn_sched_barrier(0)
    Unit cur, nxt; int ui = 0;
    if (!S.next(0, cur)) return;
    f32x4 acc[2][2][4][2];
#pragma unroll
    for (int a = 0; a < 2; ++a)
#pragma unroll
        for (int b = 0; b < 2; ++b)
#pragma unroll
            for (int m = 0; m < 4; ++m)
#pragma unroll
                for (int n = 0; n < 2; ++n) acc[a][b][m][n] = (f32x4){0.f, 0.f, 0.f, 0.f};
    bf16x8 At[4][2], B0[2][2], B1[2][2];
    const char* cA = (const char*)g.A + (size_t)cur.pm * tstep; const char* cB = (const char*)g.Bt + (size_t)cur.pn * tstep;
    S.a_ready(cur);
    if constexpr (SP2) {
        PG8_STAGE(PG8_SB(0, 0), cB, voffB); PG8_STAGE(PG8_SB(0, 1), cB + hstep, voffB); PG8_STAGE(PG8_SA(0, 0), cA, voffA); PG8_STAGE(PG8_SA(0, 1), cA + hstep, voffA);
        if (wr == 1) PG8_BAR;
        PG8_WAIT_V(2); PG8_BAR;
        PG8_STAGE(PG8_SB(1, 0), cB + kstep, voffB); PG8_STAGE(PG8_SA(1, 0), cA + kstep, voffA); PG8_STAGE(PG8_SB(1, 1), cB + hstep + kstep, voffB);
        PG8_WAIT_V(6); PG8_BAR;
    } else {
        PG8_STAGE(PG8_SB(0, 0), cB, voffB); PG8_STAGE(PG8_SA(0, 0), cA, voffA); PG8_STAGE(PG8_SB(0, 1), cB + hstep, voffB); PG8_STAGE(PG8_SA(0, 1), cA + hstep, voffA);
        if (wr == 1) PG8_BAR;
        PG8_WAIT_V(4); PG8_BAR;
        PG8_STAGE(PG8_SB(1, 0), cB + kstep, voffB); PG8_STAGE(PG8_SA(1, 0), cA + kstep, voffA); PG8_STAGE(PG8_SB(1, 1), cB + hstep + kstep, voffB);
        PG8_WAIT_V(6); PG8_BAR;
    }
    for (;;) {
        const bool has_next = S.next(ui + 1, nxt);
        const char* nA = has_next ? (const char*)g.A + (size_t)nxt.pm * tstep : cA; const char* nB = has_next ? (const char*)g.Bt + (size_t)nxt.pn * tstep : cB;
        for (int t = 0; t < nt; t += 2) {
            const bool last = (t == nt - 2);
            const char* a1 = cA + (size_t)(t + 1) * kstep;
            const char* a2 = last ? nA : cA + (size_t)(t + 2) * kstep; const char* b2 = last ? nB : cB + (size_t)(t + 2) * kstep;
            const char* a3 = a2 + kstep; const char* b3 = b2 + kstep;
            if (last && has_next) S.a_ready(nxt);
            if constexpr (SP2) {
            PG8_LDB(B0, 0, 0); PG8_LDB(B1, 0, 1); PG8_SCHED; PG8_LDA(At, 0, 0); PG8_STAGE(PG8_SA(1, 1), a1 + hstep, voffA);
            PG8_WAIT_V(8); PG8_WAIT_L(0); PG8_BAR; PG8_MMA(0, 0, At, B0); PG8_MMA(0, 1, At, B1); PG8_BAR; PG8_SCHED;
            PG8_LDA(At, 0, 1); PG8_STAGE(PG8_SB(0, 0), b2, voffB); PG8_STAGE(PG8_SB(0, 1), b2 + hstep, voffB); PG8_STAGE(PG8_SA(0, 0), a2, voffA);
            PG8_WAIT_V(8); PG8_WAIT_L(0); PG8_BAR; PG8_MMA(1, 0, At, B0); PG8_MMA(1, 1, At, B1); PG8_BAR; PG8_SCHED;
            PG8_LDB(B0, 1, 0); PG8_LDB(B1, 1, 1); PG8_SCHED; PG8_LDA(At, 1, 0); PG8_STAGE(PG8_SA(0, 1), a2 + hstep, voffA);
            PG8_WAIT_V(8); PG8_WAIT_L(0); PG8_BAR; PG8_MMA(0, 0, At, B0); PG8_MMA(0, 1, At, B1); PG8_BAR; PG8_SCHED;
            PG8_LDA(At, 1, 1); PG8_STAGE(PG8_SB(1, 0), b3, voffB); PG8_STAGE(PG8_SB(1, 1), b3 + hstep, voffB); PG8_STAGE(PG8_SA(1, 0), a3, voffA);
            PG8_WAIT_V(8); PG8_WAIT_L(0); PG8_BAR; PG8_MMA(1, 0, At, B0); PG8_MMA(1, 1, At, B1); PG8_BAR; PG8_SCHED;
            } else {
            PG8_LDB(B0, 0, 0); PG8_SCHED; PG8_LDA(At, 0, 0); PG8_STAGE(PG8_SA(1, 1), a1 + hstep, voffA);
            PG8_WAIT_L(8); PG8_BAR; PG8_WAIT_L(0); PG8_MMA(0, 0, At, B0); PG8_BAR; PG8_SCHED;
            PG8_LDB(B1, 0, 1); PG8_STAGE(PG8_SB(0, 0), b2, voffB);
            PG8_BAR; PG8_WAIT_L(0); PG8_MMA(0, 1, At, B1); PG8_BAR;
            PG8_LDA(At, 0, 1); PG8_STAGE(PG8_SA(0, 0), a2, voffA);
            PG8_BAR; PG8_WAIT_L(0); PG8_MMA(1, 0, At, B0); PG8_BAR; PG8_SCHED;
            PG8_STAGE(PG8_SB(0, 1), b2 + hstep, voffB);
            PG8_WAIT_V(6); PG8_BAR; PG8_MMA(1, 1, At, B1); PG8_BAR;
            PG8_LDB(B0, 1, 0); PG8_SCHED; PG8_LDA(At, 1, 0); PG8_STAGE(PG8_SA(0, 1), a2 + hstep, voffA);
            PG8_WAIT_L(8); PG8_BAR; PG8_WAIT_L(0); PG8_MMA(0, 0, At, B0); PG8_BAR; PG8_SCHED;
            PG8_LDB(B1, 1, 1); PG8_STAGE(PG8_SB(1, 0), b3, voffB);
            PG8_BAR; PG8_WAIT_L(0); PG8_MMA(0, 1, At, B1); PG8_BAR;
            PG8_LDA(At, 1, 1); PG8_STAGE(PG8_SA(1, 0), a3, voffA);
            PG8_BAR; PG8_WAIT_L(0); PG8_MMA(1, 0, At, B0); PG8_BAR; PG8_SCHED;
            PG8_STAGE(PG8_SB(1, 1), b3 + hstep, voffB);
            PG8_WAIT_V(6); PG8_BAR; PG8_MMA(1, 1, At, B1); PG8_BAR;
            }
        }
        if constexpr (ALIGN_EPI) { if (wr == 0) PG8_BAR; }
        if constexpr (!Epi::AFTER_DRAIN) { E(acc, cur, wr, wc, fr, fq); S.done(cur); }
        if (!has_next) break;
#pragma unroll
        for (int a = 0; a < 2; ++a)
#pragma unroll
            for (int b = 0; b < 2; ++b)
#pragma unroll
                for (int m = 0; m < 4; ++m)
#pragma unroll
                    for (int n = 0; n < 2; ++n) acc[a][b][m][n] = (f32x4){0.f, 0.f, 0.f, 0.f};
        cur = nxt; cA = nA; cB = nB; ++ui;
        if constexpr (ALIGN_EPI) { if (wr == 1) PG8_BAR; }
    }
    PG8_WAIT_V(0);
    if constexpr (!ALIGN_EPI) { if (wr == 0) PG8_BAR; }
    PG8_BAR;
    if constexpr (Epi::AFTER_DRAIN) { E.fused(acc, cur, wr, wc, fr, fq, lds, wid, lane); S.done(cur); }
#undef PG8_SA
#undef PG8_SB
#undef PG8_STAGE
#undef PG8_LDA
#undef PG8_LDB
#undef PG8_MMA
#undef PG8_WAIT_V
#undef PG8_WAIT_L
#undef PG8_BAR
#undef PG8_SCHED
}
}

namespace cg = cooperative_groups;
#define LAS __attribute__((address_space(3)))
typedef unsigned short bf16;
typedef short bf16x8 __attribute__((ext_vector_type(8)));
typedef float f32x4 __attribute__((ext_vector_type(4)));
typedef float f32x16 __attribute__((ext_vector_type(16)));
typedef unsigned u32x4 __attribute__((ext_vector_type(4)));

constexpr int NB = 8, SEQ = 4096, DM = 1024, MT = NB * SEQ;
constexpr int LDY_E = 2560, LDY_O = 3072;
constexpr float QSCALE = 0.125f * 1.4426950408889634f;
constexpr size_t MiB = 1u << 20;
constexpr size_t WS_SS = 5 * MiB + 512 * 1024;
constexpr size_t WS_SUM = 3 * MiB;
constexpr size_t WS_LRUW = 5 * MiB;
constexpr size_t WS_ROPE = 8 * MiB;
constexpr size_t WS_WINE = 16 * MiB;
constexpr size_t WS_WINO = 28 * MiB;
constexpr size_t WS_WOUT = 44 * MiB;
constexpr size_t WS_WG = 52 * MiB;
constexpr size_t WS_WP = 60 * MiB;
constexpr size_t WS_PB = 64 * MiB;
constexpr size_t WS_HB0 = 80 * MiB;
constexpr size_t WS_OMIX = 144 * MiB;
constexpr size_t WS_Y = 208 * MiB;
constexpr size_t WS_PP = WS_Y, WS_HB1 = WS_Y + 64 * MiB;
constexpr size_t WS_VT = 400 * MiB;
constexpr size_t WS_END = 464 * MiB;
constexpr int LDS_BYTES = 147456;
constexpr int NTHREADS = 512;

struct Params {
    const float* x; const float* p; const int* pos; const float* norm_mix; const float* norm_ple; const float* w_ple_gate; const float* w_ple_proj;
    const float* w_in_e; const float* conv_w; const float* conv_b; const float* lru_wa; const float* lru_ba; const float* lru_wx; const float* lru_bx; const float* lru_lambda; const float* w_out_e;
    const float* w_in_o; const float* lq1; const float* lk1; const float* lq2; const float* lk2; const float* subln_g; const float* w_out_o; const float* final_norm;
    float* out; unsigned char* ws;
    float lam_init[2]; float pad[2];
};

typedef const __attribute__((address_space(4))) Params* KPtr;
#define KP_GET() ({ KPtr kp_ = (KPtr)__builtin_amdgcn_kernarg_segment_ptr(); asm volatile("" : "+s"(kp_)); kp_; })
template <class T> __device__ __forceinline__ T* G_(T* p) { __attribute__((address_space(1))) T* g = (__attribute__((address_space(1))) T*)p; asm("" : "+s"(g)); return (T*)g; }
__device__ const float INV_FREQ[32] = {1.000000000e+00f, 7.498942018e-01f, 5.623413324e-01f, 4.216965139e-01f, 3.162277639e-01f, 2.371373773e-01f, 1.778279394e-01f, 1.333521456e-01f, 1.000000015e-01f, 7.498942316e-02f, 5.623413250e-02f, 4.216964915e-02f, 3.162277490e-02f, 2.371373773e-02f, 1.778279431e-02f, 1.333521400e-02f, 9.999999776e-03f, 7.498942316e-03f, 5.623413250e-03f, 4.216964822e-03f, 3.162277630e-03f, 2.371373819e-03f, 1.778279431e-03f, 1.333521446e-03f, 1.000000047e-03f, 7.498941850e-04f, 5.623413017e-04f, 4.216965172e-04f, 3.162277571e-04f, 2.371373703e-04f, 1.778279402e-04f, 1.333521504e-04f};
__device__ __forceinline__ float bf2f(bf16 u) { return __uint_as_float((unsigned)u << 16); }
typedef float f32x2_t __attribute__((ext_vector_type(2))); typedef __bf16 bf16x2_t __attribute__((ext_vector_type(2)));
__device__ __forceinline__ unsigned cvtpk(float lo, float hi) { f32x2_t v = {lo, hi}; bf16x2_t b = __builtin_convertvector(v, bf16x2_t); return __builtin_bit_cast(unsigned, b); }
__device__ __forceinline__ bf16 f2bf(float f) { return (bf16)(cvtpk(f, 0.f) & 0xffffu); }
__device__ __forceinline__ float wave_sum(float v) {
#pragma unroll
    for (int o = 1; o < 64; o <<= 1) v += __shfl_xor(v, o);
    return v;
}
__device__ __forceinline__ int crow(int r, int hi) { return (r & 3) + 8 * (r >> 2) + 4 * hi; }
#define GLDS16(gptr, ldsptr) __builtin_amdgcn_global_load_lds((const unsigned*)(gptr), (LAS unsigned*)(ldsptr), 16, 0, 0)
#define MFMA32(a, b, c) __builtin_amdgcn_mfma_f32_32x32x16_bf16((a), (b), (c), 0, 0, 0)

__device__ __forceinline__ void colmap(int kind, int np, int& src, float& sc) {
    src = np; sc = 1.f;
    if (kind == 2) {
        if (np >= 1024 && np < 1536) sc = QSCALE;
        else if (np >= 2048 && np < 2560) src = np + 512;
        else if (np >= 2560) src = np - 512;
    } else if (kind == 3) {
        if (np < 2048) { const int head = np >> 6, s = np & 63, w = s >> 5, fq = (s >> 3) & 3, n = (s >> 2) & 1, i = s & 3; src = head * 64 + 16 * w + 4 * fq + i + 32 * n; if (np < 1024) sc = QSCALE; }
        else if (np < 3072) src = np + 1024;
        else src = np - 1024;
    }
}
__device__ __forceinline__ void wt_item(const float* W, int K, int N, bf16* WT, int nrows, int kind, const float* gk, LAS float* scr, int item, int lane) {
    const int nblk = nrows / 32, kb = item / nblk, nb = item % nblk, k0 = 64 * kb, n0 = 32 * nb;
    int src; float sc; colmap(kind, n0 + (lane & 31), src, sc);
#pragma unroll 8
    for (int i = 0; i < 32; ++i) { const int kk = 2 * i + (lane >> 5); const float g = gk ? gk[k0 + kk] : 1.f; scr[kk * 33 + (lane & 31)] = W[(size_t)(k0 + kk) * N + src] * (g * sc); }
    const int c = lane & 7;
#pragma unroll
    for (int j = 0; j < 4; ++j) { const int n = (lane >> 3) + 8 * j; const LAS float* s = scr + (8 * c) * 33 + n;
        u32x4 o; o.x = cvtpk(s[0 * 33], s[1 * 33]); o.y = cvtpk(s[2 * 33], s[3 * 33]); o.z = cvtpk(s[4 * 33], s[5 * 33]); o.w = cvtpk(s[6 * 33], s[7 * 33]);
        *(u32x4*)(WT + (size_t)(n0 + n) * K + k0 + 8 * c) = o; }
}
__device__ __forceinline__ void sincos_acc(float af, float& s, float& c) {
    const double a = (double)af; const double q = rint(a * 0.63661977236758134308); const double r = fma(-q, 1.57079632679489661923, a) - q * 6.123233995736766e-17;
    const double r2 = r * r;
    const double sp = r * (1.0 + r2 * (-1.0 / 6 + r2 * (1.0 / 120 + r2 * (-1.0 / 5040 + r2 * (1.0 / 362880 + r2 * (-1.0 / 39916800 + r2 * (1.0 / 6227020800.0)))))));
    const double cp = 1.0 + r2 * (-0.5 + r2 * (1.0 / 24 + r2 * (-1.0 / 720 + r2 * (1.0 / 40320 + r2 * (-1.0 / 3628800 + r2 * (1.0 / 479001600.0 + r2 * (-1.0 / 87178291200.0)))))));
    const int qi = ((int)q) & 3;
    const double ss = (qi == 0) ? sp : (qi == 1) ? cp : (qi == 2) ? -sp : -cp;
    const double cc = (qi == 0) ? cp : (qi == 1) ? -sp : (qi == 2) ? -cp : sp;
    s = (float)ss; c = (float)cc;
}

__device__ __forceinline__ void prologue(KPtr P, LAS unsigned char* lds, int vcu, int G, int wave, int lane) {
    unsigned char* ws = G_(P->ws);
    LAS float* scr = (LAS float*)(lds + wave * 16384);
    const int gw = vcu * 8 + wave, NGW = G * 8;
    constexpr int I_E = 16 * 96, I_O = 16 * 128, I_S = 16 * 32, I_P = 4 * 32;
    constexpr int I_L = 2 * 16 * 2;
    constexpr int NITEMS = 2 * I_E + 2 * I_O + 4 * I_S + 4 * I_S + 4 * I_P + I_L;
    for (int it = gw; it < NITEMS; it += NGW) {
        int r = it;
        if (r < 2 * I_E) { const int j = r / I_E; wt_item(G_(P->w_in_e) + (size_t)j * 1024 * 3072, 1024, 3072, (bf16*)(ws + WS_WINE) + (size_t)j * 3072 * 1024, 3072, 2, G_(P->norm_mix) + (2 * j) * 1024, scr, r % I_E, lane); continue; } r -= 2 * I_E;
        if (r < 2 * I_O) { const int j = r / I_O; wt_item(G_(P->w_in_o) + (size_t)j * 1024 * 4096, 1024, 4096, (bf16*)(ws + WS_WINO) + (size_t)j * 4096 * 1024, 4096, 3, G_(P->norm_mix) + (2 * j + 1) * 1024, scr, r % I_O, lane); continue; } r -= 2 * I_O;
        if (r < 4 * I_S) { const int i = r / I_S; const float* src = (i & 1) ? G_(P->w_out_o) + (size_t)(i >> 1) * 1024 * 1024 : G_(P->w_out_e) + (size_t)(i >> 1) * 1024 * 1024;
            wt_item(src, 1024, 1024, (bf16*)(ws + WS_WOUT) + (size_t)i * 1024 * 1024, 1024, 0, nullptr, scr, r % I_S, lane); continue; } r -= 4 * I_S;
        if (r < 4 * I_S) { const int i = r / I_S; wt_item(G_(P->w_ple_gate) + (size_t)i * 1024 * 1024, 1024, 1024, (bf16*)(ws + WS_WG) + (size_t)i * 1024 * 1024, 1024, 1, G_(P->norm_ple) + i * 1024, scr, r % I_S, lane); continue; } r -= 4 * I_S;
        if (r < 4 * I_P) { const int i = r / I_P; wt_item(G_(P->w_ple_proj) + (size_t)i * 256 * 1024, 256, 1024, (bf16*)(ws + WS_WP) + (size_t)i * 1024 * 256, 1024, 0, nullptr, scr, r % I_P, lane); continue; } r -= 4 * I_P;
        { const int gate = r >> 5, blk = (r >> 1) & 15; wt_item((gate ? G_(P->lru_wx) : G_(P->lru_wa)) + (size_t)blk * 4096, 64, 64, (bf16*)(ws + WS_LRUW) + (size_t)(gate * 16 + blk) * 4096, 64, 0, nullptr, scr, r & 1, lane); }
    }
    pg8::ss_t* SS = (pg8::ss_t*)(ws + WS_SS);
    for (int m0 = 4 * gw; m0 < MT; m0 += 4 * NGW) {
        f32x4 v[4][4];
#pragma unroll
        for (int q = 0; q < 4; ++q) { const f32x4* xr = (const f32x4*)(G_(P->x) + (size_t)(m0 + q) * DM) + lane;
#pragma unroll
            for (int j = 0; j < 4; ++j) v[q][j] = xr[64 * j]; }
#pragma unroll
        for (int q = 0; q < 4; ++q) { float s = 0.f; unsigned long long* o8 = (unsigned long long*)((bf16*)(ws + WS_HB0) + (size_t)(m0 + q) * DM) + lane;
#pragma unroll
            for (int j = 0; j < 4; ++j) { const f32x4 w = v[q][j]; s += (w.x * w.x + w.y * w.y) + (w.z * w.z + w.w * w.w);
                o8[64 * j] = (unsigned long long)cvtpk(w.x, w.y) | ((unsigned long long)cvtpk(w.z, w.w) << 32); }
            s = wave_sum(s); if (lane == 0) SS[m0 + q] = (pg8::ss_t)(s * 4294967296.0f); }
    }
    { const int gt = gw * 64 + lane, NT = NGW * 64; for (int i = gt; i < 8 * MT; i += NT) SS[MT + i] = 0ull; }
    { const int gt = gw * 64 + lane, NT = NGW * 64; float* R = (float*)(ws + WS_ROPE);
      for (int i = gt; i < MT * 32; i += NT) { const int m = i >> 5, f = i & 31; const float ang = (float)G_(P->pos)[m] * INV_FREQ[f]; float s, c; sincos_acc(ang, s, c); R[2 * i] = c; R[2 * i + 1] = s; } }
}
__device__ __forceinline__ void convert_p(KPtr P, unsigned char* wsb, int layer, int vcu, int G, int tid) {
    const f32x4* src = (const f32x4*)(G_(P->p) + (size_t)layer * MT * 256); u32x4* dst = (u32x4*)(wsb + WS_PB);
    const int gt = vcu * NTHREADS + tid, NT = G * NTHREADS;
    for (int i = gt; i < MT * 256 / 8; i += NT) { const f32x4 a = src[2 * i], b = src[2 * i + 1]; u32x4 o; o.x = cvtpk(a.x, a.y); o.y = cvtpk(a.z, a.w); o.z = cvtpk(b.x, b.y); o.w = cvtpk(b.z, b.w); dst[i] = o; }
}
__device__ __forceinline__ void final_norm(KPtr P, int vcu, int G, int wave, int lane) {
    const pg8::ss_t* SS = (const pg8::ss_t*)(G_(P->ws) + WS_SS) + 8 * (size_t)MT;
    const int gw = vcu * 8 + wave, NGW = G * 8;
    f32x4 g[4];
#pragma unroll
    for (int j = 0; j < 4; ++j) g[j] = ((const f32x4*)G_(P->final_norm))[lane + 64 * j];
    for (int m0 = 4 * gw; m0 < MT; m0 += 4 * NGW) {
        f32x4 v[4][4]; float rs[4];
#pragma unroll
        for (int q = 0; q < 4; ++q) { const f32x4* xr = (const f32x4*)(G_(P->out) + (size_t)(m0 + q) * DM) + lane; rs[q] = pg8::ss_rstd(SS[m0 + q]);
#pragma unroll
            for (int j = 0; j < 4; ++j) v[q][j] = xr[64 * j]; }
#pragma unroll
        for (int q = 0; q < 4; ++q) { f32x4* xr = (f32x4*)(G_(P->out) + (size_t)(m0 + q) * DM) + lane;
#pragma unroll
            for (int j = 0; j < 4; ++j) xr[64 * j] = v[q][j] * rs[q] * g[j]; }
    }
}

__device__ __forceinline__ int tperm(int i) { return ((i & 4) << 2) | ((i & 16) >> 1) | ((i & 8) >> 1) | (i & 3); }
__device__ __forceinline__ void lru_unit(KPtr P, unsigned char* wsb, int j, int u, int pass, LAS unsigned char* xct, int lane) {
    asm volatile("" : "+v"(lane));
    const int ch = u & 63, n = (u >> 6) & 7, b = u >> 9, c32 = lane & 31, hi = lane >> 5, cg0 = 64 * n + c32;
    const bf16* Y = (const bf16*)(wsb + WS_Y); bf16* OM = (bf16*)(wsb + WS_OMIX);
    float* SA = (float*)(wsb + WS_SUM); float* SH = SA + 8 * 64 * 512;
    const float* cw = G_(P->conv_w) + j * 4 * 512;
    float w0[2], w1[2], w2[2], w3[2], cbi[2], ba[2], bx[2], c8[2];
    bf16x8 Ba[2][4], Bx[2][4];
#pragma unroll
    for (int cb = 0; cb < 2; ++cb) {
        const int cgi = cg0 + 32 * cb;
        w0[cb] = cw[cgi]; w1[cb] = cw[512 + cgi]; w2[cb] = cw[1024 + cgi]; w3[cb] = cw[1536 + cgi]; cbi[cb] = G_(P->conv_b)[j * 512 + cgi];
        ba[cb] = G_(P->lru_ba)[j * 512 + cgi]; bx[cb] = G_(P->lru_bx)[j * 512 + cgi];
        const float lam = G_(P->lru_lambda)[j * 512 + cgi];
        c8[cb] = 8.0f * (fminf(lam, 0.f) - log1pf(__expf(-fabsf(lam))));
        const bf16* wa = (const bf16*)(wsb + WS_LRUW) + ((size_t)((j * 8 + n) * 64 + c32 + 32 * cb)) * 64 + 8 * hi; const bf16* wx = wa + 16 * 4096;
#pragma unroll
        for (int kk = 0; kk < 4; ++kk) { Ba[cb][kk] = *(const bf16x8*)(wa + 16 * kk); Bx[cb][kk] = *(const bf16x8*)(wx + 16 * kk); }
    }
    const size_t tok0 = (size_t)b * SEQ + ch * 64;
    float hc[2] = {0.f, 0.f}; float Ap[2] = {1.f, 1.f};
    if (pass == 1) {
#pragma unroll
        for (int cb = 0; cb < 2; ++cb) { const float* sa = SA + (size_t)b * 64 * 512 + cg0 + 32 * cb; const float* sh = SH + (size_t)b * 64 * 512 + cg0 + 32 * cb; float h = 0.f;
#pragma unroll 16
            for (int c = 0; c < ch; ++c) h = sa[c * 512] * h + sh[c * 512];
            hc[cb] = h; }
    }
    const int arow = tperm(c32), aswz = (arow >> 1) & 7;
    for (int sub = 0; sub < 2; ++sub) {
        const size_t t0 = tok0 + sub * 32 + 16 * hi;
        const bool first = (ch == 0) && (sub == 0) && (hi == 0);
        f32x16 xc[2];
#pragma unroll
        for (int cb = 0; cb < 2; ++cb) {
            const bf16* yp = Y + t0 * LDY_E + cg0 + 32 * cb;
            float x0 = 0.f, x1 = 0.f, x2 = 0.f;
            if (!first) { x0 = bf2f(*(yp - 3 * (ptrdiff_t)LDY_E)); x1 = bf2f(*(yp - 2 * (ptrdiff_t)LDY_E)); x2 = bf2f(*(yp - (ptrdiff_t)LDY_E)); }
#pragma unroll
            for (int r = 0; r < 16; ++r) { const float xv = bf2f(yp[(size_t)r * LDY_E]); xc[cb][r] = cbi[cb] + w0[cb] * x0 + w1[cb] * x1 + w2[cb] * x2 + w3[cb] * xv; x0 = x1; x1 = x2; x2 = xv; }
#pragma unroll
            for (int r = 0; r < 16; ++r) { const int tt = 16 * hi + r, col = c32 + 32 * cb;
                *(LAS bf16*)(xct + tt * 128 + ((((col >> 3) ^ ((tt >> 1) & 7))) << 4) + (col & 7) * 2) = f2bf(xc[cb][r]); }
        }
        f32x16 pa[2], px[2];
        pa[0] = (f32x16){}; pa[1] = (f32x16){}; px[0] = (f32x16){}; px[1] = (f32x16){};
#pragma unroll
        for (int kk = 0; kk < 4; ++kk) {
            const bf16x8 af = *(const LAS bf16x8*)(xct + arow * 128 + (((2 * kk + hi) ^ aswz) << 4));
            pa[0] = MFMA32(af, Ba[0][kk], pa[0]); pa[1] = MFMA32(af, Ba[1][kk], pa[1]); px[0] = MFMA32(af, Bx[0][kk], px[0]); px[1] = MFMA32(af, Bx[1][kk], px[1]);
        }
        float Al[2], Hl[2];
#pragma unroll
        for (int cb = 0; cb < 2; ++cb) {
            float al = 1.f, hl = 0.f;
#pragma unroll
            for (int r = 0; r < 16; ++r) {
                const float rg = __builtin_amdgcn_rcpf(1.0f + __expf(-(pa[cb][r] + ba[cb]))), ig = __builtin_amdgcn_rcpf(1.0f + __expf(-(px[cb][r] + bx[cb])));
                const float la = c8[cb] * rg, a = __expf(la), x2 = 2.0f * la;
                const float ems = -x2 * (1.0f + x2 * (0.5f + x2 * ((1.0f / 6) + x2 * ((1.0f / 24) + x2 * ((1.0f / 120) + x2 * (1.0f / 720))))));
                const float em = (x2 > -0.5f) ? ems : 1.0f - a * a;
                const float uu = sqrtf(em) * (ig * xc[cb][r]);
                pa[cb][r] = a; px[cb][r] = uu; hl = a * hl + uu; al *= a;
            }
            Al[cb] = al; Hl[cb] = hl;
        }
#pragma unroll
        for (int cb = 0; cb < 2; ++cb) {
            const float oA = __shfl_xor(Al[cb], 32), oH = __shfl_xor(Hl[cb], 32);
            const float hmid = hi ? (oA * hc[cb] + oH) : (Al[cb] * hc[cb] + Hl[cb]);
            const float hin = hi ? hmid : hc[cb];
            const float hend = hi ? (Al[cb] * hmid + Hl[cb]) : (oA * hmid + oH);
            Ap[cb] *= Al[cb] * oA;
            if (pass == 1) {
                const bf16* gp = Y + t0 * LDY_E + 512 + cg0 + 32 * cb; bf16* op = OM + t0 * 1024 + cg0 + 32 * cb;
                float h = hin;
#pragma unroll
                for (int rh = 0; rh < 16; rh += 8) {
                    bf16 graw[8];
#pragma unroll
                    for (int r = 0; r < 8; ++r) graw[r] = gp[(size_t)(rh + r) * LDY_E];
#pragma unroll
                    for (int r = 0; r < 8; ++r) { h = pa[cb][rh + r] * h + px[cb][rh + r]; const float g = bf2f(graw[r]); op[(size_t)(rh + r) * 1024] = f2bf(h * g * __builtin_amdgcn_rcpf(1.0f + __expf(-g))); }
                }
            }
            hc[cb] = hend;
        }
    }
    if (pass == 0 && hi == 0) {
#pragma unroll
        for (int cb = 0; cb < 2; ++cb) { SA[((size_t)b * 64 + ch) * 512 + cg0 + 32 * cb] = Ap[cb]; SH[((size_t)b * 64 + ch) * 512 + cg0 + 32 * cb] = hc[cb]; }
    }
}

__device__ __forceinline__ int tile_off(int row, int chunk) { return row * 128 + ((chunk ^ ((row >> 1) & 7)) << 4); }
__device__ __forceinline__ int kperm(int i) { return (i & 0x13) | ((i & 4) << 1) | ((i & 8) >> 1); }

__device__ __forceinline__ void sb_unit(KPtr P, unsigned char* wsb, int b, int h, int qb, LAS unsigned char* lds, int tid, int wave, int lane) {
    const bf16* Y = (const bf16*)(wsb + WS_Y); const bf16* VT = (const bf16*)(wsb + WS_VT); bf16* OM = (bf16*)(wsb + WS_OMIX);
    asm volatile("" : "+v"(lane));
    const int r32 = lane & 31, hi = lane >> 5;
    const size_t rowbase = (size_t)b * SEQ; const int q0 = qb * 256, qw0 = q0 + wave * 32;
    const int srow = wave * 8 + (lane >> 3), sch = (lane & 7) ^ ((srow >> 1) & 7);
    const bf16* kg = Y + (rowbase + srow) * LDY_E + 1536 + h * 64 + sch * 8;
    const bf16* vg = VT + ((size_t)(b * 8 + h) * 64) * 4096 + srow * 64 + sch * 8;
    bf16x8 qr[4];
#pragma unroll
    for (int d0 = 0; d0 < 4; ++d0) qr[d0] = *(const bf16x8*)(Y + (rowbase + qw0 + r32) * LDY_E + 1024 + h * 64 + d0 * 16 + hi * 8);
    const int krow = kperm(r32), kswz = (krow >> 1) & 7, vswz = (r32 >> 1) & 7;
    f32x16 o0 = {}, o1 = {};
    float R = 1.0f;
    const int jmax = (q0 + 255) >> 6;
    GLDS16(kg + (size_t)(jmax * 64) * LDY_E, lds + wave * 1024); GLDS16(vg + (size_t)jmax * 4096, lds + 8192 + wave * 1024);
    LAS unsigned* alive = (LAS unsigned*)(lds + 32768);
    if (tid < 3) alive[tid] = 0u;
    __syncthreads();
    int it = 0, aw = 0; bool walive = true;
    for (int j = jmax; j >= 0; --j, ++it) {
        LAS unsigned char* Kb = lds + (it & 1) * 16384; LAS unsigned char* Vb = Kb + 8192;
        if (j > 0) { LAS unsigned char* Kn = lds + ((it + 1) & 1) * 16384 + wave * 1024; GLDS16(kg + (size_t)((j - 1) * 64) * LDY_E, Kn); GLDS16(vg + (size_t)(j - 1) * 4096, Kn + 8192); }
        const int k0 = j * 64;
        if (k0 < qw0 + 31 && walive) {
            f32x16 p0 = {}, p1 = {};
#pragma unroll
            for (int d0 = 0; d0 < 4; ++d0) {
                const int co = ((2 * d0 + hi) ^ kswz) << 4;
                const bf16x8 a0 = *(const LAS bf16x8*)(Kb + krow * 128 + co), a1 = *(const LAS bf16x8*)(Kb + (krow + 32) * 128 + co);
                p0 = MFMA32(a0, qr[d0], p0); p1 = MFMA32(a1, qr[d0], p1);
            }
            const int tq = qw0 + r32; const bool need_mask = (k0 + 63 >= qw0);
            if (need_mask) {
                asm volatile("" ::: );
#pragma unroll
                for (int r = 0; r < 16; ++r) { const int s = k0 + 16 * (r >> 3) + 8 * hi + (r & 7); if (s >= tq) p0[r] = -INFINITY; if (s + 32 >= tq) p1[r] = -INFINITY; }
            }
            f32x16 b0, b1;
#pragma unroll
            for (int r = 0; r < 16; ++r) {
                { const float om = __builtin_amdgcn_rcpf(1.0f + __builtin_amdgcn_exp2f(p0[r])); p0[r] = om; b0[r] = 1.0f - om; }
                { const float om = __builtin_amdgcn_rcpf(1.0f + __builtin_amdgcn_exp2f(p1[r])); p1[r] = om; b1[r] = 1.0f - om; }
            }
            f32x4 own;
            own[0] = ((p0[0] * p0[1]) * (p0[2] * p0[3])) * ((p0[4] * p0[5]) * (p0[6] * p0[7]));
            own[1] = ((p0[8] * p0[9]) * (p0[10] * p0[11])) * ((p0[12] * p0[13]) * (p0[14] * p0[15]));
            own[2] = ((p1[0] * p1[1]) * (p1[2] * p1[3])) * ((p1[4] * p1[5]) * (p1[6] * p1[7]));
            own[3] = ((p1[8] * p1[9]) * (p1[10] * p1[11])) * ((p1[12] * p1[13]) * (p1[14] * p1[15]));
            const float t0 = __shfl_xor(own[0], 32), t1 = __shfl_xor(own[1], 32), t2 = __shfl_xor(own[2], 32), t3 = __shfl_xor(own[3], 32);
            const float a0 = hi ? t0 : own[0], a1 = hi ? own[0] : t0, a2 = hi ? t1 : own[1], a3 = hi ? own[1] : t1, a4 = hi ? t2 : own[2], a5 = hi ? own[2] : t2, a6 = hi ? t3 : own[3], a7 = hi ? own[3] : t3;
            const float s7 = 1.0f, s6 = a7, s5 = s6 * a6, s4 = s5 * a5, s3 = s4 * a4, s2 = s3 * a3, s1 = s2 * a2, s0 = s1 * a1;
            const float total = s0 * a0;
            { float run = (hi ? s1 : s0) * R;
#pragma unroll
              for (int jj = 7; jj >= 0; --jj) { const float w = b0[jj] * run; run *= p0[jj]; b0[jj] = w; } }
            { float run = (hi ? s3 : s2) * R;
#pragma unroll
              for (int jj = 7; jj >= 0; --jj) { const float w = b0[8 + jj] * run; run *= p0[8 + jj]; b0[8 + jj] = w; } }
            { float run = (hi ? s5 : s4) * R;
#pragma unroll
              for (int jj = 7; jj >= 0; --jj) { const float w = b1[jj] * run; run *= p1[jj]; b1[jj] = w; } }
            { float run = (hi ? s7 : s6) * R;
#pragma unroll
              for (int jj = 7; jj >= 0; --jj) { const float w = b1[8 + jj] * run; run *= p1[8 + jj]; b1[8 + jj] = w; } }
            R *= total;
            const u32x4 pw0 = {cvtpk(b0[0], b0[1]), cvtpk(b0[2], b0[3]), cvtpk(b0[4], b0[5]), cvtpk(b0[6], b0[7])}, pw1 = {cvtpk(b0[8], b0[9]), cvtpk(b0[10], b0[11]), cvtpk(b0[12], b0[13]), cvtpk(b0[14], b0[15])};
            const u32x4 pw2 = {cvtpk(b1[0], b1[1]), cvtpk(b1[2], b1[3]), cvtpk(b1[4], b1[5]), cvtpk(b1[6], b1[7])}, pw3 = {cvtpk(b1[8], b1[9]), cvtpk(b1[10], b1[11]), cvtpk(b1[12], b1[13]), cvtpk(b1[14], b1[15])};
#define SB_PV(kk, pw) { const int co = ((2 * (kk) + hi) ^ vswz) << 4; const bf16x8 v0 = *(const LAS bf16x8*)(Vb + r32 * 128 + co), v1 = *(const LAS bf16x8*)(Vb + (r32 + 32) * 128 + co); \
                o0 = MFMA32(__builtin_bit_cast(bf16x8, pw), v0, o0); o1 = MFMA32(__builtin_bit_cast(bf16x8, pw), v1, o1); }
            SB_PV(0, pw0) SB_PV(1, pw1) SB_PV(2, pw2) SB_PV(3, pw3)
#undef SB_PV
        }
        const int an = (aw == 2) ? 0 : aw + 1;
        walive = __any(R != 0.0f);
        if (walive && lane == 0) alive[aw] = 1u;
        if (tid == 0) alive[an] = 0u;
        __syncthreads();
        if (alive[aw] == 0u) break;
        aw = an;
    }
    int r32e = r32; asm volatile("" : "+v"(r32e));
    bf16 gr0[16], gr1[16];
#pragma unroll
    for (int r = 0; r < 16; ++r) { const size_t tok = rowbase + qw0 + crow(r, hi); gr0[r] = Y[tok * LDY_E + 2048 + h * 64 + r32e]; gr1[r] = Y[tok * LDY_E + 2048 + h * 64 + 32 + r32e]; }
#pragma unroll
    for (int r = 0; r < 16; ++r) {
        const size_t tok = rowbase + qw0 + crow(r, hi);
        const float g0 = bf2f(gr0[r]), g1 = bf2f(gr1[r]);
        OM[tok * 1024 + 512 + h * 64 + r32e] = f2bf(o0[r] * g0 * __builtin_amdgcn_rcpf(1.0f + __expf(-g0)));
        OM[tok * 1024 + 512 + h * 64 + 32 + r32e] = f2bf(o1[r] * g1 * __builtin_amdgcn_rcpf(1.0f + __expf(-g1)));
    }
    __syncthreads();
}

__device__ __forceinline__ void diff_map_half(LAS unsigned char* Qb  , LAS unsigned char* Kb, LAS unsigned char* Vb, LAS float* wsf, f32x16 (&O)[4], float& mrow, float& lrow,
                                              int kbase  , int p, int tq, bool need_mask, int krow, int kswz, int vswz, int r32, int hi) {
    f32x16 s = {};
#pragma unroll
    for (int d0 = 0; d0 < 4; ++d0) {
        const int co = ((2 * d0 + hi) ^ kswz) << 4;
        const bf16x8 a0 = *(const LAS bf16x8*)(Kb + (krow + 32 * p) * 128 + co);
        const bf16x8 qf = *(const LAS bf16x8*)(Qb + r32 * 128 + (((2 * d0 + hi) ^ vswz) << 4));
        s = MFMA32(a0, qf, s);
    }
    if (need_mask) {
        asm volatile("" ::: );
#pragma unroll
        for (int r = 0; r < 16; ++r) { const int key = kbase + 16 * (r >> 3) + 8 * hi + (r & 7); if (key > tq) s[r] = -INFINITY; }
    }
    float mx = fmaxf(s[0], s[1]);
#pragma unroll
    for (int r = 2; r < 16; ++r) mx = fmaxf(mx, s[r]);
    { const auto rr = __builtin_amdgcn_permlane32_swap(__float_as_uint(mx), __float_as_uint(mx), false, false); mx = fmaxf(__uint_as_float(rr[0]), __uint_as_float(rr[1])); }
    constexpr float DIFF_THR = 8.0f;
    float mnew = mrow;
    if (__any(mx > mrow + DIFF_THR)) {
        mnew = fmaxf(mrow, mx);
        const float alpha = __builtin_amdgcn_exp2f(mrow - mnew);
        lrow *= alpha;
        if (hi == 0) wsf[r32] = alpha;
#pragma unroll
        for (int r = 0; r < 16; ++r) { const float al = wsf[crow(r, hi)];
#pragma unroll
            for (int dd = 0; dd < 4; ++dd) O[dd][r] *= al; }
    }
    mrow = mnew;
    float sum = 0.f;
#pragma unroll
    for (int r = 0; r < 16; ++r) { s[r] = __builtin_amdgcn_exp2f(s[r] - mnew); sum += s[r]; }
    lrow += sum;
    const u32x4 pw0 = {cvtpk(s[0], s[1]), cvtpk(s[2], s[3]), cvtpk(s[4], s[5]), cvtpk(s[6], s[7])}, pw1 = {cvtpk(s[8], s[9]), cvtpk(s[10], s[11]), cvtpk(s[12], s[13]), cvtpk(s[14], s[15])};
#pragma unroll
    for (int dd = 0; dd < 4; ++dd) {
        const bf16x8 v0 = *(const LAS bf16x8*)(Vb + (r32 + 32 * dd) * 128 + (((4 * p + hi) ^ vswz) << 4)), v1 = *(const LAS bf16x8*)(Vb + (r32 + 32 * dd) * 128 + (((4 * p + 2 + hi) ^ vswz) << 4));
        O[dd] = MFMA32(__builtin_bit_cast(bf16x8, pw0), v0, O[dd]); O[dd] = MFMA32(__builtin_bit_cast(bf16x8, pw1), v1, O[dd]);
    }
}

__device__ __forceinline__ void diff_unit(KPtr P, unsigned char* wsb, int jl, float lam, int b, int h, int qb, LAS unsigned char* lds, int tid, int wave, int lane) {
    const bf16* Y = (const bf16*)(wsb + WS_Y); const bf16* VT = (const bf16*)(wsb + WS_VT); bf16* OM = (bf16*)(wsb + WS_OMIX);
    asm volatile("" : "+v"(lane));
    const int r32 = lane & 31, hi = lane >> 5;
    const size_t rowbase = (size_t)b * SEQ; const int q0 = qb * 256, qw0 = q0 + wave * 32;
    const int srow = wave * 8 + (lane >> 3), sch = (lane & 7) ^ ((srow >> 1) & 7);
    const bf16* k1g = Y + (rowbase + srow) * LDY_O + 1024 + (2 * h) * 64 + sch * 8;
    const bf16* k2g = k1g + 64;
    const bf16* vg = VT + ((size_t)(b * 8 + h) * 64) * 8192 + srow * 64 + sch * 8;
    constexpr int BUF = 32768;
    LAS float* wsf = (LAS float*)(lds + 2 * BUF) + wave * 64;
    LAS unsigned char* Q1b = lds + 2 * BUF + 2048 + wave * 8192; LAS unsigned char* Q2b = Q1b + 4096;
#pragma unroll
    for (int i = 0; i < 4; ++i) { const int qrow = 8 * i + (lane >> 3), qch = (lane & 7) ^ ((qrow >> 1) & 7); const bf16* qp = Y + (rowbase + qw0 + qrow) * LDY_O + (2 * h) * 64 + qch * 8;
        GLDS16(qp, Q1b + i * 1024); GLDS16(qp + 64, Q2b + i * 1024); }
    const int krow = kperm(r32), kswz = (krow >> 1) & 7, vswz = (r32 >> 1) & 7;
    f32x16 O1[4], O2[4];
#pragma unroll
    for (int dd = 0; dd < 4; ++dd) { O1[dd] = (f32x16){}; O2[dd] = (f32x16){}; }
    float m1 = -INFINITY, m2 = -INFINITY, l1 = 0.f, l2 = 0.f;
    const int jmax = (q0 + 255) >> 6;
    { LAS unsigned char* Bn = lds + wave * 1024; GLDS16(k1g, Bn); GLDS16(k2g, Bn + 8192); GLDS16(vg, Bn + 16384); GLDS16(vg + 4096, Bn + 24576); }
    __syncthreads();
    const int tq = qw0 + r32;
    for (int j = 0; j <= jmax; ++j) {
        LAS unsigned char* B0 = lds + (j & 1) * BUF;
        if (j < jmax) { const size_t ko = (size_t)(j + 1) * 64; LAS unsigned char* Bn = lds + ((j + 1) & 1) * BUF + wave * 1024; GLDS16(k1g + ko * LDY_O, Bn); GLDS16(k2g + ko * LDY_O, Bn + 8192); GLDS16(vg + (size_t)(j + 1) * 8192, Bn + 16384); GLDS16(vg + (size_t)(j + 1) * 8192 + 4096, Bn + 24576); }
        const int k0 = j * 64;
        if (k0 <= qw0 + 31) {
            const bool need_mask = (k0 + 63 > qw0);
            diff_map_half(Q1b, B0, B0 + 16384, wsf, O1, m1, l1, k0, 0, tq, need_mask, krow, kswz, vswz, r32, hi);
            diff_map_half(Q2b, B0 + 8192, B0 + 16384, wsf + 32, O2, m2, l2, k0, 0, tq, need_mask, krow, kswz, vswz, r32, hi);
            if (k0 + 32 <= qw0 + 31) {
                diff_map_half(Q1b, B0, B0 + 16384, wsf, O1, m1, l1, k0 + 32, 1, tq, need_mask, krow, kswz, vswz, r32, hi);
                diff_map_half(Q2b, B0 + 8192, B0 + 16384, wsf + 32, O2, m2, l2, k0 + 32, 1, tq, need_mask, krow, kswz, vswz, r32, hi);
            }
        }
        __syncthreads();
    }
    l1 += __shfl_xor(l1, 32); l2 += __shfl_xor(l2, 32);
    int r32e = r32; asm volatile("" : "+v"(r32e));
    if (hi == 0) { wsf[r32] = __builtin_amdgcn_rcpf(l1); wsf[32 + r32] = lam * __builtin_amdgcn_rcpf(l2); }
    const float* sg = G_(P->subln_g) + jl * 128; const float post = 1.0f - P->lam_init[jl];
    f32x4 gsc;
#pragma unroll
    for (int dd = 0; dd < 4; ++dd) gsc[dd] = sg[32 * dd + r32e] * post;
#pragma unroll
    for (int rh = 0; rh < 16; rh += 4) {
        bf16 graw[4][4];
#pragma unroll
        for (int r = 0; r < 4; ++r)
#pragma unroll
            for (int dd = 0; dd < 4; ++dd) graw[r][dd] = Y[(rowbase + qw0 + crow(rh + r, hi)) * LDY_O + 2048 + h * 128 + 32 * dd + r32e];
#pragma unroll
        for (int r8 = 0; r8 < 4; ++r8) {
            const int r = rh + r8;
            const int qr_ = crow(r, hi); const float i1 = wsf[qr_], i2 = wsf[32 + qr_];
            f32x4 v; float sq = 0.f;
#pragma unroll
            for (int dd = 0; dd < 4; ++dd) { v[dd] = O1[dd][r] * i1 - O2[dd][r] * i2; sq += v[dd] * v[dd]; }
            sq += __shfl_xor(sq, 1); sq += __shfl_xor(sq, 2); sq += __shfl_xor(sq, 4); sq += __shfl_xor(sq, 8); sq += __shfl_xor(sq, 16);
            const float rn = __builtin_amdgcn_rsqf(sq * (1.0f / 128.0f) + 1e-6f);
            const size_t tok = rowbase + qw0 + qr_;
#pragma unroll
            for (int dd = 0; dd < 4; ++dd) { const float g = bf2f(graw[r8][dd]);
                OM[tok * 1024 + h * 128 + 32 * dd + r32e] = f2bf(v[dd] * rn * gsc[dd] * g * __builtin_amdgcn_rcpf(1.0f + __expf(-g))); }
        }
    }
    __syncthreads();
}

#define XB_TMO      128
#define XB_XCNT(j)  (256  + 64 * (j))
#define XB_XSUB(j)  (1280 + 64 * (j))
#define XB_XGEN(j)  (2304 + 64 * (j))
#define XB_TOP      3328
#define XB_TOPGEN   3392
#define XCD_BAR_WORDS 3456
#define XB_SPIN_CAP (1u << 18)

__device__ __forceinline__ unsigned xb_ld(unsigned* p)              { return __hip_atomic_load(p, __ATOMIC_RELAXED, __HIP_MEMORY_SCOPE_AGENT); }
__device__ __forceinline__ unsigned xb_add(unsigned* p, unsigned v) { return __hip_atomic_fetch_add(p, v, __ATOMIC_RELAXED, __HIP_MEMORY_SCOPE_AGENT); }
__device__ __forceinline__ unsigned xb_xcc_id() { return (unsigned)__builtin_amdgcn_s_getreg((3 << 11) | 20) & 0xFu; }
#define XB_SPIN(cond, bar) do { unsigned _sp = 0; while (cond) { __builtin_amdgcn_s_sleep(1); \
    if ((++_sp & 255u) == 0u) { if (xb_ld(&(bar)[XB_TMO])) break; if (_sp > XB_SPIN_CAP) { atomicAdd(&(bar)[XB_TMO], 1u); break; } } } } while (0)

struct XcdBarrier {
    unsigned* bar; unsigned x;
    volatile LAS unsigned* st;
};

__device__ __forceinline__ XcdBarrier xcd_barrier_post(unsigned* bar, volatile LAS unsigned* st) {
    XcdBarrier b; b.bar = bar; b.x = xb_xcc_id(); b.st = st;
    if (threadIdx.x == 0) (void)xb_add(&bar[XB_XCNT(b.x)], 1u);
    return b;
}
__device__ __forceinline__ void xcd_barrier_complete(unsigned* bar, unsigned x, unsigned& nloc, unsigned& nx) {
    const unsigned G = gridDim.x * gridDim.y * gridDim.z;
    unsigned sum, cnt, mine, sp = 0u;
    for (;;) {
        sum = 0u; cnt = 0u; mine = 0u;
#pragma unroll
        for (unsigned j = 0; j < 16; ++j) { const unsigned c = xb_ld(&bar[XB_XCNT(j)]); sum += c; cnt += (c > 0u) ? 1u : 0u; mine = (j == x) ? c : mine; }
        if (sum == G) break;
        __builtin_amdgcn_s_sleep(1);
        if ((++sp & 255u) == 0u) { if (xb_ld(&bar[XB_TMO])) break; if (sp > XB_SPIN_CAP) { atomicAdd(&bar[XB_TMO], 1u); break; } }
    }
    nloc = mine > 0u ? mine : 1u; nx = cnt > 0u ? cnt : 1u;
}

__device__ __forceinline__ void xcd_barrier(const XcdBarrier& b) {
    asm volatile("s_waitcnt vmcnt(0)" ::: "memory");
    __syncthreads();
    if (threadIdx.x == 0) {
        unsigned* bar = b.bar;
        __builtin_amdgcn_s_waitcnt(0);
        unsigned nloc = b.st[0], nx = b.st[1];
        if (nloc == 0u) { xcd_barrier_complete(bar, b.x, nloc, nx); b.st[0] = nloc; b.st[1] = nx; }
        const unsigned old = xb_add(&bar[XB_XSUB(b.x)], 1u);
        const unsigned gen = old / nloc;
        if (old + 1u == (gen + 1u) * nloc) {
            __builtin_amdgcn_fence(__ATOMIC_RELEASE, "agent");
            asm volatile("s_waitcnt vmcnt(0)" ::: "memory");
            const unsigned og = xb_add(&bar[XB_TOP], 1u);
            const unsigned tg = og / nx;
            if (og + 1u == (tg + 1u) * nx) xb_add(&bar[XB_TOPGEN], 1u);
            else XB_SPIN(xb_ld(&bar[XB_TOPGEN]) == tg, bar);
            __builtin_amdgcn_fence(__ATOMIC_ACQUIRE, "agent");
            xb_add(&bar[XB_XGEN(b.x)], 1u);
            asm volatile("s_waitcnt vmcnt(0)" ::: "memory");
        } else {
            XB_SPIN(xb_ld(&bar[XB_XGEN(b.x)]) == gen, bar);
            __builtin_amdgcn_fence(__ATOMIC_ACQUIRE, "agent");
            asm volatile("s_waitcnt vmcnt(0)" ::: "memory");
        }
    }
    __syncthreads();
}

#ifndef DUP_MASK
#define DUP_MASK 0
#endif
#define GSYNC() do { xcd_barrier(xbar); if (DUP_MASK & 128) xcd_barrier(xbar); } while (0)
__global__ void __launch_bounds__(NTHREADS, 2) trunk_fwd(Params Pv) {
    extern __shared__ __attribute__((aligned(16))) unsigned char lds_raw[];
    LAS unsigned char* lds = (LAS unsigned char*)lds_raw;
    cg::grid_group grid = cg::this_grid();
    const int tid0 = threadIdx.x, lane0 = tid0 & 63, wave0 = __builtin_amdgcn_readfirstlane(tid0 >> 6);
    const int G = gridDim.x, bx = blockIdx.x, vcu = (G % 8 == 0) ? (bx % 8) * (G / 8) + bx / 8 : bx;

    volatile LAS unsigned* bst = (volatile LAS unsigned*)(lds + LDS_BYTES - 64);
    if (tid0 < 2) bst[tid0] = 0u;
    __syncthreads();
    XcdBarrier xbar;
    { KPtr P = KP_GET(); xbar = xcd_barrier_post((unsigned*)G_(P->ws), bst);
      prologue(P, lds, vcu, G, wave0, lane0);
      convert_p(P, G_(P->ws), 0, vcu, G, tid0); }
    grid.sync();

    for (int layer = 0; layer < 4; ++layer) {
        const int jl = layer >> 1; const bool odd = layer & 1;
        int tid = threadIdx.x; asm volatile("" : "+v"(tid));
        KPtr P = KP_GET();
        unsigned char* ws = P->ws; asm volatile("" : "+s"(ws)); ws = G_(ws);
        pg8::ss_t* SS = (pg8::ss_t*)(ws + WS_SS);
        bf16* HB0 = (bf16*)(ws + WS_HB0); bf16* HB1 = (bf16*)(ws + WS_HB1); bf16* OMIX = (bf16*)(ws + WS_OMIX); bf16* Yb = (bf16*)(ws + WS_Y); bf16* VTb = (bf16*)(ws + WS_VT); bf16* PPb = (bf16*)(ws + WS_PP); bf16* PBb = (bf16*)(ws + WS_PB);
        const int lane = tid & 63, wave = __builtin_amdgcn_readfirstlane(tid >> 6);
        const pg8::ss_t* ss_mix = SS + (size_t)layer * MT; pg8::ss_t* ss_ple = SS + (size_t)(4 + layer) * MT; pg8::ss_t* ss_next = SS + (size_t)(layer < 3 ? layer + 1 : 8) * MT;
        {
            const bf16* Wt = odd ? (const bf16*)(ws + WS_WINO) + (size_t)jl * 4096 * 1024 : (const bf16*)(ws + WS_WINE) + (size_t)jl * 3072 * 1024;
            const int nmain = odd ? 3072 : 2560, nv = odd ? 1024 : 512;
            for (int rep = 0; rep < ((DUP_MASK & 1) ? 2 : 1); ++rep) {
            { pg8::Gemm g{HB0, Wt, MT, nmain, 1024}; pg8::StaticOrder S; S.init(MT, nmain, G, bx);
              pg8::EpiY E{Yb, nmain, ss_mix, (const float*)(ws + WS_ROPE), odd ? 8 : 0};
              pg8::gemm_phase<pg8::EpiY, pg8::StaticOrder, true, true>(lds, g, S, E); }
            { pg8::Gemm g{Wt + (size_t)nmain * 1024, HB0, nv, MT, 1024}; pg8::StaticOrder S; S.init(nv, MT, G, bx);
              pg8::EpiVt E{VTb, odd ? 7 : 6, ss_mix};
              pg8::gemm_phase<pg8::EpiVt, pg8::StaticOrder, true, true>(lds, g, S, E); }
            }
        }
        GSYNC();
        if (!odd) {
            LAS unsigned char* xct = lds + wave * 4096;
            for (int rep = 0; rep < ((DUP_MASK & 2) ? 2 : 1); ++rep)
            for (int u = vcu * 8 + wave; u < 4096; u += G * 8) lru_unit(P, ws, jl, u, 0, xct, lane);
            if (layer > 0) convert_p(P, ws, layer, vcu, G, tid);
            GSYNC();
            for (int rep = 0; rep < ((DUP_MASK & 2) ? 2 : 1); ++rep)
            for (int u = vcu * 8 + wave; u < 4096; u += G * 8) lru_unit(P, ws, jl, u, 1, xct, lane);
            __syncthreads();
            for (int rep = 0; rep < ((DUP_MASK & 8) ? 2 : 1); ++rep)
            for (int vv = vcu; vv < 256; vv += G)
                for (int i = 0; i < 4; ++i) { const int li = vv & 31, bh = 8 * (vv >> 5) + 2 * i + (li >> 4), qb = (i & 1) ? 15 - (li & 15) : (li & 15); sb_unit(P, ws, bh >> 3, bh & 7, qb, lds, tid, wave, lane); }
        } else {
            float lam;
            { const float a = wave_sum(lane < 64 ? G_(P->lq1)[jl * 64 + lane] * G_(P->lk1)[jl * 64 + lane] : 0.f), c = wave_sum(G_(P->lq2)[jl * 64 + lane] * G_(P->lk2)[jl * 64 + lane]); lam = __expf(a) - __expf(c) + P->lam_init[jl]; }
            convert_p(P, ws, layer, vcu, G, tid);
            for (int rep = 0; rep < ((DUP_MASK & 16) ? 2 : 1); ++rep)
            for (int vv = vcu; vv < 256; vv += G)
                for (int i = 0; i < 4; ++i) { const int li = vv & 31, bh = 8 * (vv >> 5) + 2 * i + (li >> 4), qb = (i & 1) ? 15 - (li & 15) : (li & 15); diff_unit(P, ws, jl, lam, bh >> 3, bh & 7, qb, lds, tid, wave, lane); }
        }
        GSYNC();
        {
            { pg8::Gemm g{OMIX, (const bf16*)(ws + WS_WOUT) + (size_t)layer * 1024 * 1024, MT, 1024, 1024}; pg8::StaticOrder S; S.init(MT, 1024, G, bx);
              pg8::EpiRes E{layer == 0 ? G_(P->x) : G_(P->out), G_(P->out), HB1, ss_ple};
              pg8::gemm_phase<pg8::EpiRes, pg8::StaticOrder, true, true>(lds, g, S, E); }
            { pg8::Gemm g{PBb, (const bf16*)(ws + WS_WP) + (size_t)layer * 1024 * 256, MT, 1024, 256}; pg8::StaticOrder S; S.init(MT, 1024, G, bx);
              pg8::EpiPlain E{PPb, 1024};
              pg8::gemm_phase<pg8::EpiPlain, pg8::StaticOrder, false, true>(lds, g, S, E); }
        }
        GSYNC();
        {
            pg8::Gemm g{HB1, (const bf16*)(ws + WS_WG) + (size_t)layer * 1024 * 1024, MT, 1024, 1024}; pg8::StaticOrder S; S.init(MT, 1024, G, bx);
            pg8::EpiGate E{ss_ple, HB1, G_(P->out), PPb, HB0, ss_next};
            pg8::gemm_phase<pg8::EpiGate, pg8::StaticOrder, true, true>(lds, g, S, E);
        }
        GSYNC();
    }
    { KPtr P = KP_GET(); final_norm(P, vcu, G, wave0, lane0); }
}

extern "C" void kernel_launch(void* const* d_in, const int* in_sizes, int n_in, void* d_out, int out_size, void* d_ws, size_t ws_size, hipStream_t stream) {
    static int grid = 0;
    if (grid == 0) {
        if (n_in != 24 || out_size != MT * DM || ws_size < WS_END) { fprintf(stderr, "kernel_launch: unexpected problem (n_in %d out %d ws %zu)\n", n_in, out_size, ws_size); grid = -1; return; }
        int dev = 0, cus = 0, per_cu = 0;
        hipGetDevice(&dev); hipDeviceGetAttribute(&cus, hipDeviceAttributeMultiprocessorCount, dev);
        hipFuncSetAttribute((const void*)trunk_fwd, hipFuncAttributeMaxDynamicSharedMemorySize, LDS_BYTES);
        hipOccupancyMaxActiveBlocksPerMultiprocessor(&per_cu, (const void*)trunk_fwd, NTHREADS, LDS_BYTES);
        (void)hipGetLastError();
        if (per_cu < 1) per_cu = 1;
        grid = cus;
        if (grid > 256) grid = 256;
        grid &= ~7;
    }
    if (grid <= 0) return;
    Params P{};
    P.x = (const float*)d_in[0]; P.p = (const float*)d_in[1]; P.pos = (const int*)d_in[2]; P.norm_mix = (const float*)d_in[3]; P.norm_ple = (const float*)d_in[4];
    P.w_ple_gate = (const float*)d_in[5]; P.w_ple_proj = (const float*)d_in[6]; P.w_in_e = (const float*)d_in[7]; P.conv_w = (const float*)d_in[8]; P.conv_b = (const float*)d_in[9];
    P.lru_wa = (const float*)d_in[10]; P.lru_ba = (const float*)d_in[11]; P.lru_wx = (const float*)d_in[12]; P.lru_bx = (const float*)d_in[13]; P.lru_lambda = (const float*)d_in[14];
    P.w_out_e = (const float*)d_in[15]; P.w_in_o = (const float*)d_in[16]; P.lq1 = (const float*)d_in[17]; P.lk1 = (const float*)d_in[18]; P.lq2 = (const float*)d_in[19]; P.lk2 = (const float*)d_in[20];
    P.subln_g = (const float*)d_in[21]; P.w_out_o = (const float*)d_in[22]; P.final_norm = (const float*)d_in[23];
    P.out = (float*)d_out; P.ws = (unsigned char*)d_ws;
    P.lam_init[0] = (float)(0.8 - 0.6 * exp(-0.3 * 1.0)); P.lam_init[1] = (float)(0.8 - 0.6 * exp(-0.3 * 3.0));
    if (hipMemsetAsync(d_ws, 0, 65536, stream) != hipSuccess) { fprintf(stderr, "kernel_launch: memset of the barrier words failed\n"); return; }
    void* args[] = {&P};
    hipError_t e = hipLaunchCooperativeKernel((const void*)trunk_fwd, dim3(grid), dim3(NTHREADS), args, LDS_BYTES, stream);
    if (e != hipSuccess) fprintf(stderr, "cooperative launch failed: %s (grid %d)\n", hipGetErrorString(e), grid);
}
```

```cpp
#include <hip/hip_runtime.h>
#include <hip/hip_cooperative_groups.h>
#include <cstdio>
#include <cstdint>
#include <cmath>
namespace pg8 {
#define PG8_LAS __attribute__((address_space(3)))
typedef unsigned short bf16_t;
typedef short bf16x8 __attribute__((ext_vector_type(8)));
typedef float f32x4 __attribute__((ext_vector_type(4)));
typedef unsigned u32x4 __attribute__((ext_vector_type(4)));
constexpr int BM = 256, BK = 64, HALF = 128, HTB = HALF * BK * 2  , STAGE_BYTES = 8 * HTB, NXCD = 8, WGM = 8;

__host__ __device__ __forceinline__ int lds_byte(int r, int c) { const int st = (r >> 4) * 2 + (c >> 5), rr = r & 15, cc = c & 31, ob = rr * 64 + cc * 2; return st * 1024 + (ob ^ (((ob >> 9) & 1) << 5)); }
__host__ __device__ __forceinline__ void stage_rc(int b, int& R, int& C) { const int st = b / 1024, sb = b % 1024, swz = sb ^ (((sb >> 9) & 1) << 5); R = (st >> 1) * 16 + swz / 64; C = (st & 1) * 32 + (swz % 64) / 2; }
__host__ __device__ __forceinline__ int perm32(int rho) { const int n = rho >> 4, i = rho & 15; return 8 * (i >> 2) + 4 * n + (i & 3); }

struct Unit { int pm, pn; };
struct Gemm { const bf16_t* A; const bf16_t* Bt; int M, N, K; };

struct StaticOrder {
    int nM, nN, nwg, G, c;
    __host__ __device__ void init(int M, int N, int G_, int c_) { nM = M / BM; nN = N / BM; nwg = nM * nN; G = G_; c = c_; }
    __host__ __device__ bool next(int i, Unit& u) const {
        const long L = (long)i * G + c; if (L >= nwg) return false;
        int wgid = (int)L; { const int q = nwg / NXCD, r = nwg % NXCD, xcd = wgid % NXCD, off = wgid / NXCD; wgid = (xcd < r ? xcd * (q + 1) : r * (q + 1) + (xcd - r) * q) + off; }
        const int nig = WGM * nN, gid = wgid / nig, fm = gid * WGM, gsz = (nM - fm) < WGM ? (nM - fm) : WGM;
        u.pm = fm + ((wgid % nig) % gsz); u.pn = (wgid % nig) / gsz; return true;
    }
    __device__ __forceinline__ void a_ready(const Unit&) const {}
    __device__ __forceinline__ void done(const Unit&) const {}
};

__device__ __forceinline__ unsigned cvt_pk_bf16(float lo, float hi) { unsigned r; asm volatile("v_cvt_pk_bf16_f32 %0, %1, %2" : "=v"(r) : "v"(lo), "v"(hi)); return r; }
__device__ __forceinline__ float bf2f(unsigned short u) { return __uint_as_float((unsigned)u << 16); }
__device__ __forceinline__ u32x4 pack8(const f32x4& v0, const f32x4& v1) { u32x4 w; w.x = cvt_pk_bf16(v0[0], v0[1]); w.y = cvt_pk_bf16(v0[2], v0[3]); w.z = cvt_pk_bf16(v1[0], v1[1]); w.w = cvt_pk_bf16(v1[2], v1[3]); return w; }
constexpr float RMS_EPS = 1e-6f;
typedef unsigned long long ss_t;
__device__ __forceinline__ float ss_rstd(ss_t v) { return __builtin_amdgcn_rsqf((float)v * (2.3283064365386963e-10f / 1024.0f) + RMS_EPS); }
__device__ __forceinline__ void ss_add(ss_t* p, float sq) { atomicAdd(p, (ss_t)(sq * 4294967296.0f)); }

struct EpiY {
    static constexpr bool PERM = true, AFTER_DRAIN = false;
    bf16_t* O; int ldc; const ss_t* ss; const float* rope; int rope_pn;
    __device__ __forceinline__ void operator()(const f32x4 (&acc)[2][2][4][2], const Unit& u, int wr, int wc, int fr, int fq) const {
        asm volatile("" : "+v"(fr), "+v"(fq));
        const int row0 = u.pm * BM + wr * 64 + fr, col0 = u.pn * BM + wc * 32 + 8 * fq;
        const bool do_rope = u.pn < rope_pn;
#pragma unroll
        for (int ai = 0; ai < 2; ++ai) {
            ss_t sv[4]; f32x4 c0[4], c1[4];
#pragma unroll
            for (int m = 0; m < 4; ++m) { const int row = row0 + ai * HALF + m * 16; sv[m] = ss[row]; c0[m] = (f32x4){1.f, 0.f, 1.f, 0.f}; c1[m] = (f32x4){1.f, 0.f, 1.f, 0.f};
                if (do_rope) { const float* rp = rope + (size_t)row * 64 + ((wc & 1) * 16 + 4 * fq) * 2; c0[m] = *(const f32x4*)rp; c1[m] = *(const f32x4*)(rp + 4); } }
#pragma unroll
            for (int m = 0; m < 4; ++m) {
                const int row = row0 + ai * HALF + m * 16;
                const float rstd = ss_rstd(sv[m]);
                const f32x4 cs0 = c0[m], cs1 = c1[m];
                bf16_t* rowp = O + (size_t)row * ldc + col0;
#pragma unroll
                for (int bj = 0; bj < 2; ++bj) {
                    f32x4 v0 = acc[ai][bj][m][0] * rstd, v1 = acc[ai][bj][m][1] * rstd;
                    if (do_rope) {
                        const f32x4 c = {cs0[0], cs0[2], cs1[0], cs1[2]}, s = {cs0[1], cs0[3], cs1[1], cs1[3]};
                        const f32x4 o0 = v0 * c - v1 * s, o1 = v1 * c + v0 * s; v0 = o0; v1 = o1;
                    }
                    *(u32x4*)(rowp + bj * HALF) = pack8(v0, v1);
                }
            }
        }
    }
};
struct EpiVt {
    static constexpr bool PERM = true, AFTER_DRAIN = false;
    bf16_t* O; int dvs; const ss_t* ss;
    __device__ __forceinline__ void operator()(const f32x4 (&acc)[2][2][4][2], const Unit& u, int wr, int wc, int fr, int fq) const {
        asm volatile("" : "+v"(fr), "+v"(fq));
        const int row0 = u.pm * BM + wr * 64 + fr, col0 = u.pn * BM + wc * 32 + 8 * fq;
        f32x4 r0[2], r1[2];
#pragma unroll
        for (int bj = 0; bj < 2; ++bj) {
#pragma unroll
            for (int i = 0; i < 4; ++i) { r0[bj][i] = ss_rstd(ss[col0 + bj * HALF + i]); r1[bj][i] = ss_rstd(ss[col0 + bj * HALF + 4 + i]); }
        }
#pragma unroll
        for (int ai = 0; ai < 2; ++ai)
#pragma unroll
            for (int m = 0; m < 4; ++m) {
                const int c = row0 + ai * HALF + m * 16, hh = c >> dvs, d = c & ((1 << dvs) - 1);
#pragma unroll
                for (int bj = 0; bj < 2; ++bj) { const int tok = col0 + bj * HALF, b = tok >> 12, s = tok & 4095;
                    *(u32x4*)(O + ((((size_t)(b * 8 + hh) * 64 + (s >> 6)) << dvs) + d) * 64 + (s & 63)) = pack8(acc[ai][bj][m][0] * r0[bj], acc[ai][bj][m][1] * r1[bj]); }
            }
    }
};
struct EpiPlain {
    static constexpr bool PERM = true, AFTER_DRAIN = false;
    bf16_t* O; int ldc;
    __device__ __forceinline__ void operator()(const f32x4 (&acc)[2][2][4][2], const Unit& u, int wr, int wc, int fr, int fq) const {
        asm volatile("" : "+v"(fr), "+v"(fq));
        const int row0 = u.pm * BM + wr * 64 + fr, col0 = u.pn * BM + wc * 32 + 8 * fq;
#pragma unroll
        for (int ai = 0; ai < 2; ++ai)
#pragma unroll
            for (int m = 0; m < 4; ++m) {
                bf16_t* rowp = O + (size_t)(row0 + ai * HALF + m * 16) * ldc + col0;
#pragma unroll
                for (int bj = 0; bj < 2; ++bj) *(u32x4*)(rowp + bj * HALF) = pack8(acc[ai][bj][m][0], acc[ai][bj][m][1]);
            }
    }
};
struct EpiRes {
    static constexpr bool PERM = true, AFTER_DRAIN = false;
    const float* base; float* out; bf16_t* hb; ss_t* ssacc;
    __device__ __forceinline__ void operator()(const f32x4 (&acc)[2][2][4][2], const Unit& u, int wr, int wc, int fr, int fq) const {
        asm volatile("" : "+v"(fr), "+v"(fq));
        const int row0 = u.pm * BM + wr * 64 + fr, col0 = u.pn * BM + wc * 32 + 8 * fq;
#pragma unroll
        for (int ai = 0; ai < 2; ++ai)
#pragma unroll
            for (int m = 0; m < 4; ++m) {
                const int row = row0 + ai * HALF + m * 16; float sq = 0.f;
#pragma unroll
                for (int bj = 0; bj < 2; ++bj) {
                    const size_t off = (size_t)row * 1024 + col0 + bj * HALF;
                    const f32x4 v0 = *(const f32x4*)(base + off) + acc[ai][bj][m][0], v1 = *(const f32x4*)(base + off + 4) + acc[ai][bj][m][1];
                    *(u32x4*)(hb + off) = pack8(v0, v1);
                    sq += (v0[0] * v0[0] + v0[1] * v0[1]) + (v0[2] * v0[2] + v0[3] * v0[3]) + (v1[0] * v1[0] + v1[1] * v1[1]) + (v1[2] * v1[2] + v1[3] * v1[3]);
                }
                sq += __shfl_xor(sq, 16); sq += __shfl_xor(sq, 32);
                if (fq == 0) ss_add(ssacc + row, sq);
                if (m & 1) asm volatile("" ::: "memory");
            }
    }
};
struct EpiGate {
    static constexpr bool PERM = true, AFTER_DRAIN = false;
    const ss_t* ss; const bf16_t* h1b; float* h; const bf16_t* pp; bf16_t* hb; ss_t* ssacc;
    __device__ __forceinline__ void operator()(const f32x4 (&acc)[2][2][4][2], const Unit& u, int wr, int wc, int fr, int fq) const {
        asm volatile("" : "+v"(fr), "+v"(fq));
        const int row0 = u.pm * BM + wr * 64 + fr, col0 = u.pn * BM + wc * 32 + 8 * fq;
#pragma unroll
        for (int ai = 0; ai < 2; ++ai)
#pragma unroll
            for (int m = 0; m < 4; ++m) {
                const int row = row0 + ai * HALF + m * 16; float sq = 0.f;
                const float rstd = ss_rstd(ss[row]) * -1.4426950408889634f;
#pragma unroll
                for (int bj = 0; bj < 2; ++bj) {
                    const size_t off = (size_t)row * 1024 + col0 + bj * HALF;
                    const u32x4 pw = *(const u32x4*)(pp + off);
                    const f32x4 p0 = {__uint_as_float(pw.x << 16), __uint_as_float(pw.x & 0xffff0000u), __uint_as_float(pw.y << 16), __uint_as_float(pw.y & 0xffff0000u)};
                    const f32x4 p1 = {__uint_as_float(pw.z << 16), __uint_as_float(pw.z & 0xffff0000u), __uint_as_float(pw.w << 16), __uint_as_float(pw.w & 0xffff0000u)};
                    f32x4 g0, g1;
#pragma unroll
                    for (int i = 0; i < 4; ++i) { g0[i] = __builtin_amdgcn_rcpf(1.0f + __builtin_amdgcn_exp2f(acc[ai][bj][m][0][i] * rstd)); g1[i] = __builtin_amdgcn_rcpf(1.0f + __builtin_amdgcn_exp2f(acc[ai][bj][m][1][i] * rstd)); }
                    const u32x4 hw = *(const u32x4*)(h1b + off);
                    const f32x4 h0 = {__uint_as_float(hw.x << 16), __uint_as_float(hw.x & 0xffff0000u), __uint_as_float(hw.y << 16), __uint_as_float(hw.y & 0xffff0000u)};
                    const f32x4 h1 = {__uint_as_float(hw.z << 16), __uint_as_float(hw.z & 0xffff0000u), __uint_as_float(hw.w << 16), __uint_as_float(hw.w & 0xffff0000u)};
                    const f32x4 v0 = h0 + g0 * p0, v1 = h1 + g1 * p1;
                    *(f32x4*)(h + off) = v0; *(f32x4*)(h + off + 4) = v1; *(u32x4*)(hb + off) = pack8(v0, v1);
                    sq += (v0[0] * v0[0] + v0[1] * v0[1]) + (v0[2] * v0[2] + v0[3] * v0[3]) + (v1[0] * v1[0] + v1[1] * v1[1]) + (v1[2] * v1[2] + v1[3] * v1[3]);
                }
                sq += __shfl_xor(sq, 16); sq += __shfl_xor(sq, 32);
                if (fq == 0) ss_add(ssacc + row, sq);
                if (m & 1) asm volatile("" ::: "memory");
            }
    }
};
template <class Epi, class Sched, bool ALIGN_EPI = false, bool SP2 = false>
__device__ __forceinline__ void gemm_phase(PG8_LAS unsigned char* lds, const Gemm g, const Sched& S, const Epi& E) {
    int tid_ = threadIdx.x; asm volatile("" : "+v"(tid_));
    const int tid = tid_, wid = __builtin_amdgcn_readfirstlane(tid >> 6), lane = tid & 63, wr = wid >> 2, wc = wid & 3, fr = lane & 15, fq = lane >> 4;
    const int K = g.K, nt = K / BK;
    unsigned voffA[2], voffB[2];
#pragma unroll
    for (int i = 0; i < 2; ++i) { int R, C; stage_rc(tid * 16 + i * 8192, R, C); const int Rb = Epi::PERM ? ((R & ~31) + perm32(R & 31)) : R;
        voffA[i] = (unsigned)(R * K + C) * 2u; voffB[i] = (unsigned)(Rb * K + C) * 2u; }
    const size_t kstep = (size_t)(BK * 2);
    const size_t hstep = (size_t)HALF * K * 2;
    const size_t tstep = 2 * hstep;
    const unsigned ldsw = (unsigned)wid * 1024u;
    const int aoff = lds_byte(wr * 64 + fr, fq * 8), boff = lds_byte(wc * 32 + fr, fq * 8);
#define PG8_SA(b, h) (((b) * 2 + (h)) * HTB)
#define PG8_SB(b, h) ((4 + (b) * 2 + (h)) * HTB)
#define PG8_STAGE(bufoff, gbase, voff) do { _Pragma("unroll") for (int _i = 0; _i < 2; ++_i) \
        __builtin_amdgcn_global_load_lds((const unsigned*)((const char*)(gbase) + (voff)[_i]), (PG8_LAS unsigned*)(lds + (bufoff) + ldsw + _i * 8192), 16, 0, 0); } while (0)
#define PG8_LDA(dst, b, h) do { _Pragma("unroll") for (int m = 0; m < 4; ++m) _Pragma("unroll") for (int k = 0; k < 2; ++k) dst[m][k] = *(const PG8_LAS bf16x8*)(lds + PG8_SA(b, h) + aoff + m * 2048 + k * 1024); } while (0)
#define PG8_LDB(dst, b, h) do { _Pragma("unroll") for (int n = 0; n < 2; ++n) _Pragma("unroll") for (int k = 0; k < 2; ++k) dst[n][k] = *(const PG8_LAS bf16x8*)(lds + PG8_SB(b, h) + boff + n * 2048 + k * 1024); } while (0)
#define PG8_MMA(ai, bj, At, Bt) do { __builtin_amdgcn_s_setprio(1); _Pragma("unroll") for (int m = 0; m < 4; ++m) _Pragma("unroll") for (int n = 0; n < 2; ++n) _Pragma("unroll") for (int k = 0; k < 2; ++k) \
        acc[ai][bj][m][n] = __builtin_amdgcn_mfma_f32_16x16x32_bf16(Bt[n][k], At[m][k], acc[ai][bj][m][n], 0, 0, 0); __builtin_amdgcn_s_setprio(0); } while (0)
#define PG8_WAIT_V(n) asm volatile("s_waitcnt vmcnt(" #n ")" ::: "memory")
#define PG8_WAIT_L(n) asm volatile("s_waitcnt lgkmcnt(" #n ")" ::: "memory")
#define PG8_BAR __builtin_amdgcn_s_barrier()
#define PG8_SCHED __builtin_amdgcn_sched_barrier(0)
    Unit cur, nxt; int ui = 0;
    if (!S.next(0, cur)) return;
    f32x4 acc[2][2][4][2];
#pragma unroll
    for (int a = 0; a < 2; ++a)
#pragma unroll
        for (int b = 0; b < 2; ++b)
#pragma unroll
            for (int m = 0; m < 4; ++m)
#pragma unroll
                for (int n = 0; n < 2; ++n) acc[a][b][m][n] = (f32x4){0.f, 0.f, 0.f, 0.f};
    bf16x8 At[4][2], B0[2][2], B1[2][2];
    const char* cA = (const char*)g.A + (size_t)cur.pm * tstep; const char* cB = (const char*)g.Bt + (size_t)cur.pn * tstep;
    S.a_ready(cur);
    if constexpr (SP2) {
        PG8_STAGE(PG8_SB(0, 0), cB, voffB); PG8_STAGE(PG8_SB(0, 1), cB + hstep, voffB); PG8_STAGE(PG8_SA(0, 0), cA, voffA); PG8_STAGE(PG8_SA(0, 1), cA + hstep, voffA);
        if (wr == 1) PG8_BAR;
        PG8_WAIT_V(2); PG8_BAR;
        PG8_STAGE(PG8_SB(1, 0), cB + kstep, voffB); PG8_STAGE(PG8_SA(1, 0), cA + kstep, voffA); PG8_STAGE(PG8_SB(1, 1), cB + hstep + kstep, voffB);
        PG8_WAIT_V(6); PG8_BAR;
    } else {
        PG8_STAGE(PG8_SB(0, 0), cB, voffB); PG8_STAGE(PG8_SA(0, 0), cA, voffA); PG8_STAGE(PG8_SB(0, 1), cB + hstep, voffB); PG8_STAGE(PG8_SA(0, 1), cA + hstep, voffA);
        if (wr == 1) PG8_BAR;
        PG8_WAIT_V(4); PG8_BAR;
        PG8_STAGE(PG8_SB(1, 0), cB + kstep, voffB); PG8_STAGE(PG8_SA(1, 0), cA + kstep, voffA); PG8_STAGE(PG8_SB(1, 1), cB + hstep + kstep, voffB);
        PG8_WAIT_V(6); PG8_BAR;
    }
    for (;;) {
        const bool has_next = S.next(ui + 1, nxt);
        const char* nA = has_next ? (const char*)g.A + (size_t)nxt.pm * tstep : cA; const char* nB = has_next ? (const char*)g.Bt + (size_t)nxt.pn * tstep : cB;
        for (int t = 0; t < nt; t += 2) {
            const bool last = (t == nt - 2);
            const char* a1 = cA + (size_t)(t + 1) * kstep;
            const char* a2 = last ? nA : cA + (size_t)(t + 2) * kstep; const char* b2 = last ? nB : cB + (size_t)(t + 2) * kstep;
            const char* a3 = a2 + kstep; const char* b3 = b2 + kstep;
            if (last && has_next) S.a_ready(nxt);
            if constexpr (SP2) {
            PG8_LDB(B0, 0, 0); PG8_LDB(B1, 0, 1); PG8_SCHED; PG8_LDA(At, 0, 0); PG8_STAGE(PG8_SA(1, 1), a1 + hstep, voffA);
            PG8_WAIT_V(8); PG8_WAIT_L(0); PG8_BAR; PG8_MMA(0, 0, At, B0); PG8_MMA(0, 1, At, B1); PG8_BAR; PG8_SCHED;
            PG8_LDA(At, 0, 1); PG8_STAGE(PG8_SB(0, 0), b2, voffB); PG8_STAGE(PG8_SB(0, 1), b2 + hstep, voffB); PG8_STAGE(PG8_SA(0, 0), a2, voffA);
            PG8_WAIT_V(8); PG8_WAIT_L(0); PG8_BAR; PG8_MMA(1, 0, At, B0); PG8_MMA(1, 1, At, B1); PG8_BAR; PG8_SCHED;
            PG8_LDB(B0, 1, 0); PG8_LDB(B1, 1, 1); PG8_SCHED; PG8_LDA(At, 1, 0); PG8_STAGE(PG8_SA(0, 1), a2 + hstep, voffA);
            PG8_WAIT_V(8); PG8_WAIT_L(0); PG8_BAR; PG8_MMA(0, 0, At, B0); PG8_MMA(0, 1, At, B1); PG8_BAR; PG8_SCHED;
            PG8_LDA(At, 1, 1); PG8_STAGE(PG8_SB(1, 0), b3, voffB); PG8_STAGE(PG8_SB(1, 1), b3 + hstep, voffB); PG8_STAGE(PG8_SA(1, 0), a3, voffA);
            PG8_WAIT_V(8); PG8_WAIT_L(0); PG8_BAR; PG8_MMA(1, 0, At, B0); PG8_MMA(1, 1, At, B1); PG8_BAR; PG8_SCHED;
            } else {
            PG8_LDB(B0, 0, 0); PG8_SCHED; PG8_LDA(At, 0, 0); PG8_STAGE(PG8_SA(1, 1), a1 + hstep, voffA);
            PG8_WAIT_L(8); PG8_BAR; PG8_WAIT_L(0); PG8_MMA(0, 0, At, B0); PG8_BAR; PG8_SCHED;
            PG8_LDB(B1, 0, 1); PG8_STAGE(PG8_SB(0, 0), b2, voffB);
            PG8_BAR; PG8_WAIT_L(0); PG8_MMA(0, 1, At, B1); PG8_BAR;
            PG8_LDA(At, 0, 1); PG8_STAGE(PG8_SA(0, 0), a2, voffA);
            PG8_BAR; PG8_WAIT_L(0); PG8_MMA(1, 0, At, B0); PG8_BAR; PG8_SCHED;
            PG8_STAGE(PG8_SB(0, 1), b2 + hstep, voffB);
            PG8_WAIT_V(6); PG8_BAR; PG8_MMA(1, 1, At, B1); PG8_BAR;
            PG8_LDB(B0, 1, 0); PG8_SCHED; PG8_LDA(At, 1, 0); PG8_STAGE(PG8_SA(0, 1), a2 + hstep, voffA);
            PG8_WAIT_L(8); PG8_BAR; PG8_WAIT_L(0); PG8_MMA(0, 0, At, B0); PG8_BAR; PG8_SCHED;
            PG8_LDB(B1, 1, 1); PG8_STAGE(PG8_SB(1, 0), b3, voffB);
            PG8_BAR; PG8_WAIT_L(0); PG8_MMA(0, 1, At, B1); PG8_BAR;
            PG8_LDA(At, 1, 1); PG8_STAGE(PG8_SA(1, 0), a3, voffA);
            PG8_BAR; PG8_WAIT_L(0); PG8_MMA(1, 0, At, B0); PG8_BAR; PG8_SCHED;
            PG8_STAGE(PG8_SB(1, 1), b3 + hstep, voffB);
            PG8_WAIT_V(6); PG8_BAR; PG8_MMA(1, 1, At, B1); PG8_BAR;
            }
        }
        if constexpr (ALIGN_EPI) { if (wr == 0) PG8_BAR; }
        if constexpr (!Epi::AFTER_DRAIN) { E(acc, cur, wr, wc, fr, fq); S.done(cur); }
        if (!has_next) break;
#pragma unroll
        for (int a = 0; a < 2; ++a)
#pragma unroll
            for (int b = 0; b < 2; ++b)
#pragma unroll
                for (int m = 0; m < 4; ++m)
#pragma unroll
                    for (int n = 0; n < 2; ++n) acc[a][b][m][n] = (f32x4){0.f, 0.f, 0.f, 0.f};
        cur = nxt; cA = nA; cB = nB; ++ui;
        if constexpr (ALIGN_EPI) { if (wr == 1) PG8_BAR; }
    }
    PG8_WAIT_V(0);
    if constexpr (!ALIGN_EPI) { if (wr == 0) PG8_BAR; }
    PG8_BAR;
    if constexpr (Epi::AFTER_DRAIN) { E.fused(acc, cur, wr, wc, fr, fq, lds, wid, lane); S.done(cur); }
#undef PG8_SA
#undef PG8_SB
#undef PG8_STAGE
#undef PG8_LDA
#undef PG8_LDB
#undef PG8_MMA
#undef PG8_WAIT_V
#undef PG8_WAIT_L
#undef PG8_BAR
#undef PG8_SCHED
}
}

namespace cg = cooperative_groups;
#define LAS __attribute__((address_space(3)))
typedef unsigned short bf16;
typedef short bf16x8 __attribute__((ext_vector_type(8)));
typedef float f32x4 __attribute__((ext_vector_type(4)));
typedef float f32x16 __attribute__((ext_vector_type(16)));
typedef unsigned u32x4 __attribute__((ext_vector_type(4)));

constexpr int NB = 8, SEQ = 4096, DM = 1024, MT = NB * SEQ;
constexpr int LDY_E = 2560, LDY_O = 3072;
constexpr float QSCALE = 0.125f * 1.4426950408889634f;
constexpr size_t MiB = 1u << 20;
constexpr size_t WS_SS = 5 * MiB + 512 * 1024;
constexpr size_t WS_SUM = 3 * MiB;
constexpr size_t WS_LRUW = 5 * MiB;
constexpr size_t WS_ROPE = 8 * MiB;
constexpr size_t WS_WINE = 16 * MiB;
constexpr size_t WS_WINO = 28 * MiB;
constexpr size_t WS_WOUT = 44 * MiB;
constexpr size_t WS_WG = 52 * MiB;
constexpr size_t WS_WP = 60 * MiB;
constexpr size_t WS_PB = 64 * MiB;
constexpr size_t WS_HB0 = 80 * MiB;
constexpr size_t WS_OMIX = 144 * MiB;
constexpr size_t WS_Y = 208 * MiB;
constexpr size_t WS_PP = WS_Y, WS_HB1 = WS_Y + 64 * MiB;
constexpr size_t WS_VT = 400 * MiB;
constexpr size_t WS_END = 464 * MiB;
constexpr int LDS_BYTES = 147456;
constexpr int NTHREADS = 512;

struct Params {
    const float* x; const float* p; const int* pos; const float* norm_mix; const float* norm_ple; const float* w_ple_gate; const float* w_ple_proj;
    const float* w_in_e; const float* conv_w; const float* conv_b; const float* lru_wa; const float* lru_ba; const float* lru_wx; const float* lru_bx; const float* lru_lambda; const float* w_out_e;
    const float* w_in_o; const float* lq1; const float* lk1; const float* lq2; const float* lk2; const float* subln_g; const float* w_out_o; const float* final_norm;
    float* out; unsigned char* ws;
    float lam_init[2]; float pad[2];
};

typedef const __attribute__((address_space(4))) Params* KPtr;
#define KP_GET() ({ KPtr kp_ = (KPtr)__builtin_amdgcn_kernarg_segment_ptr(); asm volatile("" : "+s"(kp_)); kp_; })
template <class T> __device__ __forceinline__ T* G_(T* p) { __attribute__((address_space(1))) T* g = (__attribute__((address_space(1))) T*)p; asm("" : "+s"(g)); return (T*)g; }
__device__ const float INV_FREQ[32] = {1.000000000e+00f, 7.498942018e-01f, 5.623413324e-01f, 4.216965139e-01f, 3.162277639e-01f, 2.371373773e-01f, 1.778279394e-01f, 1.333521456e-01f, 1.000000015e-01f, 7.498942316e-02f, 5.623413250e-02f, 4.216964915e-02f, 3.162277490e-02f, 2.371373773e-02f, 1.778279431e-02f, 1.333521400e-02f, 9.999999776e-03f, 7.498942316e-03f, 5.623413250e-03f, 4.216964822e-03f, 3.162277630e-03f, 2.371373819e-03f, 1.778279431e-03f, 1.333521446e-03f, 1.000000047e-03f, 7.498941850e-04f, 5.623413017e-04f, 4.216965172e-04f, 3.162277571e-04f, 2.371373703e-04f, 1.778279402e-04f, 1.333521504e-04f};
__device__ __forceinline__ float bf2f(bf16 u) { return __uint_as_float((unsigned)u << 16); }
typedef float f32x2_t __attribute__((ext_vector_type(2))); typedef __bf16 bf16x2_t __attribute__((ext_vector_type(2)));
__device__ __forceinline__ unsigned cvtpk(float lo, float hi) { f32x2_t v = {lo, hi}; bf16x2_t b = __builtin_convertvector(v, bf16x2_t); return __builtin_bit_cast(unsigned, b); }
__device__ __forceinline__ bf16 f2bf(float f) { return (bf16)(cvtpk(f, 0.f) & 0xffffu); }
__device__ __forceinline__ float wave_sum(float v) {
#pragma unroll
    for (int o = 1; o < 64; o <<= 1) v += __shfl_xor(v, o);
    return v;
}
__device__ __forceinline__ int crow(int r, int hi) { return (r & 3) + 8 * (r >> 2) + 4 * hi; }
#define GLDS16(gptr, ldsptr) __builtin_amdgcn_global_load_lds((const unsigned*)(gptr), (LAS unsigned*)(ldsptr), 16, 0, 0)
#define MFMA32(a, b, c) __builtin_amdgcn_mfma_f32_32x32x16_bf16((a), (b), (c), 0, 0, 0)

__device__ __forceinline__ void colmap(int kind, int np, int& src, float& sc) {
    src = np; sc = 1.f;
    if (kind == 2) {
        if (np >= 1024 && np < 1536) sc = QSCALE;
        else if (np >= 2048 && np < 2560) src = np + 512;
        else if (np >= 2560) src = np - 512;
    } else if (kind == 3) {
        if (np < 2048) { const int head = np >> 6, s = np & 63, w = s >> 5, fq = (s >> 3) & 3, n = (s >> 2) & 1, i = s & 3; src = head * 64 + 16 * w + 4 * fq + i + 32 * n; if (np < 1024) sc = QSCALE; }
        else if (np < 3072) src = np + 1024;
        else src = np - 1024;
    }
}
__device__ __forceinline__ void wt_item(const float* W, int K, int N, bf16* WT, int nrows, int kind, const float* gk, LAS float* scr, int item, int lane) {
    const int nblk = nrows / 32, kb = item / nblk, nb = item % nblk, k0 = 64 * kb, n0 = 32 * nb;
    int src; float sc; colmap(kind, n0 + (lane & 31), src, sc);
    float wv[32];
#pragma unroll
    for (int i = 0; i < 32; ++i) wv[i] = W[(size_t)(k0 + 2 * i + (lane >> 5)) * N + src];
    const int c = lane & 7;
    f32x4 g0 = {1.f, 1.f, 1.f, 1.f}, g1 = {1.f, 1.f, 1.f, 1.f};
    if (gk) { g0 = *(const f32x4*)(gk + k0 + 8 * c); g1 = *(const f32x4*)(gk + k0 + 8 * c + 4); }
#pragma unroll
    for (int i = 0; i < 32; ++i) scr[(2 * i + (lane >> 5)) * 33 + (lane & 31)] = wv[i];
#pragma unroll
    for (int j = 0; j < 4; ++j) { const int n = (lane >> 3) + 8 * j; const LAS float* s = scr + (8 * c) * 33 + n;
        const float scn = __shfl(sc, n);
        u32x4 o; o.x = cvtpk(s[0 * 33] * (g0[0] * scn), s[1 * 33] * (g0[1] * scn)); o.y = cvtpk(s[2 * 33] * (g0[2] * scn), s[3 * 33] * (g0[3] * scn));
        o.z = cvtpk(s[4 * 33] * (g1[0] * scn), s[5 * 33] * (g1[1] * scn)); o.w = cvtpk(s[6 * 33] * (g1[2] * scn), s[7 * 33] * (g1[3] * scn));
        *(u32x4*)(WT + (size_t)(n0 + n) * K + k0 + 8 * c) = o; }
}
__device__ __forceinline__ void sincos_acc(float af, float& s, float& c) {
    const double a = (double)af; const double q = rint(a * 0.63661977236758134308); const double r = fma(-q, 1.57079632679489661923, a) - q * 6.123233995736766e-17;
    const double r2 = r * r;
    const double sp = r * (1.0 + r2 * (-1.0 / 6 + r2 * (1.0 / 120 + r2 * (-1.0 / 5040 + r2 * (1.0 / 362880 + r2 * (-1.0 / 39916800 + r2 * (1.0 / 6227020800.0)))))));
    const double cp = 1.0 + r2 * (-0.5 + r2 * (1.0 / 24 + r2 * (-1.0 / 720 + r2 * (1.0 / 40320 + r2 * (-1.0 / 3628800 + r2 * (1.0 / 479001600.0 + r2 * (-1.0 / 87178291200.0)))))));
    const int qi = ((int)q) & 3;
    const double ss = (qi == 0) ? sp : (qi == 1) ? cp : (qi == 2) ? -sp : -cp;
    const double cc = (qi == 0) ? cp : (qi == 1) ? -sp : (qi == 2) ? -cp : sp;
    s = (float)ss; c = (float)cc;
}

__device__ __forceinline__ void prologue(KPtr P, LAS unsigned char* lds, int vcu, int G, int wave, int lane) {
    unsigned char* ws = G_(P->ws);
    LAS float* scr = (LAS float*)(lds + wave * 16384);
    const int gw = vcu * 8 + wave, NGW = G * 8;
    constexpr int I_E = 16 * 96, I_O = 16 * 128, I_S = 16 * 32, I_P = 4 * 32;
    constexpr int I_L = 2 * 16 * 2;
    constexpr int NITEMS = 2 * I_E + 2 * I_O + 4 * I_S + 4 * I_S + 4 * I_P + I_L;
    for (int it = gw; it < NITEMS; it += NGW) {
        int r = it;
        if (r < 2 * I_E) { const int j = r / I_E; wt_item(G_(P->w_in_e) + (size_t)j * 1024 * 3072, 1024, 3072, (bf16*)(ws + WS_WINE) + (size_t)j * 3072 * 1024, 3072, 2, G_(P->norm_mix) + (2 * j) * 1024, scr, r % I_E, lane); continue; } r -= 2 * I_E;
        if (r < 2 * I_O) { const int j = r / I_O; wt_item(G_(P->w_in_o) + (size_t)j * 1024 * 4096, 1024, 4096, (bf16*)(ws + WS_WINO) + (size_t)j * 4096 * 1024, 4096, 3, G_(P->norm_mix) + (2 * j + 1) * 1024, scr, r % I_O, lane); continue; } r -= 2 * I_O;
        if (r < 4 * I_S) { const int i = r / I_S; const float* src = (i & 1) ? G_(P->w_out_o) + (size_t)(i >> 1) * 1024 * 1024 : G_(P->w_out_e) + (size_t)(i >> 1) * 1024 * 1024;
            wt_item(src, 1024, 1024, (bf16*)(ws + WS_WOUT) + (size_t)i * 1024 * 1024, 1024, 0, nullptr, scr, r % I_S, lane); continue; } r -= 4 * I_S;
        if (r < 4 * I_S) { const int i = r / I_S; wt_item(G_(P->w_ple_gate) + (size_t)i * 1024 * 1024, 1024, 1024, (bf16*)(ws + WS_WG) + (size_t)i * 1024 * 1024, 1024, 1, G_(P->norm_ple) + i * 1024, scr, r % I_S, lane); continue; } r -= 4 * I_S;
        if (r < 4 * I_P) { const int i = r / I_P; wt_item(G_(P->w_ple_proj) + (size_t)i * 256 * 1024, 256, 1024, (bf16*)(ws + WS_WP) + (size_t)i * 1024 * 256, 1024, 0, nullptr, scr, r % I_P, lane); continue; } r -= 4 * I_P;
        { const int gate = r >> 5, blk = (r >> 1) & 15; wt_item((gate ? G_(P->lru_wx) : G_(P->lru_wa)) + (size_t)blk * 4096, 64, 64, (bf16*)(ws + WS_LRUW) + (size_t)(gate * 16 + blk) * 4096, 64, 0, nullptr, scr, r & 1, lane); }
    }
    pg8::ss_t* SS = (pg8::ss_t*)(ws + WS_SS);
    for (int m0 = 4 * gw; m0 < MT; m0 += 4 * NGW) {
        f32x4 v[4][4];
#pragma unroll
        for (int q = 0; q < 4; ++q) { const f32x4* xr = (const f32x4*)(G_(P->x) + (size_t)(m0 + q) * DM) + lane;
#pragma unroll
            for (int j = 0; j < 4; ++j) v[q][j] = xr[64 * j]; }
#pragma unroll
        for (int q = 0; q < 4; ++q) { float s = 0.f; unsigned long long* o8 = (unsigned long long*)((bf16*)(ws + WS_HB0) + (size_t)(m0 + q) * DM) + lane;
#pragma unroll
            for (int j = 0; j < 4; ++j) { const f32x4 w = v[q][j]; s += (w.x * w.x + w.y * w.y) + (w.z * w.z + w.w * w.w);
                o8[64 * j] = (unsigned long long)cvtpk(w.x, w.y) | ((unsigned long long)cvtpk(w.z, w.w) << 32); }
            s = wave_sum(s); if (lane == 0) SS[m0 + q] = (pg8::ss_t)(s * 4294967296.0f); }
    }
    { const int gt = gw * 64 + lane, NT = NGW * 64; for (int i = gt; i < 8 * MT; i += NT) SS[MT + i] = 0ull; }
    { const int gt = gw * 64 + lane, NT = NGW * 64; float* R = (float*)(ws + WS_ROPE);
      for (int i = gt; i < MT * 32; i += NT) { const int m = i >> 5, f = i & 31; const float ang = (float)G_(P->pos)[m] * INV_FREQ[f]; float s, c; sincos_acc(ang, s, c); R[2 * i] = c; R[2 * i + 1] = s; } }
}
__device__ __forceinline__ void convert_p(KPtr P, unsigned char* wsb, int layer, int vcu, int G, int tid) {
    const f32x4* src = (const f32x4*)(G_(P->p) + (size_t)layer * MT * 256); u32x4* dst = (u32x4*)(wsb + WS_PB);
    const int gt = vcu * NTHREADS + tid, NT = G * NTHREADS;
    for (int i = gt; i < MT * 256 / 8; i += NT) { const f32x4 a = src[2 * i], b = src[2 * i + 1]; u32x4 o; o.x = cvtpk(a.x, a.y); o.y = cvtpk(a.z, a.w); o.z = cvtpk(b.x, b.y); o.w = cvtpk(b.z, b.w); dst[i] = o; }
}
__device__ __forceinline__ void final_norm(KPtr P, int vcu, int G, int wave, int lane) {
    const pg8::ss_t* SS = (const pg8::ss_t*)(G_(P->ws) + WS_SS) + 8 * (size_t)MT;
    const int gw = vcu * 8 + wave, NGW = G * 8;
    f32x4 g[4];
#pragma unroll
    for (int j = 0; j < 4; ++j) g[j] = ((const f32x4*)G_(P->final_norm))[lane + 64 * j];
    for (int m0 = 4 * gw; m0 < MT; m0 += 4 * NGW) {
        f32x4 v[4][4]; float rs[4];
#pragma unroll
        for (int q = 0; q < 4; ++q) { const f32x4* xr = (const f32x4*)(G_(P->out) + (size_t)(m0 + q) * DM) + lane; rs[q] = pg8::ss_rstd(SS[m0 + q]);
#pragma unroll
            for (int j = 0; j < 4; ++j) v[q][j] = xr[64 * j]; }
#pragma unroll
        for (int q = 0; q < 4; ++q) { f32x4* xr = (f32x4*)(G_(P->out) + (size_t)(m0 + q) * DM) + lane;
#pragma unroll
            for (int j = 0; j < 4; ++j) xr[64 * j] = v[q][j] * rs[q] * g[j]; }
    }
}

__device__ __forceinline__ int tperm(int i) { return ((i & 4) << 2) | ((i & 16) >> 1) | ((i & 8) >> 1) | (i & 3); }
__device__ __forceinline__ void lru_unit(KPtr P, unsigned char* wsb, int j, int u, int pass, LAS unsigned char* xct, int lane) {
    asm volatile("" : "+v"(lane));
    const int ch = u & 63, n = (u >> 6) & 7, b = u >> 9, c32 = lane & 31, hi = lane >> 5, cg0 = 64 * n + c32;
    const bf16* Y = (const bf16*)(wsb + WS_Y); bf16* OM = (bf16*)(wsb + WS_OMIX);
    float* SA = (float*)(wsb + WS_SUM); float* SH = SA + 8 * 64 * 512;
    const float* cw = G_(P->conv_w) + j * 4 * 512;
    float w0[2], w1[2], w2[2], w3[2], cbi[2], ba[2], bx[2], c8[2];
    bf16x8 Ba[2][4], Bx[2][4];
#pragma unroll
    for (int cb = 0; cb < 2; ++cb) {
        const int cgi = cg0 + 32 * cb;
        w0[cb] = cw[cgi]; w1[cb] = cw[512 + cgi]; w2[cb] = cw[1024 + cgi]; w3[cb] = cw[1536 + cgi]; cbi[cb] = G_(P->conv_b)[j * 512 + cgi];
        ba[cb] = G_(P->lru_ba)[j * 512 + cgi]; bx[cb] = G_(P->lru_bx)[j * 512 + cgi];
        const float lam = G_(P->lru_lambda)[j * 512 + cgi];
        c8[cb] = 8.0f * (fminf(lam, 0.f) - log1pf(__expf(-fabsf(lam))));
        const bf16* wa = (const bf16*)(wsb + WS_LRUW) + ((size_t)((j * 8 + n) * 64 + c32 + 32 * cb)) * 64 + 8 * hi; const bf16* wx = wa + 16 * 4096;
#pragma unroll
        for (int kk = 0; kk < 4; ++kk) { Ba[cb][kk] = *(const bf16x8*)(wa + 16 * kk); Bx[cb][kk] = *(const bf16x8*)(wx + 16 * kk); }
    }
    const size_t tok0 = (size_t)b * SEQ + ch * 64;
    float hc[2] = {0.f, 0.f}; float Ap[2] = {1.f, 1.f};
    if (pass == 1) {
#pragma unroll
        for (int cb = 0; cb < 2; ++cb) { const float* sa = SA + (size_t)b * 64 * 512 + cg0 + 32 * cb; const float* sh = SH + (size_t)b * 64 * 512 + cg0 + 32 * cb; float h = 0.f;
            for (int c0 = 0; c0 < ch; c0 += 16) {
                float av[16], hv[16];
#pragma unroll
                for (int i = 0; i < 16; ++i) { const int c = (c0 + i < 64) ? c0 + i : 63; av[i] = sa[c * 512]; hv[i] = sh[c * 512]; }
#pragma unroll
                for (int i = 0; i < 16; ++i) if (c0 + i < ch) h = av[i] * h + hv[i];
            }
            hc[cb] = h; }
    }
    const int arow = tperm(c32), aswz = (arow >> 1) & 7;
    for (int sub = 0; sub < 2; ++sub) {
        const size_t t0 = tok0 + sub * 32 + 16 * hi;
        const bool first = (ch == 0) && (sub == 0) && (hi == 0);
        f32x16 xc[2];
#pragma unroll
        for (int cb = 0; cb < 2; ++cb) {
            const bf16* yp = Y + t0 * LDY_E + cg0 + 32 * cb;
            float x0 = 0.f, x1 = 0.f, x2 = 0.f;
            if (!first) { x0 = bf2f(*(yp - 3 * (ptrdiff_t)LDY_E)); x1 = bf2f(*(yp - 2 * (ptrdiff_t)LDY_E)); x2 = bf2f(*(yp - (ptrdiff_t)LDY_E)); }
#pragma unroll
            for (int r = 0; r < 16; ++r) { const float xv = bf2f(yp[(size_t)r * LDY_E]); xc[cb][r] = cbi[cb] + w0[cb] * x0 + w1[cb] * x1 + w2[cb] * x2 + w3[cb] * xv; x0 = x1; x1 = x2; x2 = xv; }
#pragma unroll
            for (int r = 0; r < 16; ++r) { const int tt = 16 * hi + r, col = c32 + 32 * cb;
                *(LAS bf16*)(xct + tt * 128 + ((((col >> 3) ^ ((tt >> 1) & 7))) << 4) + (col & 7) * 2) = f2bf(xc[cb][r]); }
        }
        f32x16 pa[2], px[2];
        pa[0] = (f32x16){}; pa[1] = (f32x16){}; px[0] = (f32x16){}; px[1] = (f32x16){};
#pragma unroll
        for (int kk = 0; kk < 4; ++kk) {
            const bf16x8 af = *(const LAS bf16x8*)(xct + arow * 128 + (((2 * kk + hi) ^ aswz) << 4));
            pa[0] = MFMA32(af, Ba[0][kk], pa[0]); pa[1] = MFMA32(af, Ba[1][kk], pa[1]); px[0] = MFMA32(af, Bx[0][kk], px[0]); px[1] = MFMA32(af, Bx[1][kk], px[1]);
        }
        float Al[2], Hl[2];
#pragma unroll
        for (int cb = 0; cb < 2; ++cb) {
            float al = 1.f, hl = 0.f;
#pragma unroll
            for (int r = 0; r < 16; ++r) {
                const float rg = __builtin_amdgcn_rcpf(1.0f + __expf(-(pa[cb][r] + ba[cb]))), ig = __builtin_amdgcn_rcpf(1.0f + __expf(-(px[cb][r] + bx[cb])));
                const float la = c8[cb] * rg, a = __expf(la), x2 = 2.0f * la;
                const float ems = -x2 * (1.0f + x2 * (0.5f + x2 * ((1.0f / 6) + x2 * ((1.0f / 24) + x2 * ((1.0f / 120) + x2 * (1.0f / 720))))));
                const float em = (x2 > -0.5f) ? ems : 1.0f - a * a;
                const float uu = sqrtf(em) * (ig * xc[cb][r]);
                pa[cb][r] = a; px[cb][r] = uu; hl = a * hl + uu; al *= a;
            }
            Al[cb] = al; Hl[cb] = hl;
        }
#pragma unroll
        for (int cb = 0; cb < 2; ++cb) {
            const float oA = __shfl_xor(Al[cb], 32), oH = __shfl_xor(Hl[cb], 32);
            const float hmid = hi ? (oA * hc[cb] + oH) : (Al[cb] * hc[cb] + Hl[cb]);
            const float hin = hi ? hmid : hc[cb];
            const float hend = hi ? (Al[cb] * hmid + Hl[cb]) : (oA * hmid + oH);
            Ap[cb] *= Al[cb] * oA;
            if (pass == 1) {
                const bf16* gp = Y + t0 * LDY_E + 512 + cg0 + 32 * cb; bf16* op = OM + t0 * 1024 + cg0 + 32 * cb;
                float h = hin;
#pragma unroll
                for (int rh = 0; rh < 16; rh += 8) {
                    bf16 graw[8];
#pragma unroll
                    for (int r = 0; r < 8; ++r) graw[r] = gp[(size_t)(rh + r) * LDY_E];
#pragma unroll
                    for (int r = 0; r < 8; ++r) { h = pa[cb][rh + r] * h + px[cb][rh + r]; const float g = bf2f(graw[r]); op[(size_t)(rh + r) * 1024] = f2bf(h * g * __builtin_amdgcn_rcpf(1.0f + __expf(-g))); }
                }
            }
            hc[cb] = hend;
        }
    }
    if (pass == 0 && hi == 0) {
#pragma unroll
        for (int cb = 0; cb < 2; ++cb) { SA[((size_t)b * 64 + ch) * 512 + cg0 + 32 * cb] = Ap[cb]; SH[((size_t)b * 64 + ch) * 512 + cg0 + 32 * cb] = hc[cb]; }
    }
}

__device__ __forceinline__ int tile_off(int row, int chunk) { return row * 128 + ((chunk ^ ((row >> 1) & 7)) << 4); }
__device__ __forceinline__ int kperm(int i) { return (i & 0x13) | ((i & 4) << 1) | ((i & 8) >> 1); }

__device__ __forceinline__ void sb_unit(KPtr P, unsigned char* wsb, int b, int h, int qb, LAS unsigned char* lds, int tid, int wave, int lane) {
    const bf16* Y = (const bf16*)(wsb + WS_Y); const bf16* VT = (const bf16*)(wsb + WS_VT); bf16* OM = (bf16*)(wsb + WS_OMIX);
    asm volatile("" : "+v"(lane));
    const int r32 = lane & 31, hi = lane >> 5;
    const size_t rowbase = (size_t)b * SEQ; const int q0 = qb * 256, qw0 = q0 + wave * 32;
    const int srow = wave * 8 + (lane >> 3), sch = (lane & 7) ^ ((srow >> 1) & 7);
    const bf16* kg = Y + (rowbase + srow) * LDY_E + 1536 + h * 64 + sch * 8;
    const bf16* vg = VT + ((size_t)(b * 8 + h) * 64) * 4096 + srow * 64 + sch * 8;
    bf16x8 qr[4];
#pragma unroll
    for (int d0 = 0; d0 < 4; ++d0) qr[d0] = *(const bf16x8*)(Y + (rowbase + qw0 + r32) * LDY_E + 1024 + h * 64 + d0 * 16 + hi * 8);
    const int krow = kperm(r32), kswz = (krow >> 1) & 7, vswz = (r32 >> 1) & 7;
    f32x16 o0 = {}, o1 = {};
    float R = 1.0f;
    const int jmax = (q0 + 255) >> 6;
    GLDS16(kg + (size_t)(jmax * 64) * LDY_E, lds + wave * 1024); GLDS16(vg + (size_t)jmax * 4096, lds + 8192 + wave * 1024);
    LAS unsigned* alive = (LAS unsigned*)(lds + 32768);
    if (tid < 3) alive[tid] = 0u;
    __syncthreads();
    int it = 0, aw = 0; bool walive = true;
    for (int j = jmax; j >= 0; --j, ++it) {
        LAS unsigned char* Kb = lds + (it & 1) * 16384; LAS unsigned char* Vb = Kb + 8192;
        if (j > 0) { LAS unsigned char* Kn = lds + ((it + 1) & 1) * 16384 + wave * 1024; GLDS16(kg + (size_t)((j - 1) * 64) * LDY_E, Kn); GLDS16(vg + (size_t)(j - 1) * 4096, Kn + 8192); }
        const int k0 = j * 64;
        if (k0 < qw0 + 31 && walive) {
            f32x16 p0 = {}, p1 = {};
#pragma unroll
            for (int d0 = 0; d0 < 4; ++d0) {
                const int co = ((2 * d0 + hi) ^ kswz) << 4;
                const bf16x8 a0 = *(const LAS bf16x8*)(Kb + krow * 128 + co), a1 = *(const LAS bf16x8*)(Kb + (krow + 32) * 128 + co);
                p0 = MFMA32(a0, qr[d0], p0); p1 = MFMA32(a1, qr[d0], p1);
            }
            const int tq = qw0 + r32; const bool need_mask = (k0 + 63 >= qw0);
            if (need_mask) {
                asm volatile("" ::: );
#pragma unroll
                for (int r = 0; r < 16; ++r) { const int s = k0 + 16 * (r >> 3) + 8 * hi + (r & 7); if (s >= tq) p0[r] = -INFINITY; if (s + 32 >= tq) p1[r] = -INFINITY; }
            }
            f32x16 b0, b1;
#pragma unroll
            for (int r = 0; r < 16; ++r) {
                { const float om = __builtin_amdgcn_rcpf(1.0f + __builtin_amdgcn_exp2f(p0[r])); p0[r] = om; b0[r] = 1.0f - om; }
                { const float om = __builtin_amdgcn_rcpf(1.0f + __builtin_amdgcn_exp2f(p1[r])); p1[r] = om; b1[r] = 1.0f - om; }
            }
            f32x4 own;
            own[0] = ((p0[0] * p0[1]) * (p0[2] * p0[3])) * ((p0[4] * p0[5]) * (p0[6] * p0[7]));
            own[1] = ((p0[8] * p0[9]) * (p0[10] * p0[11])) * ((p0[12] * p0[13]) * (p0[14] * p0[15]));
            own[2] = ((p1[0] * p1[1]) * (p1[2] * p1[3])) * ((p1[4] * p1[5]) * (p1[6] * p1[7]));
            own[3] = ((p1[8] * p1[9]) * (p1[10] * p1[11])) * ((p1[12] * p1[13]) * (p1[14] * p1[15]));
            const float t0 = __shfl_xor(own[0], 32), t1 = __shfl_xor(own[1], 32), t2 = __shfl_xor(own[2], 32), t3 = __shfl_xor(own[3], 32);
            const float a0 = hi ? t0 : own[0], a1 = hi ? own[0] : t0, a2 = hi ? t1 : own[1], a3 = hi ? own[1] : t1, a4 = hi ? t2 : own[2], a5 = hi ? own[2] : t2, a6 = hi ? t3 : own[3], a7 = hi ? own[3] : t3;
            const float s7 = 1.0f, s6 = a7, s5 = s6 * a6, s4 = s5 * a5, s3 = s4 * a4, s2 = s3 * a3, s1 = s2 * a2, s0 = s1 * a1;
            const float total = s0 * a0;
            { float run = (hi ? s1 : s0) * R;
#pragma unroll
              for (int jj = 7; jj >= 0; --jj) { const float w = b0[jj] * run; run *= p0[jj]; b0[jj] = w; } }
            { float run = (hi ? s3 : s2) * R;
#pragma unroll
              for (int jj = 7; jj >= 0; --jj) { const float w = b0[8 + jj] * run; run *= p0[8 + jj]; b0[8 + jj] = w; } }
            { float run = (hi ? s5 : s4) * R;
#pragma unroll
              for (int jj = 7; jj >= 0; --jj) { const float w = b1[jj] * run; run *= p1[jj]; b1[jj] = w; } }
            { float run = (hi ? s7 : s6) * R;
#pragma unroll
              for (int jj = 7; jj >= 0; --jj) { const float w = b1[8 + jj] * run; run *= p1[8 + jj]; b1[8 + jj] = w; } }
            R *= total;
            const u32x4 pw0 = {cvtpk(b0[0], b0[1]), cvtpk(b0[2], b0[3]), cvtpk(b0[4], b0[5]), cvtpk(b0[6], b0[7])}, pw1 = {cvtpk(b0[8], b0[9]), cvtpk(b0[10], b0[11]), cvtpk(b0[12], b0[13]), cvtpk(b0[14], b0[15])};
            const u32x4 pw2 = {cvtpk(b1[0], b1[1]), cvtpk(b1[2], b1[3]), cvtpk(b1[4], b1[5]), cvtpk(b1[6], b1[7])}, pw3 = {cvtpk(b1[8], b1[9]), cvtpk(b1[10], b1[11]), cvtpk(b1[12], b1[13]), cvtpk(b1[14], b1[15])};
#define SB_PV(kk, pw) { const int co = ((2 * (kk) + hi) ^ vswz) << 4; const bf16x8 v0 = *(const LAS bf16x8*)(Vb + r32 * 128 + co), v1 = *(const LAS bf16x8*)(Vb + (r32 + 32) * 128 + co); \
                o0 = MFMA32(__builtin_bit_cast(bf16x8, pw), v0, o0); o1 = MFMA32(__builtin_bit_cast(bf16x8, pw), v1, o1); }
            SB_PV(0, pw0) SB_PV(1, pw1) SB_PV(2, pw2) SB_PV(3, pw3)
#undef SB_PV
        }
        const int an = (aw == 2) ? 0 : aw + 1;
        walive = __any(R != 0.0f);
        if (walive && lane == 0) alive[aw] = 1u;
        if (tid == 0) alive[an] = 0u;
        __syncthreads();
        if (alive[aw] == 0u) break;
        aw = an;
    }
    int r32e = r32; asm volatile("" : "+v"(r32e));
    bf16 gr0[16], gr1[16];
#pragma unroll
    for (int r = 0; r < 16; ++r) { const size_t tok = rowbase + qw0 + crow(r, hi); gr0[r] = Y[tok * LDY_E + 2048 + h * 64 + r32e]; gr1[r] = Y[tok * LDY_E + 2048 + h * 64 + 32 + r32e]; }
#pragma unroll
    for (int r = 0; r < 16; ++r) {
        const size_t tok = rowbase + qw0 + crow(r, hi);
        const float g0 = bf2f(gr0[r]), g1 = bf2f(gr1[r]);
        OM[tok * 1024 + 512 + h * 64 + r32e] = f2bf(o0[r] * g0 * __builtin_amdgcn_rcpf(1.0f + __expf(-g0)));
        OM[tok * 1024 + 512 + h * 64 + 32 + r32e] = f2bf(o1[r] * g1 * __builtin_amdgcn_rcpf(1.0f + __expf(-g1)));
    }
    __syncthreads();
}

__device__ __forceinline__ void diff_map_half(LAS unsigned char* Qb  , LAS unsigned char* Kb, LAS unsigned char* Vb, LAS float* wsf, f32x16 (&O)[4], float& mrow, float& lrow,
                                              int kbase  , int p, int tq, bool need_mask, int krow, int kswz, int vswz, int r32, int hi) {
    f32x16 s = {};
#pragma unroll
    for (int d0 = 0; d0 < 4; ++d0) {
        const int co = ((2 * d0 + hi) ^ kswz) << 4;
        const bf16x8 a0 = *(const LAS bf16x8*)(Kb + (krow + 32 * p) * 128 + co);
        const bf16x8 qf = *(const LAS bf16x8*)(Qb + r32 * 128 + (((2 * d0 + hi) ^ vswz) << 4));
        s = MFMA32(a0, qf, s);
    }
    if (need_mask) {
        asm volatile("" ::: );
#pragma unroll
        for (int r = 0; r < 16; ++r) { const int key = kbase + 16 * (r >> 3) + 8 * hi + (r & 7); if (key > tq) s[r] = -INFINITY; }
    }
    float mx = fmaxf(s[0], s[1]);
#pragma unroll
    for (int r = 2; r < 16; ++r) mx = fmaxf(mx, s[r]);
    { const auto rr = __builtin_amdgcn_permlane32_swap(__float_as_uint(mx), __float_as_uint(mx), false, false); mx = fmaxf(__uint_as_float(rr[0]), __uint_as_float(rr[1])); }
    constexpr float DIFF_THR = 8.0f;
    float mnew = mrow;
    if (__any(mx > mrow + DIFF_THR)) {
        mnew = fmaxf(mrow, mx);
        const float alpha = __builtin_amdgcn_exp2f(mrow - mnew);
        lrow *= alpha;
        if (hi == 0) wsf[r32] = alpha;
#pragma unroll
        for (int r = 0; r < 16; ++r) { const float al = wsf[crow(r, hi)];
#pragma unroll
            for (int dd = 0; dd < 4; ++dd) O[dd][r] *= al; }
    }
    mrow = mnew;
    float sum = 0.f;
#pragma unroll
    for (int r = 0; r < 16; ++r) { s[r] = __builtin_amdgcn_exp2f(s[r] - mnew); sum += s[r]; }
    lrow += sum;
    const u32x4 pw0 = {cvtpk(s[0], s[1]), cvtpk(s[2], s[3]), cvtpk(s[4], s[5]), cvtpk(s[6], s[7])}, pw1 = {cvtpk(s[8], s[9]), cvtpk(s[10], s[11]), cvtpk(s[12], s[13]), cvtpk(s[14], s[15])};
#pragma unroll
    for (int dd = 0; dd < 4; ++dd) {
        const bf16x8 v0 = *(const LAS bf16x8*)(Vb + (r32 + 32 * dd) * 128 + (((4 * p + hi) ^ vswz) << 4)), v1 = *(const LAS bf16x8*)(Vb + (r32 + 32 * dd) * 128 + (((4 * p + 2 + hi) ^ vswz) << 4));
        O[dd] = MFMA32(__builtin_bit_cast(bf16x8, pw0), v0, O[dd]); O[dd] = MFMA32(__builtin_bit_cast(bf16x8, pw1), v1, O[dd]);
    }
}

__device__ __forceinline__ void diff_unit(KPtr P, unsigned char* wsb, int jl, float lam, int b, int h, int qb, LAS unsigned char* lds, int tid, int wave, int lane) {
    const bf16* Y = (const bf16*)(wsb + WS_Y); const bf16* VT = (const bf16*)(wsb + WS_VT); bf16* OM = (bf16*)(wsb + WS_OMIX);
    asm volatile("" : "+v"(lane));
    const int r32 = lane & 31, hi = lane >> 5;
    const size_t rowbase = (size_t)b * SEQ; const int q0 = qb * 256, qw0 = q0 + wave * 32;
    const int srow = wave * 8 + (lane >> 3), sch = (lane & 7) ^ ((srow >> 1) & 7);
    const bf16* k1g = Y + (rowbase + srow) * LDY_O + 1024 + (2 * h) * 64 + sch * 8;
    const bf16* k2g = k1g + 64;
    const bf16* vg = VT + ((size_t)(b * 8 + h) * 64) * 8192 + srow * 64 + sch * 8;
    constexpr int BUF = 32768;
    LAS float* wsf = (LAS float*)(lds + 2 * BUF) + wave * 64;
    LAS unsigned char* Q1b = lds + 2 * BUF + 2048 + wave * 8192; LAS unsigned char* Q2b = Q1b + 4096;
#pragma unroll
    for (int i = 0; i < 4; ++i) { const int qrow = 8 * i + (lane >> 3), qch = (lane & 7) ^ ((qrow >> 1) & 7); const bf16* qp = Y + (rowbase + qw0 + qrow) * LDY_O + (2 * h) * 64 + qch * 8;
        GLDS16(qp, Q1b + i * 1024); GLDS16(qp + 64, Q2b + i * 1024); }
    const int krow = kperm(r32), kswz = (krow >> 1) & 7, vswz = (r32 >> 1) & 7;
    f32x16 O1[4], O2[4];
#pragma unroll
    for (int dd = 0; dd < 4; ++dd) { O1[dd] = (f32x16){}; O2[dd] = (f32x16){}; }
    float m1 = -INFINITY, m2 = -INFINITY, l1 = 0.f, l2 = 0.f;
    const int jmax = (q0 + 255) >> 6;
    { LAS unsigned char* Bn = lds + wave * 1024; GLDS16(k1g, Bn); GLDS16(k2g, Bn + 8192); GLDS16(vg, Bn + 16384); GLDS16(vg + 4096, Bn + 24576); }
    __syncthreads();
    const int tq = qw0 + r32;
    for (int j = 0; j <= jmax; ++j) {
        LAS unsigned char* B0 = lds + (j & 1) * BUF;
        if (j < jmax) { const size_t ko = (size_t)(j + 1) * 64; LAS unsigned char* Bn = lds + ((j + 1) & 1) * BUF + wave * 1024; GLDS16(k1g + ko * LDY_O, Bn); GLDS16(k2g + ko * LDY_O, Bn + 8192); GLDS16(vg + (size_t)(j + 1) * 8192, Bn + 16384); GLDS16(vg + (size_t)(j + 1) * 8192 + 4096, Bn + 24576); }
        const int k0 = j * 64;
        if (k0 <= qw0 + 31) {
            const bool need_mask = (k0 + 63 > qw0);
            diff_map_half(Q1b, B0, B0 + 16384, wsf, O1, m1, l1, k0, 0, tq, need_mask, krow, kswz, vswz, r32, hi);
            diff_map_half(Q2b, B0 + 8192, B0 + 16384, wsf + 32, O2, m2, l2, k0, 0, tq, need_mask, krow, kswz, vswz, r32, hi);
            if (k0 + 32 <= qw0 + 31) {
                diff_map_half(Q1b, B0, B0 + 16384, wsf, O1, m1, l1, k0 + 32, 1, tq, need_mask, krow, kswz, vswz, r32, hi);
                diff_map_half(Q2b, B0 + 8192, B0 + 16384, wsf + 32, O2, m2, l2, k0 + 32, 1, tq, need_mask, krow, kswz, vswz, r32, hi);
            }
        }
        __syncthreads();
    }
    l1 += __shfl_xor(l1, 32); l2 += __shfl_xor(l2, 32);
    int r32e = r32; asm volatile("" : "+v"(r32e));
    if (hi == 0) { wsf[r32] = __builtin_amdgcn_rcpf(l1); wsf[32 + r32] = lam * __builtin_amdgcn_rcpf(l2); }
    const float* sg = G_(P->subln_g) + jl * 128; const float post = 1.0f - P->lam_init[jl];
    f32x4 gsc;
#pragma unroll
    for (int dd = 0; dd < 4; ++dd) gsc[dd] = sg[32 * dd + r32e] * post;
#pragma unroll
    for (int rh = 0; rh < 16; rh += 4) {
        bf16 graw[4][4];
#pragma unroll
        for (int r = 0; r < 4; ++r)
#pragma unroll
            for (int dd = 0; dd < 4; ++dd) graw[r][dd] = Y[(rowbase + qw0 + crow(rh + r, hi)) * LDY_O + 2048 + h * 128 + 32 * dd + r32e];
#pragma unroll
        for (int r8 = 0; r8 < 4; ++r8) {
            const int r = rh + r8;
            const int qr_ = crow(r, hi); const float i1 = wsf[qr_], i2 = wsf[32 + qr_];
            f32x4 v; float sq = 0.f;
#pragma unroll
            for (int dd = 0; dd < 4; ++dd) { v[dd] = O1[dd][r] * i1 - O2[dd][r] * i2; sq += v[dd] * v[dd]; }
            sq += __shfl_xor(sq, 1); sq += __shfl_xor(sq, 2); sq += __shfl_xor(sq, 4); sq += __shfl_xor(sq, 8); sq += __shfl_xor(sq, 16);
            const float rn = __builtin_amdgcn_rsqf(sq * (1.0f / 128.0f) + 1e-6f);
            const size_t tok = rowbase + qw0 + qr_;
#pragma unroll
            for (int dd = 0; dd < 4; ++dd) { const float g = bf2f(graw[r8][dd]);
                OM[tok * 1024 + h * 128 + 32 * dd + r32e] = f2bf(v[dd] * rn * gsc[dd] * g * __builtin_amdgcn_rcpf(1.0f + __expf(-g))); }
        }
    }
    __syncthreads();
}

#define XB_TMO      128
#define XB_XCNT(j)  (256  + 64 * (j))
#define XB_XSUB(j)  (1280 + 64 * (j))
#define XB_XGEN(j)  (2304 + 64 * (j))
#define XB_TOP      3328
#define XB_TOPGEN   3392
#define XCD_BAR_WORDS 3456
#define XB_SPIN_CAP (1u << 18)

__device__ __forceinline__ unsigned xb_ld(unsigned* p)              { return __hip_atomic_load(p, __ATOMIC_RELAXED, __HIP_MEMORY_SCOPE_AGENT); }
__device__ __forceinline__ unsigned xb_add(unsigned* p, unsigned v) { return __hip_atomic_fetch_add(p, v, __ATOMIC_RELAXED, __HIP_MEMORY_SCOPE_AGENT); }
__device__ __forceinline__ unsigned xb_xcc_id() { return (unsigned)__builtin_amdgcn_s_getreg((3 << 11) | 20) & 0xFu; }
#define XB_SPIN(cond, bar) do { unsigned _sp = 0; while (cond) { __builtin_amdgcn_s_sleep(1); \
    if ((++_sp & 255u) == 0u) { if (xb_ld(&(bar)[XB_TMO])) break; if (_sp > XB_SPIN_CAP) { atomicAdd(&(bar)[XB_TMO], 1u); break; } } } } while (0)

struct XcdBarrier {
    unsigned* bar; unsigned x;
    volatile LAS unsigned* st;
};

__device__ __forceinline__ XcdBarrier xcd_barrier_post(unsigned* bar, volatile LAS unsigned* st) {
    XcdBarrier b; b.bar = bar; b.x = xb_xcc_id(); b.st = st;
    if (threadIdx.x == 0) (void)xb_add(&bar[XB_XCNT(b.x)], 1u);
    return b;
}
__device__ __forceinline__ void xcd_barrier_complete(unsigned* bar, unsigned x, unsigned& nloc, unsigned& nx) {
    const unsigned G = gridDim.x * gridDim.y * gridDim.z;
    unsigned sum, cnt, mine, sp = 0u;
    for (;;) {
        sum = 0u; cnt = 0u; mine = 0u;
#pragma unroll
        for (unsigned j = 0; j < 16; ++j) { const unsigned c = xb_ld(&bar[XB_XCNT(j)]); sum += c; cnt += (c > 0u) ? 1u : 0u; mine = (j == x) ? c : mine; }
        if (sum == G) break;
        __builtin_amdgcn_s_sleep(1);
        if ((++sp & 255u) == 0u) { if (xb_ld(&bar[XB_TMO])) break; if (sp > XB_SPIN_CAP) { atomicAdd(&bar[XB_TMO], 1u); break; } }
    }
    nloc = mine > 0u ? mine : 1u; nx = cnt > 0u ? cnt : 1u;
}

__device__ __forceinline__ void xcd_barrier(const XcdBarrier& b) {
    asm volatile("s_waitcnt vmcnt(0)" ::: "memory");
    __syncthreads();
    if (threadIdx.x == 0) {
        unsigned* bar = b.bar;
        __builtin_amdgcn_s_waitcnt(0);
        unsigned nloc = b.st[0], nx = b.st[1];
        if (nloc == 0u) { xcd_barrier_complete(bar, b.x, nloc, nx); b.st[0] = nloc; b.st[1] = nx; }
        const unsigned old = xb_add(&bar[XB_XSUB(b.x)], 1u);
        const unsigned gen = old / nloc;
        if (old + 1u == (gen + 1u) * nloc) {
            __builtin_amdgcn_fence(__ATOMIC_RELEASE, "agent");
            asm volatile("s_waitcnt vmcnt(0)" ::: "memory");
            const unsigned og = xb_add(&bar[XB_TOP], 1u);
            const unsigned tg = og / nx;
            if (og + 1u == (tg + 1u) * nx) xb_add(&bar[XB_TOPGEN], 1u);
            else XB_SPIN(xb_ld(&bar[XB_TOPGEN]) == tg, bar);
            __builtin_amdgcn_fence(__ATOMIC_ACQUIRE, "agent");
            xb_add(&bar[XB_XGEN(b.x)], 1u);
            asm volatile("s_waitcnt vmcnt(0)" ::: "memory");
        } else {
            XB_SPIN(xb_ld(&bar[XB_XGEN(b.x)]) == gen, bar);
            __builtin_amdgcn_fence(__ATOMIC_ACQUIRE, "agent");
            asm volatile("s_waitcnt vmcnt(0)" ::: "memory");
        }
    }
    __syncthreads();
}

#ifndef DUP_MASK
#define DUP_MASK 0
#endif
#define GSYNC() do { xcd_barrier(xbar); if (DUP_MASK & 128) xcd_barrier(xbar); } while (0)
__global__ void __launch_bounds__(NTHREADS, 2) trunk_fwd(Params Pv) {
    extern __shared__ __attribute__((aligned(16))) unsigned char lds_raw[];
    LAS unsigned char* lds = (LAS unsigned char*)lds_raw;
    cg::grid_group grid = cg::this_grid();
    const int tid0 = threadIdx.x, lane0 = tid0 & 63, wave0 = __builtin_amdgcn_readfirstlane(tid0 >> 6);
    const int G = gridDim.x, bx = blockIdx.x, vcu = (G % 8 == 0) ? (bx % 8) * (G / 8) + bx / 8 : bx;

    volatile LAS unsigned* bst = (volatile LAS unsigned*)(lds + LDS_BYTES - 64);
    if (tid0 < 2) bst[tid0] = 0u;
    __syncthreads();
    XcdBarrier xbar;
    { KPtr P = KP_GET(); xbar = xcd_barrier_post((unsigned*)G_(P->ws), bst);
      prologue(P, lds, vcu, G, wave0, lane0);
      convert_p(P, G_(P->ws), 0, vcu, G, tid0); }
    grid.sync();

    for (int layer = 0; layer < 4; ++layer) {
        const int jl = layer >> 1; const bool odd = layer & 1;
        int tid = threadIdx.x; asm volatile("" : "+v"(tid));
        KPtr P = KP_GET();
        unsigned char* ws = P->ws; asm volatile("" : "+s"(ws)); ws = G_(ws);
        pg8::ss_t* SS = (pg8::ss_t*)(ws + WS_SS);
        bf16* HB0 = (bf16*)(ws + WS_HB0); bf16* HB1 = (bf16*)(ws + WS_HB1); bf16* OMIX = (bf16*)(ws + WS_OMIX); bf16* Yb = (bf16*)(ws + WS_Y); bf16* VTb = (bf16*)(ws + WS_VT); bf16* PPb = (bf16*)(ws + WS_PP); bf16* PBb = (bf16*)(ws + WS_PB);
        const int lane = tid & 63, wave = __builtin_amdgcn_readfirstlane(tid >> 6);
        const pg8::ss_t* ss_mix = SS + (size_t)layer * MT; pg8::ss_t* ss_ple = SS + (size_t)(4 + layer) * MT; pg8::ss_t* ss_next = SS + (size_t)(layer < 3 ? layer + 1 : 8) * MT;
        {
            const bf16* Wt = odd ? (const bf16*)(ws + WS_WINO) + (size_t)jl * 4096 * 1024 : (const bf16*)(ws + WS_WINE) + (size_t)jl * 3072 * 1024;
            const int nmain = odd ? 3072 : 2560, nv = odd ? 1024 : 512;
            for (int rep = 0; rep < ((DUP_MASK & 1) ? 2 : 1); ++rep) {
            { pg8::Gemm g{HB0, Wt, MT, nmain, 1024}; pg8::StaticOrder S; S.init(MT, nmain, G, bx);
              pg8::EpiY E{Yb, nmain, ss_mix, (const float*)(ws + WS_ROPE), odd ? 8 : 0};
              pg8::gemm_phase<pg8::EpiY, pg8::StaticOrder, true, true>(lds, g, S, E); }
            { pg8::Gemm g{Wt + (size_t)nmain * 1024, HB0, nv, MT, 1024}; pg8::StaticOrder S; S.init(nv, MT, G, bx);
              pg8::EpiVt E{VTb, odd ? 7 : 6, ss_mix};
              pg8::gemm_phase<pg8::EpiVt, pg8::StaticOrder, true, true>(lds, g, S, E); }
            }
        }
        GSYNC();
        if (!odd) {
            LAS unsigned char* xct = lds + wave * 4096;
            for (int rep = 0; rep < ((DUP_MASK & 2) ? 2 : 1); ++rep)
            for (int u = vcu * 8 + wave; u < 4096; u += G * 8) lru_unit(P, ws, jl, u, 0, xct, lane);
            if (layer > 0) convert_p(P, ws, layer, vcu, G, tid);
            GSYNC();
            for (int rep = 0; rep < ((DUP_MASK & 2) ? 2 : 1); ++rep)
            for (int u = vcu * 8 + wave; u < 4096; u += G * 8) lru_unit(P, ws, jl, u, 1, xct, lane);
            __syncthreads();
            for (int rep = 0; rep < ((DUP_MASK & 8) ? 2 : 1); ++rep)
            for (int vv = vcu; vv < 256; vv += G)
                for (int i = 0; i < 4; ++i) { const int li = vv & 31, bh = 8 * (vv >> 5) + 2 * i + (li >> 4), qb = (i & 1) ? 15 - (li & 15) : (li & 15); sb_unit(P, ws, bh >> 3, bh & 7, qb, lds, tid, wave, lane); }
        } else {
            float lam;
            { const float a = wave_sum(lane < 64 ? G_(P->lq1)[jl * 64 + lane] * G_(P->lk1)[jl * 64 + lane] : 0.f), c = wave_sum(G_(P->lq2)[jl * 64 + lane] * G_(P->lk2)[jl * 64 + lane]); lam = __expf(a) - __expf(c) + P->lam_init[jl]; }
            convert_p(P, ws, layer, vcu, G, tid);
            for (int rep = 0; rep < ((DUP_MASK & 16) ? 2 : 1); ++rep)
            for (int vv = vcu; vv < 256; vv += G)
                for (int i = 0; i < 4; ++i) { const int li = vv & 31, bh = 8 * (vv >> 5) + 2 * i + (li >> 4), qb = (i & 1) ? 15 - (li & 15) : (li & 15); diff_unit(P, ws, jl, lam, bh >> 3, bh & 7, qb, lds, tid, wave, lane); }
        }
        GSYNC();
        {
            { pg8::Gemm g{OMIX, (const bf16*)(ws + WS_WOUT) + (size_t)layer * 1024 * 1024, MT, 1024, 1024}; pg8::StaticOrder S; S.init(MT, 1024, G, bx);
              pg8::EpiRes E{layer == 0 ? G_(P->x) : G_(P->out), G_(P->out), HB1, ss_ple};
              pg8::gemm_phase<pg8::EpiRes, pg8::StaticOrder, true, true>(lds, g, S, E); }
            { pg8::Gemm g{PBb, (const bf16*)(ws + WS_WP) + (size_t)layer * 1024 * 256, MT, 1024, 256}; pg8::StaticOrder S; S.init(MT, 1024, G, bx);
              pg8::EpiPlain E{PPb, 1024};
              pg8::gemm_phase<pg8::EpiPlain, pg8::StaticOrder, false, true>(lds, g, S, E); }
        }
        GSYNC();
        {
            pg8::Gemm g{HB1, (const bf16*)(ws + WS_WG) + (size_t)layer * 1024 * 1024, MT, 1024, 1024}; pg8::StaticOrder S; S.init(MT, 1024, G, bx);
            pg8::EpiGate E{ss_ple, HB1, G_(P->out), PPb, HB0, ss_next};
            pg8::gemm_phase<pg8::EpiGate, pg8::StaticOrder, true, true>(lds, g, S, E);
        }
        GSYNC();
    }
    { KPtr P = KP_GET(); final_norm(P, vcu, G, wave0, lane0); }
}

extern "C" void kernel_launch(void* const* d_in, const int* in_sizes, int n_in, void* d_out, int out_size, void* d_ws, size_t ws_size, hipStream_t stream) {
    static int grid = 0;
    if (grid == 0) {
        if (n_in != 24 || out_size != MT * DM || ws_size < WS_END) { fprintf(stderr, "kernel_launch: unexpected problem (n_in %d out %d ws %zu)\n", n_in, out_size, ws_size); grid = -1; return; }
        int dev = 0, cus = 0, per_cu = 0;
        hipGetDevice(&dev); hipDeviceGetAttribute(&cus, hipDeviceAttributeMultiprocessorCount, dev);
        hipFuncSetAttribute((const void*)trunk_fwd, hipFuncAttributeMaxDynamicSharedMemorySize, LDS_BYTES);
        hipOccupancyMaxActiveBlocksPerMultiprocessor(&per_cu, (const void*)trunk_fwd, NTHREADS, LDS_BYTES);
        (void)hipGetLastError();
        if (per_cu < 1) per_cu = 1;
        grid = cus;
        if (grid > 256) grid = 256;
        grid &= ~7;
    }
    if (grid <= 0) return;
    Params P{};
    P.x = (const float*)d_in[0]; P.p = (const float*)d_in[1]; P.pos = (const int*)d_in[2]; P.norm_mix = (const float*)d_in[3]; P.norm_ple = (const float*)d_in[4];
    P.w_ple_gate = (const float*)d_in[5]; P.w_ple_proj = (const float*)d_in[6]; P.w_in_e = (const float*)d_in[7]; P.conv_w = (const float*)d_in[8]; P.conv_b = (const float*)d_in[9];
    P.lru_wa = (const float*)d_in[10]; P.lru_ba = (const float*)d_in[11]; P.lru_wx = (const float*)d_in[12]; P.lru_bx = (const float*)d_in[13]; P.lru_lambda = (const float*)d_in[14];
    P.w_out_e = (const float*)d_in[15]; P.w_in_o = (const float*)d_in[16]; P.lq1 = (const float*)d_in[17]; P.lk1 = (const float*)d_in[18]; P.lq2 = (const float*)d_in[19]; P.lk2 = (const float*)d_in[20];
    P.subln_g = (const float*)d_in[21]; P.w_out_o = (const float*)d_in[22]; P.final_norm = (const float*)d_in[23];
    P.out = (float*)d_out; P.ws = (unsigned char*)d_ws;
    P.lam_init[0] = (float)(0.8 - 0.6 * exp(-0.3 * 1.0)); P.lam_init[1] = (float)(0.8 - 0.6 * exp(-0.3 * 3.0));
    if (hipMemsetAsync(d_ws, 0, 65536, stream) != hipSuccess) { fprintf(stderr, "kernel_launch: memset of the barrier words failed\n"); return; }
    void* args[] = {&P};
    hipError_t e = hipLaunchCooperativeKernel((const void*)trunk_fwd, dim3(grid), dim3(NTHREADS), args, LDS_BYTES, stream);
    if (e != hipSuccess) fprintf(stderr, "cooperative launch failed: %s (grid %d)\n", hipGetErrorString(e), grid);
}
```
